# Optimizing an MI355X kernel written in HIP

```python
import jax, jax.numpy as jnp
from jax import lax
import numpy as np

D_MODEL = 1024
BATCH = 8
SEQ = 2048
DEPTH = 2

N_EVEN = (DEPTH + 1) // 2
N_ODD = DEPTH // 2

CONV_DIM = D_MODEL // 2
CONV_WIDTH = 3
HGRN_HEADS = 4
HGRN_EXPAND = 128
HGRN_HEAD_V = (D_MODEL // 2) // HGRN_HEADS
HGRN_KEY_DIM = HGRN_HEADS * HGRN_EXPAND
HGRN_VAL_DIM = HGRN_HEADS * HGRN_HEAD_V
HGRN_CHUNK = 64
EVEN_SPLITS = [CONV_DIM] * 3 + [HGRN_KEY_DIM] * 2 + [HGRN_VAL_DIM] * 2
EVEN_IN = sum(EVEN_SPLITS)
EVEN_MIX = CONV_DIM + HGRN_VAL_DIM

RET_HEADS = 4
RET_HEAD_K = D_MODEL // RET_HEADS
RET_HEAD_V = 2 * RET_HEAD_K
RET_K_DIM = RET_HEADS * RET_HEAD_K
RET_V_DIM = RET_HEADS * RET_HEAD_V
RET_CHUNK = 128
ROPE_BASE = 10000.0
ODD_SPLITS = [RET_K_DIM, RET_K_DIM, RET_V_DIM, RET_V_DIM]
ODD_IN = sum(ODD_SPLITS)

FFN_HIDDEN = -(-(8 * D_MODEL) // (3 * 256)) * 256

EPS = 1e-6

kernel_name = "hybrid_conv_hgrn2_retention_trunk"


def _split_points(sizes):
    return [int(v) for v in np.cumsum(sizes)[:-1]]


def rmsnorm(x, w):
    xf = x.astype(jnp.float32)
    y = xf * lax.rsqrt(jnp.mean(xf * xf, axis=-1, keepdims=True) + EPS)
    return (y * w.astype(jnp.float32)).astype(x.dtype)


def short_conv_mixer(a, b, c, w_conv):
    S = a.shape[1]
    u = c * a
    up = jnp.pad(u, ((0, 0), (CONV_WIDTH - 1, 0), (0, 0)))
    y = up[:, 0:S] * w_conv[0]
    for k in range(1, CONV_WIDTH):
        y = y + up[:, k:k + S] * w_conv[k]
    return b * y


def hgrn2_mixer(q, f, i, g, lb, norm_w):
    Bn, S, _ = q.shape
    N = S // HGRN_CHUNK
    C = HGRN_CHUNK
    f32 = jnp.float32
    qf = jax.nn.silu(q.astype(f32))
    logf = jnp.logaddexp(jnp.log(lb), jnp.log1p(-lb) + jax.nn.log_sigmoid(f.astype(f32)))
    kf = -jnp.expm1(logf)
    vf = i.astype(f32)

    def to_chunks(t, hd):
        return t.reshape(Bn, N, C, HGRN_HEADS, hd).transpose(1, 0, 3, 2, 4)

    qc = to_chunks(qf, HGRN_EXPAND)
    kc = to_chunks(kf, HGRN_EXPAND)
    lc = to_chunks(logf, HGRN_EXPAND)
    vc = to_chunks(vf, HGRN_HEAD_V)
    causal = jnp.tril(jnp.ones((C, C), dtype=bool))

    def step(state, inp):
        qn, kn, ln, vn = inp
        b = jnp.cumsum(ln, axis=-2)
        o_inter = jnp.einsum('bhck,bhkv->bhcv', qn * jnp.exp(b), state)
        diff = b[:, :, :, None, :] - b[:, :, None, :, :]
        decay = jnp.exp(jnp.where(causal[:, :, None], diff, -jnp.inf))
        scores = jnp.einsum('bhik,bhijk,bhjk->bhij', qn, decay, kn)
        o_intra = jnp.einsum('bhij,bhjv->bhiv', scores, vn)
        b_last = b[:, :, -1:, :]
        new_state = (jnp.exp(b_last[:, :, 0, :])[..., None] * state
                     + jnp.einsum('bhck,bhcv->bhkv', kn * jnp.exp(b_last - b), vn))
        return new_state, o_inter + o_intra

    state0 = jnp.zeros((Bn, HGRN_HEADS, HGRN_EXPAND, HGRN_HEAD_V), f32)
    _, o = lax.scan(step, state0, (qc, kc, lc, vc))
    o = o.transpose(1, 0, 3, 2, 4).reshape(Bn, S, HGRN_HEADS, HGRN_HEAD_V)
    o = o * lax.rsqrt(jnp.mean(o * o, axis=-1, keepdims=True) + EPS)
    o = o * norm_w.astype(f32).reshape(HGRN_HEADS, HGRN_HEAD_V)
    o = o.reshape(Bn, S, HGRN_VAL_DIM) * jax.nn.silu(g.astype(f32))
    return o.astype(q.dtype)


def rotary(x, pos):
    half = x.shape[-1] // 2
    inv_freq = ROPE_BASE ** (-jnp.arange(half, dtype=jnp.float32) / half)
    ang = pos.astype(jnp.float32)[..., None] * inv_freq
    cos = jnp.cos(ang)[:, :, None, :]
    sin = jnp.sin(ang)[:, :, None, :]
    x1, x2 = x[..., :half], x[..., half:]
    return jnp.concatenate([x1 * cos - x2 * sin, x1 * sin + x2 * cos], axis=-1)


def retention_mixer(q, k, v, g, pos, norm_w):
    Bn, S, _ = q.shape
    C = RET_CHUNK
    N = S // C
    f32 = jnp.float32
    qh = rotary(q.astype(f32).reshape(Bn, S, RET_HEADS, RET_HEAD_K), pos)
    kh = rotary(k.astype(f32).reshape(Bn, S, RET_HEADS, RET_HEAD_K), pos) * (RET_HEAD_K ** -0.5)
    vh = v.astype(f32).reshape(Bn, S, RET_HEADS, RET_HEAD_V)
    log_gamma = jnp.log1p(-jnp.exp2(-5.0 - jnp.arange(RET_HEADS, dtype=f32)))
    idx = jnp.arange(C, dtype=f32)
    rel = idx[:, None] - idx[None, :]
    d_mat = jnp.where(rel >= 0, jnp.exp(log_gamma[:, None, None] * jnp.maximum(rel, 0.0)), 0.0)

    qc = qh.reshape(Bn, N, C, RET_HEADS, RET_HEAD_K)
    kc = kh.reshape(Bn, N, C, RET_HEADS, RET_HEAD_K)
    vc = vh.reshape(Bn, N, C, RET_HEADS, RET_HEAD_V)
    scores = jnp.einsum('bnihd,bnjhd->bnhij', qc, kc) * d_mat
    o_intra = jnp.einsum('bnhij,bnjhv->bnihv', scores, vc)

    q_dec = qc * jnp.exp(log_gamma[None, :] * (idx[:, None] + 1.0))[:, :, None]
    k_dec = kc * jnp.exp(log_gamma[None, :] * (C - 1.0 - idx[:, None]))[:, :, None]
    chunk_decay = jnp.exp(log_gamma * C)[None, :, None, None]

    def step(state, inp):
        qd, kd, vn = inp
        o = jnp.einsum('bchk,bhkv->bchv', qd, state)
        new_state = chunk_decay * state + jnp.einsum('bchk,bchv->bhkv', kd, vn)
        return new_state, o

    state0 = jnp.zeros((Bn, RET_HEADS, RET_HEAD_K, RET_HEAD_V), f32)
    _, o_inter = lax.scan(step, state0, (q_dec.transpose(1, 0, 2, 3, 4),
                                         k_dec.transpose(1, 0, 2, 3, 4),
                                         vc.transpose(1, 0, 2, 3, 4)))
    o = (o_intra + o_inter.transpose(1, 0, 2, 3, 4)).reshape(Bn, S, RET_HEADS, RET_HEAD_V)
    mu = jnp.mean(o, axis=-1, keepdims=True)
    oc = o - mu
    y = oc * lax.rsqrt(jnp.mean(oc * oc, axis=-1, keepdims=True) + EPS)
    y = y * norm_w.astype(f32).reshape(RET_HEADS, RET_HEAD_V)
    y = y.reshape(Bn, S, RET_V_DIM) * jax.nn.silu(g.astype(f32))
    return y.astype(q.dtype)


def setup_inputs(seed: int = 0) -> dict:
    key = jax.random.key(seed)
    ks = jax.random.split(key, 16)
    f32 = jnp.float32

    def dense(k, shape, fan_in):
        return jax.random.normal(k, shape, f32) * (fan_in ** -0.5)

    def gain(k, shape):
        return 1.0 + 0.02 * jax.random.normal(k, shape, f32)

    return {
        "x": jax.random.normal(ks[0], (BATCH, SEQ, D_MODEL), f32),
        "positions": jnp.broadcast_to(jnp.arange(SEQ, dtype=jnp.int32), (BATCH, SEQ)),
        "norm_mix_w": gain(ks[1], (DEPTH, D_MODEL)),
        "norm_ffn_w": gain(ks[2], (DEPTH, D_MODEL)),
        "norm_final_w": gain(ks[3], (D_MODEL,)),
        "even_w_in": dense(ks[4], (N_EVEN, D_MODEL, EVEN_IN), D_MODEL),
        "conv_w": dense(ks[5], (N_EVEN, CONV_WIDTH, CONV_DIM), CONV_WIDTH),
        "hgrn_lb_logits": 0.1 * jax.random.normal(ks[6], (N_EVEN + 1, HGRN_KEY_DIM), f32),
        "hgrn_norm_w": gain(ks[7], (N_EVEN, HGRN_VAL_DIM)),
        "even_w_out": dense(ks[8], (N_EVEN, EVEN_MIX, D_MODEL), EVEN_MIX),
        "odd_w_in": dense(ks[9], (N_ODD, D_MODEL, ODD_IN), D_MODEL),
        "ret_norm_w": gain(ks[10], (N_ODD, RET_V_DIM)),
        "odd_w_out": dense(ks[11], (N_ODD, RET_V_DIM, D_MODEL), RET_V_DIM),
        "ffn_w_in": dense(ks[12], (DEPTH, D_MODEL, 2 * FFN_HIDDEN), D_MODEL),
        "ffn_w_out": dense(ks[13], (DEPTH, FFN_HIDDEN, D_MODEL), FFN_HIDDEN),
    }


def reference(x, positions, norm_mix_w, norm_ffn_w, norm_final_w, even_w_in, conv_w,
              hgrn_lb_logits, hgrn_norm_w, even_w_out, odd_w_in, ret_norm_w, odd_w_out,
              ffn_w_in, ffn_w_out):
    lbs = jnp.cumsum(jax.nn.softmax(hgrn_lb_logits.astype(jnp.float32), axis=0), axis=0)[:N_EVEN]
    even_pts = _split_points(EVEN_SPLITS)
    odd_pts = _split_points(ODD_SPLITS)
    h = x
    for layer in range(DEPTH):
        hn = rmsnorm(h, norm_mix_w[layer])
        if layer % 2 == 0:
            e = layer // 2
            proj = hn @ even_w_in[e]
            a, b, c, q, f, i, g = jnp.split(proj, even_pts, axis=-1)
            y_conv = short_conv_mixer(a, b, c, conv_w[e])
            y_rec = hgrn2_mixer(q, f, i, g, lbs[e], hgrn_norm_w[e])
            mix = jnp.concatenate([y_conv, y_rec], axis=-1) @ even_w_out[e]
        else:
            o = layer // 2
            proj = hn @ odd_w_in[o]
            q, k, v, g = jnp.split(proj, odd_pts, axis=-1)
            mix = retention_mixer(q, k, v, g, positions, ret_norm_w[o]) @ odd_w_out[o]
        h = h + mix
        hn = rmsnorm(h, norm_ffn_w[layer])
        gate, up = jnp.split(hn @ ffn_w_in[layer], 2, axis=-1)
        h = h + (jax.nn.silu(gate) * up) @ ffn_w_out[layer]
    return rmsnorm(h, norm_final_w)
```

```cpp
#include <hip/hip_runtime.h>
#include <cstdio>
#include <cstdint>
namespace pg8 {
#define PG8_LAS __attribute__((address_space(3)))
typedef unsigned short bf16_t;
typedef short bf16x8 __attribute__((ext_vector_type(8)));
typedef float f32x4 __attribute__((ext_vector_type(4)));
typedef unsigned u32x4 __attribute__((ext_vector_type(4)));
constexpr int BM = 256, BK = 64, HALF = 128, HTB = HALF * BK * 2  , STAGE_BYTES = 8 * HTB, NXCD = 8, WGM = 8;

__host__ __device__ __forceinline__ int lds_byte(int r, int c) { const int st = (r >> 4) * 2 + (c >> 5), rr = r & 15, cc = c & 31, ob = rr * 64 + cc * 2; return st * 1024 + (ob ^ (((ob >> 9) & 1) << 5)); }
__host__ __device__ __forceinline__ void stage_rc(int b, int& R, int& C) { const int st = b / 1024, sb = b % 1024, swz = sb ^ (((sb >> 9) & 1) << 5); R = (st >> 1) * 16 + swz / 64; C = (st & 1) * 32 + (swz % 64) / 2; }
__host__ __device__ __forceinline__ int perm32(int rho) { const int n = rho >> 4, i = rho & 15; return 8 * (i >> 2) + 4 * n + (i & 3); }

struct Unit { int pm, pn; };
struct Gemm { const bf16_t* A; const bf16_t* Bt; int M, N, K; };

struct StaticOrder {
    int nM, nN, nwg, G, c;
    __host__ __device__ void init(int M, int N, int G_, int c_) { nM = M / BM; nN = N / BM; nwg = nM * nN; G = G_; c = c_; }
    __host__ __device__ bool next(int i, Unit& u) const {
        const long L = (long)i * G + c; if (L >= nwg) return false;
        int wgid = (int)L; { const int q = nwg / NXCD, r = nwg % NXCD, xcd = wgid % NXCD, off = wgid / NXCD; wgid = (xcd < r ? xcd * (q + 1) : r * (q + 1) + (xcd - r) * q) + off; }
        const int nig = WGM * nN, gid = wgid / nig, fm = gid * WGM, gsz = (nM - fm) < WGM ? (nM - fm) : WGM;
        u.pm = fm + ((wgid % nig) % gsz); u.pn = (wgid % nig) / gsz; return true;
    }
    __device__ __forceinline__ void a_ready(const Unit&) const {}
    __device__ __forceinline__ void done(const Unit&) const {}
};

__device__ __forceinline__ unsigned cvt_pk_bf16(float lo, float hi) { unsigned r; asm volatile("v_cvt_pk_bf16_f32 %0, %1, %2" : "=v"(r) : "v"(lo), "v"(hi)); return r; }
__device__ __forceinline__ float fast_rcp(float x) { return __builtin_amdgcn_rcpf(x); }
__device__ __forceinline__ float fast_exp(float x) { return __builtin_amdgcn_exp2f(x * 1.44269504089f); }
__device__ __forceinline__ float fast_log(float x) { return __builtin_amdgcn_logf(x) * 0.69314718056f; }
__device__ __forceinline__ float silu_f(float x) { return x * fast_rcp(1.0f + fast_exp(-x)); }
__device__ __forceinline__ float sigmoid_f(float x) { return fast_rcp(1.0f + fast_exp(-x)); }
constexpr float RMS_EPS = 1e-6f;
__device__ __forceinline__ float row_rs(const float* part, int row) {
    const f32x4* p = (const f32x4*)(part + (size_t)row * 16);
    const f32x4 a = p[0], b = p[1], c = p[2], d = p[3];
    const float s = ((a[0] + a[1]) + (a[2] + a[3])) + ((b[0] + b[1]) + (b[2] + b[3])) + ((c[0] + c[1]) + (c[2] + c[3])) + ((d[0] + d[1]) + (d[2] + d[3]));
    return 1.0f / sqrtf(s * (1.0f / 1024.0f) + RMS_EPS);
}
__device__ __forceinline__ void store_bf16x8(bf16_t* p, const f32x4 v0, const f32x4 v1) {
    u32x4 w; w.x = cvt_pk_bf16(v0[0], v0[1]); w.y = cvt_pk_bf16(v0[2], v0[3]); w.z = cvt_pk_bf16(v1[0], v1[1]); w.w = cvt_pk_bf16(v1[2], v1[3]);
    *(u32x4*)p = w;
}

struct EpiL0In {
    static constexpr bool PERM = true, AFTER_DRAIN = false;
    const float* part;
    bf16_t *U, *Bb, *SQ, *IV, *SG; float* LOGF; const float* lbl;
    __device__ __forceinline__ void operator()(const f32x4 (&acc)[2][2][4][2], const Unit& u, int wr, int wc, int fr, int fq) const {
        const int row0 = u.pm * BM + wr * 64 + fr, cw = wc * 32 + 8 * fq, pn = u.pn;
        if (pn < 4) {
#pragma unroll
            for (int ai = 0; ai < 2; ++ai)
#pragma unroll
                for (int m = 0; m < 4; ++m) { const int row = row0 + ai * HALF + m * 16; const float r = row_rs(part, row), r2 = r * r;
                    const f32x4 v0 = acc[ai][0][m][0] * acc[ai][1][m][0] * r2, v1 = acc[ai][0][m][1] * acc[ai][1][m][1] * r2;
                    store_bf16x8(U + (size_t)row * 512 + pn * 128 + cw, v0, v1); }
        } else {
            const int seg = (pn - 4) >> 1, cb = ((pn - 4) & 1) * 256;
            float lb[2][8];
            if (seg == 2) {
#pragma unroll
                for (int bj = 0; bj < 2; ++bj)
#pragma unroll
                    for (int e = 0; e < 8; ++e) { const int c = cb + bj * HALF + cw + e; lb[bj][e] = fast_rcp(1.0f + fast_exp(lbl[512 + c] - lbl[c])); }
            }
#pragma unroll
            for (int ai = 0; ai < 2; ++ai)
#pragma unroll
                for (int m = 0; m < 4; ++m) { const int row = row0 + ai * HALF + m * 16; const float r = row_rs(part, row);
#pragma unroll
                    for (int bj = 0; bj < 2; ++bj) { const int col = cb + bj * HALF + cw; f32x4 v0 = acc[ai][bj][m][0] * r, v1 = acc[ai][bj][m][1] * r; const size_t off = (size_t)row * 512 + col;
                        if (seg == 0) store_bf16x8(Bb + off, v0, v1);
                        else if (seg == 1) { _Pragma("unroll") for (int e = 0; e < 4; ++e) { v0[e] = silu_f(v0[e]); v1[e] = silu_f(v1[e]); } store_bf16x8(SQ + off, v0, v1); }
                        else if (seg == 2) { _Pragma("unroll") for (int e = 0; e < 4; ++e) { const float l0 = lb[bj][e], l1 = lb[bj][4 + e];
                                v0[e] = fast_log(l0 + (1.0f - l0) * sigmoid_f(v0[e])); v1[e] = fast_log(l1 + (1.0f - l1) * sigmoid_f(v1[e])); }
                            *(f32x4*)(LOGF + off) = v0; *(f32x4*)(LOGF + off + 4) = v1; }
                        else if (seg == 3) store_bf16x8(IV + off, v0, v1);
                        else { _Pragma("unroll") for (int e = 0; e < 4; ++e) { v0[e] = silu_f(v0[e]); v1[e] = silu_f(v1[e]); } store_bf16x8(SG + off, v0, v1); }
                    } }
        }
    }
};

struct EpiSwiGLU {
    static constexpr bool PERM = true, AFTER_DRAIN = false;
    const float* part; bf16_t* ACT;
    __device__ __forceinline__ void operator()(const f32x4 (&acc)[2][2][4][2], const Unit& u, int wr, int wc, int fr, int fq) const {
        const int row0 = u.pm * BM + wr * 64 + fr, cw = wc * 32 + 8 * fq;
#pragma unroll
        for (int ai = 0; ai < 2; ++ai)
#pragma unroll
            for (int m = 0; m < 4; ++m) { const int row = row0 + ai * HALF + m * 16; const float r = row_rs(part, row);
                f32x4 g0 = acc[ai][0][m][0] * r, g1 = acc[ai][0][m][1] * r; const f32x4 u0 = acc[ai][1][m][0] * r, u1 = acc[ai][1][m][1] * r;
#pragma unroll
                for (int e = 0; e < 4; ++e) { g0[e] = silu_f(g0[e]) * u0[e]; g1[e] = silu_f(g1[e]) * u1[e]; }
                store_bf16x8(ACT + (size_t)row * 2816 + u.pn * 128 + cw, g0, g1); }
    }
};

struct EpiResid {
    static constexpr bool PERM = false, AFTER_DRAIN = false;
    const float* BASE; float* H; bf16_t* HB; float* PART;
    __device__ __forceinline__ void operator()(const f32x4 (&acc)[2][2][4][2], const Unit& u, int wr, int wc, int fr, int fq) const {
        const int row0 = u.pm * BM + wr * 64 + fr, col0 = u.pn * BM + wc * 32 + 4 * fq;
        typedef unsigned u32x2v __attribute__((ext_vector_type(2)));
#pragma unroll
        for (int ai = 0; ai < 2; ++ai)
#pragma unroll
            for (int m = 0; m < 4; ++m) { const int row = row0 + ai * HALF + m * 16; const size_t off = (size_t)row * 1024 + col0; float s = 0.f;
#pragma unroll
                for (int bj = 0; bj < 2; ++bj)
#pragma unroll
                    for (int n = 0; n < 2; ++n) { const size_t o = off + bj * HALF + n * 16; const f32x4 h = *(const f32x4*)(BASE + o) + acc[ai][bj][m][n];
                        *(f32x4*)(H + o) = h; u32x2v w; w.x = cvt_pk_bf16(h[0], h[1]); w.y = cvt_pk_bf16(h[2], h[3]); *(u32x2v*)(HB + o) = w;
                        s += (h[0] * h[0] + h[1] * h[1]) + (h[2] * h[2] + h[3] * h[3]); }
                s += __shfl_xor(s, 16); s += __shfl_xor(s, 32);
                if (fq == 0) PART[(size_t)row * 16 + u.pn * 4 + wc] = s; }
    }
};

struct EpiL1In {
    static constexpr bool PERM = true, AFTER_DRAIN = false;
    const float* part; const int* pos; bf16_t *Q, *Kk, *V, *G;
    __device__ __forceinline__ void operator()(const f32x4 (&acc)[2][2][4][2], const Unit& u, int wr, int wc, int fr, int fq) const {
        const int row0 = u.pm * BM + wr * 64 + fr, cw = wc * 32 + 8 * fq, pn = u.pn;
        if (pn < 8) {
            const int head = pn & 3; bf16_t* O = (pn < 4) ? Q : Kk; const float sc = (pn < 4) ? 1.0f : 0.0625f;
            float fr_rev[8];
#pragma unroll
            for (int e = 0; e < 8; ++e) fr_rev[e] = __builtin_amdgcn_exp2f((float)(cw + e) * (-13.287712379549449f / 128.0f)) * 0.15915494309189535f;
#pragma unroll
            for (int ai = 0; ai < 2; ++ai)
#pragma unroll
                for (int m = 0; m < 4; ++m) { const int row = row0 + ai * HALF + m * 16; const float r = row_rs(part, row) * sc; const float p = (float)pos[row];
                    f32x4 o1[2], o2[2];
#pragma unroll
                    for (int n = 0; n < 2; ++n)
#pragma unroll
                        for (int e = 0; e < 4; ++e) { const float rev = p * fr_rev[4 * n + e]; const float fr_ = rev - floorf(rev);
                            const float sn = __builtin_amdgcn_sinf(fr_), cs = __builtin_amdgcn_cosf(fr_);
                            const float x1 = acc[ai][0][m][n][e] * r, x2 = acc[ai][1][m][n][e] * r;
                            o1[n][e] = x1 * cs - x2 * sn; o2[n][e] = x1 * sn + x2 * cs; }
                    bf16_t* rp = O + (size_t)row * 1024 + head * 256 + cw;
                    store_bf16x8(rp, o1[0], o1[1]); store_bf16x8(rp + 128, o2[0], o2[1]); }
        } else {
            const bool isg = pn >= 16; bf16_t* O = isg ? G : V; const int cb = ((pn - 8) & 7) * 256;
#pragma unroll
            for (int ai = 0; ai < 2; ++ai)
#pragma unroll
                for (int m = 0; m < 4; ++m) { const int row = row0 + ai * HALF + m * 16; const float r = row_rs(part, row);
#pragma unroll
                    for (int bj = 0; bj < 2; ++bj) { f32x4 v0 = acc[ai][bj][m][0] * r, v1 = acc[ai][bj][m][1] * r;
                        if (isg) { _Pragma("unroll") for (int e = 0; e < 4; ++e) { v0[e] = silu_f(v0[e]); v1[e] = silu_f(v1[e]); } }
                        store_bf16x8(O + (size_t)row * 2048 + cb + bj * HALF + cw, v0, v1); } }
        }
    }
};

template <class Epi, class Sched, bool ALIGN_EPI = false, bool SP2 = false>
__device__ __forceinline__ void gemm_phase(PG8_LAS unsigned char* lds, const Gemm g, const Sched& S, const Epi& E) {
    const int tid = threadIdx.x, wid = __builtin_amdgcn_readfirstlane(tid >> 6), lane = tid & 63, wr = wid >> 2, wc = wid & 3, fr = lane & 15, fq = lane >> 4;
    const int K = g.K, nt = K / BK;
    unsigned voffA[2], voffB[2];
#pragma unroll
    for (int i = 0; i < 2; ++i) { int R, C; stage_rc(tid * 16 + i * 8192, R, C); const int Rb = Epi::PERM ? ((R & ~31) + perm32(R & 31)) : R;
        voffA[i] = (unsigned)(R * K + C) * 2u; voffB[i] = (unsigned)(Rb * K + C) * 2u; }
    const size_t kstep = (size_t)(BK * 2);
    const size_t hstep = (size_t)HALF * K * 2;
    const size_t tstep = 2 * hstep;
    const unsigned ldsw = (unsigned)wid * 1024u;
    const int aoff = lds_byte(wr * 64 + fr, fq * 8), boff = lds_byte(wc * 32 + fr, fq * 8);
#define PG8_SA(b, h) (((b) * 2 + (h)) * HTB)
#define PG8_SB(b, h) ((4 + (b) * 2 + (h)) * HTB)
#define PG8_STAGE(bufoff, gbase, voff) do { _Pragma("unroll") for (int _i = 0; _i < 2; ++_i) \
        __builtin_amdgcn_global_load_lds((const unsigned*)((const char*)(gbase) + (voff)[_i]), (PG8_LAS unsigned*)(lds + (bufoff) + ldsw + _i * 8192), 16, 0, 0); } while (0)
#define PG8_LDA(dst, b, h) do { _Pragma("unroll") for (int m = 0; m < 4; ++m) _Pragma("unroll") for (int k = 0; k < 2; ++k) dst[m][k] = *(const PG8_LAS bf16x8*)(lds + PG8_SA(b, h) + aoff + m * 2048 + k * 1024); } while (0)
#define PG8_LDB(dst, b, h) do { _Pragma("unroll") for (int n = 0; n < 2; ++n) _Pragma("unroll") for (int k = 0; k < 2; ++k) dst[n][k] = *(const PG8_LAS bf16x8*)(lds + PG8_SB(b, h) + boff + n * 2048 + k * 1024); } while (0)
#define PG8_MMA(ai, bj, At, Bt) do { __builtin_amdgcn_s_setprio(1); _Pragma("unroll") for (int m = 0; m < 4; ++m) _Pragma("unroll") for (int n = 0; n < 2; ++n) _Pragma("unroll") for (int k = 0; k < 2; ++k) \
        acc[ai][bj][m][n] = __builtin_amdgcn_mfma_f32_16x16x32_bf16(Bt[n][k], At[m][k], acc[ai][bj][m][n], 0, 0, 0); __builtin_amdgcn_s_setprio(0); } while (0)
#define PG8_WAIT_V(n) asm volatile("s_waitcnt vmcnt(" #n ")" ::: "memory")
#define PG8_WAIT_L(n) asm volatile("s_waitcnt lgkmcnt(" #n ")" ::: "memory")
#define PG8_BAR __builtin_amdgcn_s_barrier()
#define PG8_SCHED __builtin_amdgcn_sched_barrier(0)
    Unit cur, nxt; int ui = 0;
    if (!S.next(0, cur)) return;
    f32x4 acc[2][2][4][2];
#pragma unroll
    for (int a = 0; a < 2; ++a)
#pragma unroll
        for (int b = 0; b < 2; ++b)
#pragma unroll
            for (int m = 0; m < 4; ++m)
#pragma unroll
                for (int n = 0; n < 2; ++n) acc[a][b][m][n] = (f32x4){0.f, 0.f, 0.f, 0.f};
    bf16x8 At[4][2], B0[2][2], B1[2][2];
    const char* cA = (const char*)g.A + (size_t)cur.pm * tstep; const char* cB = (const char*)g.Bt + (size_t)cur.pn * tstep;
    S.a_ready(cur);
    if constexpr (SP2) {
        PG8_STAGE(PG8_SB(0, 0), cB, voffB); PG8_STAGE(PG8_SB(0, 1), cB + hstep, voffB); PG8_STAGE(PG8_SA(0, 0), cA, voffA); PG8_STAGE(PG8_SA(0, 1), cA + hstep, voffA);
        if (wr == 1) PG8_BAR;
        PG8_WAIT_V(2); PG8_BAR;
        PG8_STAGE(PG8_SB(1, 0), cB + kstep, voffB); PG8_STAGE(PG8_SA(1, 0), cA + kstep, voffA); PG8_STAGE(PG8_SB(1, 1), cB + hstep + kstep, voffB);
        PG8_WAIT_V(6); PG8_BAR;
    } else {
        PG8_STAGE(PG8_SB(0, 0), cB, voffB); PG8_STAGE(PG8_SA(0, 0), cA, voffA); PG8_STAGE(PG8_SB(0, 1), cB + hstep, voffB); PG8_STAGE(PG8_SA(0, 1), cA + hstep, voffA);
        if (wr == 1) PG8_BAR;
        PG8_WAIT_V(4); PG8_BAR;
        PG8_STAGE(PG8_SB(1, 0), cB + kstep, voffB); PG8_STAGE(PG8_SA(1, 0), cA + kstep, voffA); PG8_STAGE(PG8_SB(1, 1), cB + hstep + kstep, voffB);
        PG8_WAIT_V(6); PG8_BAR;
    }
    for (;;) {
        const bool has_next = S.next(ui + 1, nxt);
        const char* nA = has_next ? (const char*)g.A + (size_t)nxt.pm * tstep : cA; const char* nB = has_next ? (const char*)g.Bt + (size_t)nxt.pn * tstep : cB;
        for (int t = 0; t < nt; t += 2) {
            const bool last = (t == nt - 2);
            const char* a1 = cA + (size_t)(t + 1) * kstep;
            const char* a2 = last ? nA : cA + (size_t)(t + 2) * kstep; const char* b2 = last ? nB : cB + (size_t)(t + 2) * kstep;
            const char* a3 = a2 + kstep; const char* b3 = b2 + kstep;
            if (last && has_next) S.a_ready(nxt);
            if constexpr (SP2) {
            PG8_LDB(B0, 0, 0); PG8_LDB(B1, 0, 1); PG8_SCHED; PG8_LDA(At, 0, 0); PG8_STAGE(PG8_SA(1, 1), a1 + hstep, voffA);
            PG8_WAIT_V(8); PG8_WAIT_L(0); PG8_BAR; PG8_MMA(0, 0, At, B0); PG8_MMA(0, 1, At, B1); PG8_BAR; PG8_SCHED;
            PG8_LDA(At, 0, 1); PG8_STAGE(PG8_SB(0, 0), b2, voffB); PG8_STAGE(PG8_SB(0, 1), b2 + hstep, voffB); PG8_STAGE(PG8_SA(0, 0), a2, voffA);
            PG8_WAIT_V(8); PG8_WAIT_L(0); PG8_BAR; PG8_MMA(1, 0, At, B0); PG8_MMA(1, 1, At, B1); PG8_BAR; PG8_SCHED;
            PG8_LDB(B0, 1, 0); PG8_LDB(B1, 1, 1); PG8_SCHED; PG8_LDA(At, 1, 0); PG8_STAGE(PG8_SA(0, 1), a2 + hstep, voffA);
            PG8_WAIT_V(8); PG8_WAIT_L(0); PG8_BAR; PG8_MMA(0, 0, At, B0); PG8_MMA(0, 1, At, B1); PG8_BAR; PG8_SCHED;
            PG8_LDA(At, 1, 1); PG8_STAGE(PG8_SB(1, 0), b3, voffB); PG8_STAGE(PG8_SB(1, 1), b3 + hstep, voffB); PG8_STAGE(PG8_SA(1, 0), a3, voffA);
            PG8_WAIT_V(8); PG8_WAIT_L(0); PG8_BAR; PG8_MMA(1, 0, At, B0); PG8_MMA(1, 1, At, B1); PG8_BAR; PG8_SCHED;
            } else {
            PG8_LDB(B0, 0, 0); PG8_SCHED; PG8_LDA(At, 0, 0); PG8_STAGE(PG8_SA(1, 1), a1 + hstep, voffA);
            PG8_WAIT_L(8); PG8_BAR; PG8_WAIT_L(0); PG8_MMA(0, 0, At, B0); PG8_BAR; PG8_SCHED;
            PG8_LDB(B1, 0, 1); PG8_STAGE(PG8_SB(0, 0), b2, voffB);
            PG8_BAR; PG8_WAIT_L(0); PG8_MMA(0, 1, At, B1); PG8_BAR;
            PG8_LDA(At, 0, 1); PG8_STAGE(PG8_SA(0, 0), a2, voffA);
            PG8_BAR; PG8_WAIT_L(0); PG8_MMA(1, 0, At, B0); PG8_BAR; PG8_SCHED;
            PG8_STAGE(PG8_SB(0, 1), b2 + hstep, voffB);
            PG8_WAIT_V(6); PG8_BAR; PG8_MMA(1, 1, At, B1); PG8_BAR;
            PG8_LDB(B0, 1, 0); PG8_SCHED; PG8_LDA(At, 1, 0); PG8_STAGE(PG8_SA(0, 1), a2 + hstep, voffA);
            PG8_WAIT_L(8); PG8_BAR; PG8_WAIT_L(0); PG8_MMA(0, 0, At, B0); PG8_BAR; PG8_SCHED;
            PG8_LDB(B1, 1, 1); PG8_STAGE(PG8_SB(1, 0), b3, voffB);
            PG8_BAR; PG8_WAIT_L(0); PG8_MMA(0, 1, At, B1); PG8_BAR;
            PG8_LDA(At, 1, 1); PG8_STAGE(PG8_SA(1, 0), a3, voffA);
            PG8_BAR; PG8_WAIT_L(0); PG8_MMA(1, 0, At, B0); PG8_BAR; PG8_SCHED;
            PG8_STAGE(PG8_SB(1, 1), b3 + hstep, voffB);
            PG8_WAIT_V(6); PG8_BAR; PG8_MMA(1, 1, At, B1); PG8_BAR;
            }
        }
        if constexpr (ALIGN_EPI) { if (wr == 0) PG8_BAR; }
        if constexpr (!Epi::AFTER_DRAIN) { E(acc, cur, wr, wc, fr, fq); S.done(cur); }
        if (!has_next) break;
#pragma unroll
        for (int a = 0; a < 2; ++a)
#pragma unroll
            for (int b = 0; b < 2; ++b)
#pragma unroll
                for (int m = 0; m < 4; ++m)
#pragma unroll
                    for (int n = 0; n < 2; ++n) acc[a][b][m][n] = (f32x4){0.f, 0.f, 0.f, 0.f};
        cur = nxt; cA = nA; cB = nB; ++ui;
        if constexpr (ALIGN_EPI) { if (wr == 1) PG8_BAR; }
    }
    PG8_WAIT_V(0);
    if constexpr (!ALIGN_EPI) { if (wr == 0) PG8_BAR; }
    PG8_BAR;
    if constexpr (Epi::AFTER_DRAIN) { E.fused(acc, cur, wr, wc, fr, fq, lds, wid, lane); S.done(cur); }
#undef PG8_SA
#undef PG8_SB
#undef PG8_STAGE
#undef PG8_LDA
#undef PG8_LDB
#undef PG8_MMA
#undef PG8_WAIT_V
#undef PG8_WAIT_L
#undef PG8_BAR
#undef PG8_SCHED
}
}
#define GAS __attribute__((address_space(1)))
#define LAS __attribute__((address_space(3)))
typedef unsigned short bf16;
typedef unsigned v4u __attribute__((ext_vector_type(4)));
typedef float f32x4 __attribute__((ext_vector_type(4)));
typedef short bf16x8 __attribute__((ext_vector_type(8)));
typedef GAS unsigned gu32;
typedef GAS unsigned long long gu64;
#define RLX_AGENT __ATOMIC_RELAXED, __HIP_MEMORY_SCOPE_AGENT
#define LDS_WAIT() asm volatile("s_waitcnt lgkmcnt(0)" ::: "memory")
#define VM_WAIT() asm volatile("s_waitcnt vmcnt(0)" ::: "memory")
__device__ __forceinline__ unsigned long long rt() { return __builtin_amdgcn_s_memrealtime(); }
__device__ __forceinline__ unsigned f2bf(float f) { unsigned u = __builtin_bit_cast(unsigned, f); return (u + 0x7fffu + ((u >> 16) & 1u)) >> 16; }
__device__ __forceinline__ unsigned pk2(float lo, float hi) { return f2bf(lo) | (f2bf(hi) << 16); }

#define XB_TMO      128
#define XB_XCNT(j)  (256  + 64 * (j))
#define XB_XSUB(j)  (1280 + 64 * (j))
#define XB_XGEN(j)  (2304 + 64 * (j))
#define XB_TOP      3328
#define XB_TOPGEN   3392
#define XCD_BAR_WORDS 3456
#define XB_SPIN_CAP (1u << 18)

__device__ __forceinline__ unsigned xb_ld(unsigned* p)              { return __hip_atomic_load(p, __ATOMIC_RELAXED, __HIP_MEMORY_SCOPE_AGENT); }
__device__ __forceinline__ unsigned xb_add(unsigned* p, unsigned v) { return __hip_atomic_fetch_add(p, v, __ATOMIC_RELAXED, __HIP_MEMORY_SCOPE_AGENT); }
__device__ __forceinline__ unsigned xb_xcc_id() { return (unsigned)__builtin_amdgcn_s_getreg((3 << 11) | 20) & 0xFu; }
#define XB_SPIN(cond, bar) do { unsigned _sp = 0; while (cond) { __builtin_amdgcn_s_sleep(1); \
    if ((++_sp & 255u) == 0u) { if (xb_ld(&(bar)[XB_TMO])) break; if (_sp > XB_SPIN_CAP) { atomicAdd(&(bar)[XB_TMO], 1u); break; } } } } while (0)

struct XcdBarrier {
    unsigned* bar; unsigned x;
    volatile LAS unsigned* st;
};

__device__ __forceinline__ XcdBarrier xcd_barrier_post(unsigned* bar, volatile LAS unsigned* st) {
    XcdBarrier b; b.bar = bar; b.x = xb_xcc_id(); b.st = st;
    if (threadIdx.x == 0) (void)xb_add(&bar[XB_XCNT(b.x)], 1u);
    return b;
}
__device__ __forceinline__ void xcd_barrier_complete(unsigned* bar, unsigned x, unsigned& nloc, unsigned& nx) {
    const unsigned G = gridDim.x * gridDim.y * gridDim.z;
    unsigned sum, cnt, mine, sp = 0u;
    for (;;) {
        sum = 0u; cnt = 0u; mine = 0u;
#pragma unroll
        for (unsigned j = 0; j < 16; ++j) { const unsigned c = xb_ld(&bar[XB_XCNT(j)]); sum += c; cnt += (c > 0u) ? 1u : 0u; mine = (j == x) ? c : mine; }
        if (sum == G) break;
        __builtin_amdgcn_s_sleep(1);
        if ((++sp & 255u) == 0u) { if (xb_ld(&bar[XB_TMO])) break; if (sp > XB_SPIN_CAP) { atomicAdd(&bar[XB_TMO], 1u); break; } }
    }
    nloc = mine > 0u ? mine : 1u; nx = cnt > 0u ? cnt : 1u;
}

__device__ __forceinline__ void xcd_barrier(const XcdBarrier& b) {
    asm volatile("s_waitcnt vmcnt(0)" ::: "memory");
    __syncthreads();
    if (threadIdx.x == 0) {
        unsigned* bar = b.bar;
        __builtin_amdgcn_s_waitcnt(0);
        unsigned nloc = b.st[0], nx = b.st[1];
        if (nloc == 0u) { xcd_barrier_complete(bar, b.x, nloc, nx); b.st[0] = nloc; b.st[1] = nx; }
        const unsigned old = xb_add(&bar[XB_XSUB(b.x)], 1u);
        const unsigned gen = old / nloc;
        if (old + 1u == (gen + 1u) * nloc) {
            __builtin_amdgcn_fence(__ATOMIC_RELEASE, "agent");
            asm volatile("s_waitcnt vmcnt(0)" ::: "memory");
            const unsigned og = xb_add(&bar[XB_TOP], 1u);
            const unsigned tg = og / nx;
            if (og + 1u == (tg + 1u) * nx) xb_add(&bar[XB_TOPGEN], 1u);
            else XB_SPIN(xb_ld(&bar[XB_TOPGEN]) == tg, bar);
            __builtin_amdgcn_fence(__ATOMIC_ACQUIRE, "agent");
            xb_add(&bar[XB_XGEN(b.x)], 1u);
            asm volatile("s_waitcnt vmcnt(0)" ::: "memory");
        } else {
            XB_SPIN(xb_ld(&bar[XB_XGEN(b.x)]) == gen, bar);
            __builtin_amdgcn_fence(__ATOMIC_ACQUIRE, "agent");
            asm volatile("s_waitcnt vmcnt(0)" ::: "memory");
        }
    }
    __syncthreads();
}
constexpr int NWAVES = 8;
using pg8::RMS_EPS;
constexpr int BATCH = 8, SEQ = 2048, D = 1024, M = BATCH * SEQ;
constexpr int EVEN_IN = 3584, ODD_IN = 6144, FFH = 2816, FF2 = 5632;
constexpr int N_PHASES = 13;
#ifndef MK_N_LAUNCHES
#define MK_N_LAUNCHES 13
#endif
constexpr int N_LAUNCHES = MK_N_LAUNCHES;

constexpr size_t MiB = 1u << 20;
constexpr size_t WS_CTL = 0, CTL_ZERO_BYTES = 64 * 1024;
constexpr size_t WS_PART = 1 * MiB;
constexpr size_t WS_W_ODD_IN = 2 * MiB, WS_W_ODD_OUT = 14 * MiB, WS_W_FFN_IN1 = 18 * MiB, WS_W_FFN_OUT1 = 2 * MiB  ;
constexpr size_t WS_HB = 32 * MiB;
constexpr size_t WS_W_EVEN_IN = 64 * MiB, WS_W_EVEN_OUT = 71 * MiB, WS_W_FFN_IN0 = 73 * MiB, WS_W_FFN_OUT0 = 84 * MiB;
constexpr size_t WS_U = 96 * MiB, WS_BB = 112 * MiB, WS_SQ = 128 * MiB, WS_LOGF = 144 * MiB, WS_IV = 176 * MiB, WS_SG0 = 192 * MiB, WS_MIX0 = 208 * MiB;
constexpr size_t WS_ACT0 = 96 * MiB;
constexpr size_t WS_Q = 64 * MiB, WS_K = 96 * MiB, WS_V = 128 * MiB, WS_G = 192 * MiB;
constexpr size_t WS_ACT1 = 64 * MiB;
constexpr size_t WS_END = 256 * MiB;
constexpr int CW_BAR = 4096;

constexpr int RING_OFF = 0, RING_BYTES = 131072;
constexpr int LDSCTL_OFF = RING_BYTES, MISC_OFF = LDSCTL_OFF + 320;
constexpr int LDS_BYTES = 147456;

__device__ __forceinline__ float bf2f(unsigned short u) { return __builtin_bit_cast(float, (unsigned)u << 16); }
__device__ __forceinline__ float bflo(unsigned u) { return __builtin_bit_cast(float, u << 16); }
__device__ __forceinline__ float bfhi(unsigned u) { return __builtin_bit_cast(float, u & 0xffff0000u); }
__device__ __forceinline__ float wave_sum(float v) {
#pragma unroll
    for (int o = 1; o < 64; o <<= 1) v += __shfl_xor(v, o);
    return v;
}

struct Args { const float* in[15]; float* out; unsigned char* ws; int ph_lo, ph_hi, li, pad; };

struct MatDesc { const float* W; int K, N; bf16* WT; const float* scale; int scale_from; int map; };
__device__ __forceinline__ int map_col(int map, int n) {
    if (map == 1) { const int seg = n >> 9, c = n & 511; if (seg == 0) return 256 * (c >> 7) + (c & 127); if (seg == 2) return 256 * (c >> 7) + 128 + (c & 127); if (seg == 1) return 1024 + c; return n; }
    if (map == 2) { if (n < FFH) return 256 * (n >> 7) + (n & 127); const int c = n - FFH; return 256 * (c >> 7) + 128 + (c & 127); }
    return n;
}
__device__ __forceinline__ void transpose_item(const MatDesc& md, LAS float* scr, int item, int lane) {
    const int N = md.N, K = md.K, nblk = N / 32, kb = item / nblk, nb = item % nblk, k0 = 64 * kb, n0 = 32 * nb;
#pragma unroll 8
    for (int i = 0; i < 32; ++i) { const int kk = 2 * i + (lane >> 5); const int k = k0 + kk; float w = md.W[(size_t)k * N + n0 + (lane & 31)];
        if (md.scale && k >= md.scale_from) w *= md.scale[k - md.scale_from];
        scr[kk * 33 + (lane & 31)] = w; }
    LDS_WAIT(); asm volatile("" ::: "memory");
    const int c = lane & 7; const int d0 = map_col(md.map, n0);
#pragma unroll
    for (int j = 0; j < 4; ++j) { const int n = (lane >> 3) + 8 * j; const LAS float* s = scr + (8 * c) * 33 + n;
        v4u o; o.x = pk2(s[0 * 33], s[1 * 33]); o.y = pk2(s[2 * 33], s[3 * 33]); o.z = pk2(s[4 * 33], s[5 * 33]); o.w = pk2(s[6 * 33], s[7 * 33]);
        *(GAS v4u*)(md.WT + (size_t)(d0 + n) * K + k0 + 8 * c) = o; }
    LDS_WAIT(); asm volatile("" ::: "memory");
}
__device__ __forceinline__ MatDesc mat_desc(const Args& a, int mat) {
    unsigned char* ws = a.ws; MatDesc d;
    switch (mat) {
    case 0: d = MatDesc{a.in[5], D, EVEN_IN, (bf16*)(ws + WS_W_EVEN_IN), a.in[2], 0, 1}; break;
    case 1: d = MatDesc{a.in[9], D, D, (bf16*)(ws + WS_W_EVEN_OUT), a.in[8], 512, 0}; break;
    case 2: d = MatDesc{a.in[13], D, FF2, (bf16*)(ws + WS_W_FFN_IN0), a.in[3], 0, 2}; break;
    case 3: d = MatDesc{a.in[14], FFH, D, (bf16*)(ws + WS_W_FFN_OUT0), nullptr, 0, 0}; break;
    case 4: d = MatDesc{a.in[10], D, ODD_IN, (bf16*)(ws + WS_W_ODD_IN), a.in[2] + D, 0, 0}; break;
    case 5: d = MatDesc{a.in[12], 2048, D, (bf16*)(ws + WS_W_ODD_OUT), a.in[11], 0, 0}; break;
    case 6: d = MatDesc{a.in[13] + (size_t)D * FF2, D, FF2, (bf16*)(ws + WS_W_FFN_IN1), a.in[3] + D, 0, 2}; break;
    default: d = MatDesc{a.in[14] + (size_t)FFH * D, FFH, D, (bf16*)(ws + WS_W_FFN_OUT1), nullptr, 0, 0}; break;
    }
    return d;
}
__device__ __forceinline__ void convert_mats(const Args& a, int mat_lo, int mat_hi, LAS float* scr, int gw, int NGW, int lane) {
    for (int mat = mat_lo; mat < mat_hi; ++mat) { const MatDesc md = mat_desc(a, mat); const int nitems = (md.K / 64) * (md.N / 32);
        for (int it = gw; it < nitems; it += NGW) transpose_item(md, scr, it, lane); }
}
__device__ __forceinline__ void x_row_prep(const float* xrow, bf16* orow, float* prow, int lane) {
    const GAS f32x4* xr = (const GAS f32x4*)xrow + lane; f32x4 v[4]; float s = 0.f;
#pragma unroll
    for (int j = 0; j < 4; ++j) { v[j] = xr[64 * j]; s += (v[j].x * v[j].x + v[j].y * v[j].y) + (v[j].z * v[j].z + v[j].w * v[j].w); }
    s = wave_sum(s);
    GAS unsigned long long* o8 = (GAS unsigned long long*)orow + lane;
#pragma unroll
    for (int j = 0; j < 4; ++j) o8[64 * j] = (unsigned long long)pk2(v[j].x, v[j].y) | ((unsigned long long)pk2(v[j].z, v[j].w) << 32);
    if (lane < 16) prow[lane] = (lane == 0) ? s : 0.f;
}

template <bool HGRN> __device__ __forceinline__ void scan_naive(LAS unsigned char* lds, const Args& a, int unit) {
    constexpr int DK = HGRN ? 128 : 256, DVS = HGRN ? 128 : 64, KP = 512 / DVS, TB = 16;
    static_assert(DK / KP == 32, "32 k per thread");
    LAS float* qL = (LAS float*)lds; LAS float* kL = qL + TB * DK; LAS float* fL = kL + TB * DK; LAS float* vL = fL + (HGRN ? TB * DK : 0); LAS float* parts = vL + TB * DVS;
    unsigned char* ws = a.ws;
    const int tid = threadIdx.x, lane = tid & 63, wave = tid >> 6, v = tid % DVS, kp = tid / DVS;
    int b, h, vs; if (HGRN) { b = unit >> 2; h = unit & 3; vs = 0; } else { b = unit >> 5; h = (unit >> 3) & 3; vs = unit & 7; }
    const float gam = 1.0f - exp2f(-5.0f - (float)h);
    const bf16* Qp = HGRN ? (const bf16*)(ws + WS_SQ) + h * 128 : (const bf16*)(ws + WS_Q) + h * 256;
    const bf16* Kp = (const bf16*)(ws + WS_K) + h * 256;
    const float* Lp = (const float*)(ws + WS_LOGF) + h * 128;
    bf16* Vp = HGRN ? (bf16*)(ws + WS_IV) + h * 128 : (bf16*)(ws + WS_V) + h * 512 + vs * 64;
    const int qld = HGRN ? 512 : 1024, vld = HGRN ? 512 : 2048;
    float S[32];
#pragma unroll
    for (int j = 0; j < 32; ++j) S[j] = 0.f;
    for (int t0 = 0; t0 < SEQ; t0 += TB) {
        const size_t rowb = (size_t)b * SEQ + t0;
        for (int idx = tid; idx < TB * DK; idx += 512) { const int t = idx / DK, k = idx % DK; const size_t row = rowb + t;
            qL[idx] = bf2f(Qp[row * qld + k]);
            if (HGRN) { const float f = expf(Lp[row * 512 + k]); fL[idx] = f; kL[idx] = 1.0f - f; } else kL[idx] = bf2f(Kp[row * 1024 + k]); }
        for (int idx = tid; idx < TB * DVS; idx += 512) { const int t = idx / DVS, vv = idx % DVS; vL[idx] = bf2f(Vp[(rowb + t) * vld + vv]); }
        __syncthreads();
        for (int t = 0; t < TB; ++t) { const float vt = vL[t * DVS + v]; float op = 0.f;
#pragma unroll
            for (int j4 = 0; j4 < 8; ++j4) { const f32x4 q4 = *(const LAS f32x4*)(qL + t * DK + kp * 32 + 4 * j4), k4 = *(const LAS f32x4*)(kL + t * DK + kp * 32 + 4 * j4);
                f32x4 f4 = (f32x4){gam, gam, gam, gam}; if (HGRN) f4 = *(const LAS f32x4*)(fL + t * DK + kp * 32 + 4 * j4);
#pragma unroll
                for (int e = 0; e < 4; ++e) { S[4 * j4 + e] = f4[e] * S[4 * j4 + e] + k4[e] * vt; op += q4[e] * S[4 * j4 + e]; } }
            parts[(kp * TB + t) * DVS + v] = op; }
        __syncthreads();
#pragma unroll
        for (int tt = 0; tt < 2; ++tt) { const int t = 2 * wave + tt; const size_t row = rowb + t;
            if (HGRN) { float o0 = 0.f, o1 = 0.f;
#pragma unroll
                for (int p = 0; p < KP; ++p) { o0 += parts[(p * TB + t) * DVS + lane]; o1 += parts[(p * TB + t) * DVS + lane + 64]; }
                const float ss = wave_sum(o0 * o0 + o1 * o1); const float rstd = 1.0f / sqrtf(ss * (1.0f / 128.0f) + RMS_EPS);
                const bf16* sg = (const bf16*)(ws + WS_SG0) + row * 512 + h * 128; bf16* mo = (bf16*)(ws + WS_MIX0) + row * 1024 + 512 + h * 128;
                mo[lane] = (bf16)f2bf(o0 * rstd * bf2f(sg[lane])); mo[lane + 64] = (bf16)f2bf(o1 * rstd * bf2f(sg[lane + 64]));
            } else { float o = 0.f;
#pragma unroll
                for (int p = 0; p < KP; ++p) o += parts[(p * TB + t) * DVS + lane];
                Vp[row * vld + lane] = (bf16)f2bf(o); } }
    }
    __syncthreads();
}

__global__ void __launch_bounds__(NWAVES * 64, 2) fwd_kernel(Args args) {
    extern __shared__ __attribute__((aligned(16))) unsigned char lds_raw[];
    LAS unsigned char* lds = (LAS unsigned char*)lds_raw;
    volatile LAS unsigned* MISC = (volatile LAS unsigned*)(lds + MISC_OFF);
    const int tid = threadIdx.x, lane = tid & 63, wave = __builtin_amdgcn_readfirstlane(tid >> 6);
    const int G = gridDim.x; const int bx = blockIdx.x; const int vcu = (G % 8 == 0) ? (bx % 8) * (G / 8) + bx / 8 : bx;
    unsigned char* ws = args.ws;
    gu32* ctl = (gu32*)(ws + WS_CTL);
    for (int u = tid; u < (LDS_BYTES - LDSCTL_OFF) / 4; u += NWAVES * 64) ((LAS unsigned*)(lds + LDSCTL_OFF))[u] = 0u;
    __syncthreads();
    XcdBarrier bar; bar.bar = (unsigned*)(ctl + CW_BAR); bar.x = 0; bar.st = nullptr;
    if (N_LAUNCHES == 1) bar = xcd_barrier_post((unsigned*)(ctl + CW_BAR), MISC + 8);
#define GRID_BAR() do { if (N_LAUNCHES == 1) xcd_barrier(bar); } while (0)
    const int lo = args.ph_lo, hi = args.ph_hi;
#define IN(k) (lo <= (k) && (k) < hi)
#define BOTH(k) (IN(k) && IN((k) + 1))
    const int gw = vcu * NWAVES + wave, NGW = G * NWAVES;
    float* PART = (float*)(ws + WS_PART);
    bf16* HB = (bf16*)(ws + WS_HB);
    const float* x = args.in[0];

    if (IN(0)) {
        LAS float* scr = (LAS float*)(lds + RING_OFF + wave * 16384);
        convert_mats(args, 0, 7, scr, gw, NGW, lane);
        for (int m = gw; m < M; m += NGW) x_row_prep(x + (size_t)m * D, HB + (size_t)m * D, PART + (size_t)m * 16, lane);
        if (BOTH(0)) GRID_BAR();
    }
    if (IN(1)) {
        pg8::Gemm g{HB, (const bf16*)(ws + WS_W_EVEN_IN), M, EVEN_IN, D}; pg8::StaticOrder S; S.init(M, EVEN_IN, G, bx);
        pg8::EpiL0In E{PART, (bf16*)(ws + WS_U), (bf16*)(ws + WS_BB), (bf16*)(ws + WS_SQ), (bf16*)(ws + WS_IV), (bf16*)(ws + WS_SG0), (float*)(ws + WS_LOGF), args.in[7]};
        pg8::gemm_phase<pg8::EpiL0In, pg8::StaticOrder, true, true>(lds + RING_OFF, g, S, E);
        if (BOTH(1)) GRID_BAR();
    }
    if (IN(2)) {
        for (int u = bx; u < 32; u += G) scan_naive<true>(lds, args, u);
        { int cb, ncb; if (G > 32) { cb = bx - 32; ncb = G - 32; } else { cb = bx; ncb = G; }
          if (cb >= 0) { const bf16* U = (const bf16*)(ws + WS_U); const bf16* Bb = (const bf16*)(ws + WS_BB); bf16* MIX = (bf16*)(ws + WS_MIX0); const float* cw = args.in[6];
            for (int it = cb * 512 + tid; it < M * 64; it += ncb * 512) { const int row = it >> 6, c0 = (it & 63) * 8, t = row & (SEQ - 1);
                const v4u u0 = *(const GAS v4u*)(U + (size_t)row * 512 + c0); v4u u1 = (v4u){0u, 0u, 0u, 0u}, u2 = u1;
                if (t >= 1) u1 = *(const GAS v4u*)(U + (size_t)(row - 1) * 512 + c0);
                if (t >= 2) u2 = *(const GAS v4u*)(U + (size_t)(row - 2) * 512 + c0);
                const v4u bb = *(const GAS v4u*)(Bb + (size_t)row * 512 + c0);
                float y[8];
#pragma unroll
                for (int p = 0; p < 4; ++p) { const int c = c0 + 2 * p;
                    y[2 * p] = bflo(bb[p]) * (cw[c] * bflo(u2[p]) + cw[512 + c] * bflo(u1[p]) + cw[1024 + c] * bflo(u0[p]));
                    y[2 * p + 1] = bfhi(bb[p]) * (cw[c + 1] * bfhi(u2[p]) + cw[512 + c + 1] * bfhi(u1[p]) + cw[1024 + c + 1] * bfhi(u0[p])); }
                v4u o; o.x = pk2(y[0], y[1]); o.y = pk2(y[2], y[3]); o.z = pk2(y[4], y[5]); o.w = pk2(y[6], y[7]);
                *(GAS v4u*)(MIX + (size_t)row * 1024 + c0) = o; } } }
        if (BOTH(2)) GRID_BAR();
    }
    if (IN(3)) {
        pg8::Gemm g{(const bf16*)(ws + WS_MIX0), (const bf16*)(ws + WS_W_EVEN_OUT), M, D, D}; pg8::StaticOrder S; S.init(M, D, G, bx);
        pg8::EpiResid E{x, args.out, HB, PART};
        pg8::gemm_phase<pg8::EpiResid, pg8::StaticOrder, true, true>(lds + RING_OFF, g, S, E);
        if (BOTH(3)) GRID_BAR();
    }
    if (IN(4)) {
        pg8::Gemm g{HB, (const bf16*)(ws + WS_W_FFN_IN0), M, FF2, D}; pg8::StaticOrder S; S.init(M, FF2, G, bx);
        pg8::EpiSwiGLU E{PART, (bf16*)(ws + WS_ACT0)};
        pg8::gemm_phase<pg8::EpiSwiGLU, pg8::StaticOrder, true, true>(lds + RING_OFF, g, S, E);
        if (BOTH(4)) GRID_BAR();
    }
    if (IN(5)) {
        pg8::Gemm g{(const bf16*)(ws + WS_ACT0), (const bf16*)(ws + WS_W_FFN_OUT0), M, D, FFH}; pg8::StaticOrder S; S.init(M, D, G, bx);
        pg8::EpiResid E{args.out, args.out, HB, PART};
        pg8::gemm_phase<pg8::EpiResid, pg8::StaticOrder, true, true>(lds + RING_OFF, g, S, E);
        if (BOTH(5)) GRID_BAR();
    }
    if (IN(6)) {
        pg8::Gemm g{HB, (const bf16*)(ws + WS_W_ODD_IN), M, ODD_IN, D}; pg8::StaticOrder S; S.init(M, ODD_IN, G, bx);
        pg8::EpiL1In E{PART, (const int*)args.in[1], (bf16*)(ws + WS_Q), (bf16*)(ws + WS_K), (bf16*)(ws + WS_V), (bf16*)(ws + WS_G)};
        pg8::gemm_phase<pg8::EpiL1In, pg8::StaticOrder, true, true>(lds + RING_OFF, g, S, E);
        if (BOTH(6)) GRID_BAR();
    }
    if (IN(7)) {
        for (int u = bx; u < 256; u += G) scan_naive<false>(lds, args, u);
        if (BOTH(7)) GRID_BAR();
    }
    if (IN(8)) {
        LAS float* scr = (LAS float*)(lds + RING_OFF + wave * 16384);
        convert_mats(args, 7, 8, scr, gw, NGW, lane);
        const bf16* O = (const bf16*)(ws + WS_V); bf16* Gp = (bf16*)(ws + WS_G);
        for (int it = gw; it < M * 4; it += NGW) { const size_t off = (size_t)(it >> 2) * 2048 + (it & 3) * 512 + lane * 8;
            const v4u ov = *(const GAS v4u*)(O + off); const v4u gv = *(const GAS v4u*)(Gp + off);
            float o[8]; float s = 0.f;
#pragma unroll
            for (int p = 0; p < 4; ++p) { o[2 * p] = bflo(ov[p]); o[2 * p + 1] = bfhi(ov[p]); s += o[2 * p] + o[2 * p + 1]; }
            const float mu = wave_sum(s) * (1.0f / 512.0f); float q = 0.f;
#pragma unroll
            for (int e = 0; e < 8; ++e) { o[e] -= mu; q += o[e] * o[e]; }
            const float rstd = 1.0f / sqrtf(wave_sum(q) * (1.0f / 512.0f) + RMS_EPS);
            v4u w;
#pragma unroll
            for (int p = 0; p < 4; ++p) w[p] = pk2(o[2 * p] * rstd * bflo(gv[p]), o[2 * p + 1] * rstd * bfhi(gv[p]));
            *(GAS v4u*)(Gp + off) = w; }
        if (BOTH(8)) GRID_BAR();
    }
    if (IN(9)) {
        pg8::Gemm g{(const bf16*)(ws + WS_G), (const bf16*)(ws + WS_W_ODD_OUT), M, D, 2048}; pg8::StaticOrder S; S.init(M, D, G, bx);
        pg8::EpiResid E{args.out, args.out, HB, PART};
        pg8::gemm_phase<pg8::EpiResid, pg8::StaticOrder, true, true>(lds + RING_OFF, g, S, E);
        if (BOTH(9)) GRID_BAR();
    }
    if (IN(10)) {
        pg8::Gemm g{HB, (const bf16*)(ws + WS_W_FFN_IN1), M, FF2, D}; pg8::StaticOrder S; S.init(M, FF2, G, bx);
        pg8::EpiSwiGLU E{PART, (bf16*)(ws + WS_ACT1)};
        pg8::gemm_phase<pg8::EpiSwiGLU, pg8::StaticOrder, true, true>(lds + RING_OFF, g, S, E);
        if (BOTH(10)) GRID_BAR();
    }
    if (IN(11)) {
        pg8::Gemm g{(const bf16*)(ws + WS_ACT1), (const bf16*)(ws + WS_W_FFN_OUT1), M, D, FFH}; pg8::StaticOrder S; S.init(M, D, G, bx);
        pg8::EpiResid E{args.out, args.out, HB, PART};
        pg8::gemm_phase<pg8::EpiResid, pg8::StaticOrder, true, true>(lds + RING_OFF, g, S, E);
        if (BOTH(11)) GRID_BAR();
    }
    if (IN(12)) {
        const float* wf = args.in[4];
        for (int m = gw; m < M; m += NGW) { GAS f32x4* hr = (GAS f32x4*)(args.out + (size_t)m * D) + lane; f32x4 v[4]; float s = 0.f;
#pragma unroll
            for (int j = 0; j < 4; ++j) { v[j] = hr[64 * j]; s += (v[j].x * v[j].x + v[j].y * v[j].y) + (v[j].z * v[j].z + v[j].w * v[j].w); }
            const float rs = 1.0f / sqrtf(wave_sum(s) * (1.0f / 1024.0f) + RMS_EPS);
#pragma unroll
            for (int j = 0; j < 4; ++j) { const f32x4 w = *((const GAS f32x4*)wf + lane + 64 * j); hr[64 * j] = v[j] * rs * w; } }
    }
#undef IN
#undef BOTH
#undef GRID_BAR
}

extern "C" void kernel_launch(void* const* d_in, const int* in_sizes, int n_in, void* d_out, int out_size, void* d_ws, size_t ws_size, hipStream_t stream) {
    static int grid = 0;
    if (grid == 0) {
        if (n_in != 15 || in_sizes[0] != M * D || out_size != M * D || ws_size < WS_END) { fprintf(stderr, "kernel_launch: unexpected problem shape (n_in %d, in0 %d, out %d, ws %zu); nothing launched\n", n_in, n_in > 0 ? in_sizes[0] : -1, out_size, ws_size); grid = -1; return; }
        int dev = 0, cus = 0, per_cu = 0;
        if (hipGetDevice(&dev) != hipSuccess || hipDeviceGetAttribute(&cus, hipDeviceAttributeMultiprocessorCount, dev) != hipSuccess) { grid = -1; return; }
        if (hipFuncSetAttribute((const void*)fwd_kernel, hipFuncAttributeMaxDynamicSharedMemorySize, LDS_BYTES) != hipSuccess) { fprintf(stderr, "kernel_launch: hipFuncSetAttribute failed\n"); grid = -1; return; }
        if (hipOccupancyMaxActiveBlocksPerMultiprocessor(&per_cu, (const void*)fwd_kernel, NWAVES * 64, LDS_BYTES) != hipSuccess || per_cu < 1)
            fprintf(stderr, "kernel_launch: note: occupancy query reports %d workgroups per CU\n", per_cu);
        (void)hipGetLastError();
        grid = cus;
    }
    if (grid < 0) return;
    if (hipMemsetAsync((char*)d_ws + WS_CTL, 0, CTL_ZERO_BYTES, stream) != hipSuccess) { fprintf(stderr, "kernel_launch: hipMemsetAsync failed\n"); return; }
    Args a{};
    for (int i = 0; i < 15; ++i) a.in[i] = (const float*)d_in[i];
    a.out = (float*)d_out; a.ws = (unsigned char*)d_ws;
    for (int li = 0; li < N_LAUNCHES; ++li) {
        if (N_LAUNCHES == 1) { a.ph_lo = 0; a.ph_hi = N_PHASES; } else { a.ph_lo = li; a.ph_hi = li + 1; }
        a.li = li;
        hipLaunchKernelGGL(fwd_kernel, dim3(grid), dim3(NWAVES * 64), LDS_BYTES, stream, a);
        const hipError_t le = hipPeekAtLastError();
        if (le != hipSuccess) { fprintf(stderr, "kernel_launch: launch %d failed: %s\n", li, hipGetErrorName(le)); break; }
    }
}
```

```cpp
#include <hip/hip_runtime.h>
#include <cstdio>
#include <cstdint>
namespace pg8 {
#define PG8_LAS __attribute__((address_space(3)))
typedef unsigned short bf16_t;
typedef short bf16x8 __attribute__((ext_vector_type(8)));
typedef float f32x4 __attribute__((ext_vector_type(4)));
typedef unsigned u32x4 __attribute__((ext_vector_type(4)));
constexpr int BM = 256, BK = 64, HALF = 128, HTB = HALF * BK * 2  , STAGE_BYTES = 8 * HTB, NXCD = 8, WGM = 8;

__host__ __device__ __forceinline__ int lds_byte(int r, int c) { const int st = (r >> 4) * 2 + (c >> 5), rr = r & 15, cc = c & 31, ob = rr * 64 + cc * 2; return st * 1024 + (ob ^ (((ob >> 9) & 1) << 5)); }
__host__ __device__ __forceinline__ void stage_rc(int b, int& R, int& C) { const int st = b / 1024, sb = b % 1024, swz = sb ^ (((sb >> 9) & 1) << 5); R = (st >> 1) * 16 + swz / 64; C = (st & 1) * 32 + (swz % 64) / 2; }
__host__ __device__ __forceinline__ int perm32(int rho) { const int n = rho >> 4, i = rho & 15; return 8 * (i >> 2) + 4 * n + (i & 3); }

struct Unit { int pm, pn; };
struct Gemm { const bf16_t* A; const bf16_t* Bt; int M, N, K; };

struct StaticOrder {
    int nM, nN, nwg, G, c;
    __host__ __device__ void init(int M, int N, int G_, int c_) { nM = M / BM; nN = N / BM; nwg = nM * nN; G = G_; c = c_; }
    __host__ __device__ bool next(int i, Unit& u) const {
        const long L = (long)i * G + c; if (L >= nwg) return false;
        int wgid = (int)L; { const int q = nwg / NXCD, r = nwg % NXCD, xcd = wgid % NXCD, off = wgid / NXCD; wgid = (xcd < r ? xcd * (q + 1) : r * (q + 1) + (xcd - r) * q) + off; }
        const int nig = WGM * nN, gid = wgid / nig, fm = gid * WGM, gsz = (nM - fm) < WGM ? (nM - fm) : WGM;
        u.pm = fm + ((wgid % nig) % gsz); u.pn = (wgid % nig) / gsz; return true;
    }
    __device__ __forceinline__ void a_ready(const Unit&) const {}
    __device__ __forceinline__ void done(const Unit&) const {}
};

__device__ __forceinline__ unsigned cvt_pk_bf16(float lo, float hi) { unsigned r; asm volatile("v_cvt_pk_bf16_f32 %0, %1, %2" : "=v"(r) : "v"(lo), "v"(hi)); return r; }
__device__ __forceinline__ float fast_rcp(float x) { return __builtin_amdgcn_rcpf(x); }
__device__ __forceinline__ float fast_exp(float x) { return __builtin_amdgcn_exp2f(x * 1.44269504089f); }
__device__ __forceinline__ float fast_log(float x) { return __builtin_amdgcn_logf(x) * 0.69314718056f; }
__device__ __forceinline__ float silu_f(float x) { return x * fast_rcp(1.0f + fast_exp(-x)); }
__device__ __forceinline__ float sigmoid_f(float x) { return fast_rcp(1.0f + fast_exp(-x)); }
constexpr float RMS_EPS = 1e-6f;
__device__ __forceinline__ float row_rs(const float* part, int row) {
    const f32x4* p = (const f32x4*)(part + (size_t)row * 16);
    const f32x4 a = p[0], b = p[1], c = p[2], d = p[3];
    const float s = ((a[0] + a[1]) + (a[2] + a[3])) + ((b[0] + b[1]) + (b[2] + b[3])) + ((c[0] + c[1]) + (c[2] + c[3])) + ((d[0] + d[1]) + (d[2] + d[3]));
    return 1.0f / sqrtf(s * (1.0f / 1024.0f) + RMS_EPS);
}
__device__ __forceinline__ void store_bf16x8(bf16_t* p, const f32x4 v0, const f32x4 v1) {
    u32x4 w; w.x = cvt_pk_bf16(v0[0], v0[1]); w.y = cvt_pk_bf16(v0[2], v0[3]); w.z = cvt_pk_bf16(v1[0], v1[1]); w.w = cvt_pk_bf16(v1[2], v1[3]);
    *(u32x4*)p = w;
}

struct EpiL0In {
    static constexpr bool PERM = true, AFTER_DRAIN = false;
    const float* part;
    bf16_t *U, *Bb, *SQ, *IV, *SG; float* LOGF; const float* lbl;
    __device__ __forceinline__ void operator()(const f32x4 (&acc)[2][2][4][2], const Unit& u, int wr, int wc, int fr, int fq) const {
        const int row0 = u.pm * BM + wr * 64 + fr, cw = wc * 32 + 8 * fq, pn = u.pn;
        if (pn < 4) {
#pragma unroll
            for (int ai = 0; ai < 2; ++ai)
#pragma unroll
                for (int m = 0; m < 4; ++m) { const int row = row0 + ai * HALF + m * 16; const float r = row_rs(part, row), r2 = r * r;
                    const f32x4 v0 = acc[ai][0][m][0] * acc[ai][1][m][0] * r2, v1 = acc[ai][0][m][1] * acc[ai][1][m][1] * r2;
                    store_bf16x8(U + (size_t)row * 512 + pn * 128 + cw, v0, v1); }
        } else {
            const int seg = (pn - 4) >> 1, cb = ((pn - 4) & 1) * 256;
            float lb[2][8];
            if (seg == 2) {
#pragma unroll
                for (int bj = 0; bj < 2; ++bj)
#pragma unroll
                    for (int e = 0; e < 8; ++e) { const int c = cb + bj * HALF + cw + e; lb[bj][e] = fast_rcp(1.0f + fast_exp(lbl[512 + c] - lbl[c])); }
            }
#pragma unroll
            for (int ai = 0; ai < 2; ++ai)
#pragma unroll
                for (int m = 0; m < 4; ++m) { const int row = row0 + ai * HALF + m * 16; const float r = row_rs(part, row);
#pragma unroll
                    for (int bj = 0; bj < 2; ++bj) { const int col = cb + bj * HALF + cw; f32x4 v0 = acc[ai][bj][m][0] * r, v1 = acc[ai][bj][m][1] * r; const size_t off = (size_t)row * 512 + col;
                        if (seg == 0) store_bf16x8(Bb + off, v0, v1);
                        else if (seg == 1) { _Pragma("unroll") for (int e = 0; e < 4; ++e) { v0[e] = silu_f(v0[e]); v1[e] = silu_f(v1[e]); } store_bf16x8(SQ + off, v0, v1); }
                        else if (seg == 2) { _Pragma("unroll") for (int e = 0; e < 4; ++e) { const float l0 = lb[bj][e], l1 = lb[bj][4 + e];
                                v0[e] = fast_log(l0 + (1.0f - l0) * sigmoid_f(v0[e])); v1[e] = fast_log(l1 + (1.0f - l1) * sigmoid_f(v1[e])); }
                            *(f32x4*)(LOGF + off) = v0; *(f32x4*)(LOGF + off + 4) = v1; }
                        else if (seg == 3) store_bf16x8(IV + off, v0, v1);
                        else { _Pragma("unroll") for (int e = 0; e < 4; ++e) { v0[e] = silu_f(v0[e]); v1[e] = silu_f(v1[e]); } store_bf16x8(SG + off, v0, v1); }
                    } }
        }
    }
};

struct EpiSwiGLU {
    static constexpr bool PERM = true, AFTER_DRAIN = false;
    const float* part; bf16_t* ACT;
    __device__ __forceinline__ void operator()(const f32x4 (&acc)[2][2][4][2], const Unit& u, int wr, int wc, int fr, int fq) const {
        const int row0 = u.pm * BM + wr * 64 + fr, cw = wc * 32 + 8 * fq;
#pragma unroll
        for (int ai = 0; ai < 2; ++ai)
#pragma unroll
            for (int m = 0; m < 4; ++m) { const int row = row0 + ai * HALF + m * 16; const float r = row_rs(part, row);
                f32x4 g0 = acc[ai][0][m][0] * r, g1 = acc[ai][0][m][1] * r; const f32x4 u0 = acc[ai][1][m][0] * r, u1 = acc[ai][1][m][1] * r;
#pragma unroll
                for (int e = 0; e < 4; ++e) { g0[e] = silu_f(g0[e]) * u0[e]; g1[e] = silu_f(g1[e]) * u1[e]; }
                store_bf16x8(ACT + (size_t)row * 2816 + u.pn * 128 + cw, g0, g1); }
    }
};

struct EpiResid {
    static constexpr bool PERM = false, AFTER_DRAIN = false;
    const float* BASE; float* H; bf16_t* HB; float* PART;
    __device__ __forceinline__ void operator()(const f32x4 (&acc)[2][2][4][2], const Unit& u, int wr, int wc, int fr, int fq) const {
        const int row0 = u.pm * BM + wr * 64 + fr, col0 = u.pn * BM + wc * 32 + 4 * fq;
        typedef unsigned u32x2v __attribute__((ext_vector_type(2)));
#pragma unroll
        for (int ai = 0; ai < 2; ++ai)
#pragma unroll
            for (int m = 0; m < 4; ++m) { const int row = row0 + ai * HALF + m * 16; const size_t off = (size_t)row * 1024 + col0; float s = 0.f;
#pragma unroll
                for (int bj = 0; bj < 2; ++bj)
#pragma unroll
                    for (int n = 0; n < 2; ++n) { const size_t o = off + bj * HALF + n * 16; const f32x4 h = *(const f32x4*)(BASE + o) + acc[ai][bj][m][n];
                        *(f32x4*)(H + o) = h; u32x2v w; w.x = cvt_pk_bf16(h[0], h[1]); w.y = cvt_pk_bf16(h[2], h[3]); *(u32x2v*)(HB + o) = w;
                        s += (h[0] * h[0] + h[1] * h[1]) + (h[2] * h[2] + h[3] * h[3]); }
                s += __shfl_xor(s, 16); s += __shfl_xor(s, 32);
                if (fq == 0) PART[(size_t)row * 16 + u.pn * 4 + wc] = s; }
    }
};

struct EpiL1In {
    static constexpr bool PERM = true, AFTER_DRAIN = false;
    const float* part; const int* pos; bf16_t *Q, *Kk, *V, *G;
    __device__ __forceinline__ void operator()(const f32x4 (&acc)[2][2][4][2], const Unit& u, int wr, int wc, int fr, int fq) const {
        const int row0 = u.pm * BM + wr * 64 + fr, cw = wc * 32 + 8 * fq, pn = u.pn;
        if (pn < 8) {
            const int head = pn & 3; bf16_t* O = (pn < 4) ? Q : Kk; const float sc = (pn < 4) ? 1.0f : 0.0625f;
            const float lgam = __builtin_amdgcn_logf(1.0f - __builtin_amdgcn_exp2f(-5.0f - (float)head)) * ((pn < 4) ? 1.0f : -1.0f);
            float fr_rev[8];
#pragma unroll
            for (int e = 0; e < 8; ++e) fr_rev[e] = __builtin_amdgcn_exp2f((float)(cw + e) * (-13.287712379549449f / 128.0f)) * 0.15915494309189535f;
#pragma unroll
            for (int ai = 0; ai < 2; ++ai)
#pragma unroll
                for (int m = 0; m < 4; ++m) { const int row = row0 + ai * HALF + m * 16; const float r = row_rs(part, row) * sc * __builtin_amdgcn_exp2f((float)((row & 63) - 63) * lgam); const float p = (float)pos[row];
                    f32x4 o1[2], o2[2];
#pragma unroll
                    for (int n = 0; n < 2; ++n)
#pragma unroll
                        for (int e = 0; e < 4; ++e) { const float rev = p * fr_rev[4 * n + e]; const float fr_ = rev - floorf(rev);
                            const float sn = __builtin_amdgcn_sinf(fr_), cs = __builtin_amdgcn_cosf(fr_);
                            const float x1 = acc[ai][0][m][n][e] * r, x2 = acc[ai][1][m][n][e] * r;
                            o1[n][e] = x1 * cs - x2 * sn; o2[n][e] = x1 * sn + x2 * cs; }
                    bf16_t* rp = O + (size_t)row * 1024 + head * 256 + cw;
                    store_bf16x8(rp, o1[0], o1[1]); store_bf16x8(rp + 128, o2[0], o2[1]); }
        } else {
            const bool isg = pn >= 16; bf16_t* O = isg ? G : V; const int cb = ((pn - 8) & 7) * 256;
#pragma unroll
            for (int ai = 0; ai < 2; ++ai)
#pragma unroll
                for (int m = 0; m < 4; ++m) { const int row = row0 + ai * HALF + m * 16; const float r = row_rs(part, row);
#pragma unroll
                    for (int bj = 0; bj < 2; ++bj) { f32x4 v0 = acc[ai][bj][m][0] * r, v1 = acc[ai][bj][m][1] * r;
                        if (isg) { _Pragma("unroll") for (int e = 0; e < 4; ++e) { v0[e] = silu_f(v0[e]); v1[e] = silu_f(v1[e]); } }
                        store_bf16x8(O + (size_t)row * 2048 + cb + bj * HALF + cw, v0, v1); } }
        }
    }
};

template <class Epi, class Sched, bool ALIGN_EPI = false, bool SP2 = false>
__device__ __forceinline__ void gemm_phase(PG8_LAS unsigned char* lds, const Gemm g, const Sched& S, const Epi& E) {
    const int tid = threadIdx.x, wid = __builtin_amdgcn_readfirstlane(tid >> 6), lane = tid & 63, wr = wid >> 2, wc = wid & 3, fr = lane & 15, fq = lane >> 4;
    const int K = g.K, nt = K / BK;
    unsigned voffA[2], voffB[2];
#pragma unroll
    for (int i = 0; i < 2; ++i) { int R, C; stage_rc(tid * 16 + i * 8192, R, C); const int Rb = Epi::PERM ? ((R & ~31) + perm32(R & 31)) : R;
        voffA[i] = (unsigned)(R * K + C) * 2u; voffB[i] = (unsigned)(Rb * K + C) * 2u; }
    const size_t kstep = (size_t)(BK * 2);
    const size_t hstep = (size_t)HALF * K * 2;
    const size_t tstep = 2 * hstep;
    const unsigned ldsw = (unsigned)wid * 1024u;
    const int aoff = lds_byte(wr * 64 + fr, fq * 8), boff = lds_byte(wc * 32 + fr, fq * 8);
#define PG8_SA(b, h) (((b) * 2 + (h)) * HTB)
#define PG8_SB(b, h) ((4 + (b) * 2 + (h)) * HTB)
#define PG8_STAGE(bufoff, gbase, voff) do { _Pragma("unroll") for (int _i = 0; _i < 2; ++_i) \
        __builtin_amdgcn_global_load_lds((const unsigned*)((const char*)(gbase) + (voff)[_i]), (PG8_LAS unsigned*)(lds + (bufoff) + ldsw + _i * 8192), 16, 0, 0); } while (0)
#define PG8_LDA(dst, b, h) do { _Pragma("unroll") for (int m = 0; m < 4; ++m) _Pragma("unroll") for (int k = 0; k < 2; ++k) dst[m][k] = *(const PG8_LAS bf16x8*)(lds + PG8_SA(b, h) + aoff + m * 2048 + k * 1024); } while (0)
#define PG8_LDB(dst, b, h) do { _Pragma("unroll") for (int n = 0; n < 2; ++n) _Pragma("unroll") for (int k = 0; k < 2; ++k) dst[n][k] = *(const PG8_LAS bf16x8*)(lds + PG8_SB(b, h) + boff + n * 2048 + k * 1024); } while (0)
#define PG8_MMA(ai, bj, At, Bt) do { __builtin_amdgcn_s_setprio(1); _Pragma("unroll") for (int m = 0; m < 4; ++m) _Pragma("unroll") for (int n = 0; n < 2; ++n) _Pragma("unroll") for (int k = 0; k < 2; ++k) \
        acc[ai][bj][m][n] = __builtin_amdgcn_mfma_f32_16x16x32_bf16(Bt[n][k], At[m][k], acc[ai][bj][m][n], 0, 0, 0); __builtin_amdgcn_s_setprio(0); } while (0)
#define PG8_WAIT_V(n) asm volatile("s_waitcnt vmcnt(" #n ")" ::: "memory")
#define PG8_WAIT_L(n) asm volatile("s_waitcnt lgkmcnt(" #n ")" ::: "memory")
#define PG8_BAR __builtin_amdgcn_s_barrier()
#define PG8_SCHED __builtin_amdgcn_sched_barrier(0)
    Unit cur, nxt; int ui = 0;
    if (!S.next(0, cur)) return;
    f32x4 acc[2][2][4][2];
#pragma unroll
    for (int a = 0; a < 2; ++a)
#pragma unroll
        for (int b = 0; b < 2; ++b)
#pragma unroll
            for (int m = 0; m < 4; ++m)
#pragma unroll
                for (int n = 0; n < 2; ++n) acc[a][b][m][n] = (f32x4){0.f, 0.f, 0.f, 0.f};
    bf16x8 At[4][2], B0[2][2], B1[2][2];
    const char* cA = (const char*)g.A + (size_t)cur.pm * tstep; const char* cB = (const char*)g.Bt + (size_t)cur.pn * tstep;
    S.a_ready(cur);
    if constexpr (SP2) {
        PG8_STAGE(PG8_SB(0, 0), cB, voffB); PG8_STAGE(PG8_SB(0, 1), cB + hstep, voffB); PG8_STAGE(PG8_SA(0, 0), cA, voffA); PG8_STAGE(PG8_SA(0, 1), cA + hstep, voffA);
        if (wr == 1) PG8_BAR;
        PG8_WAIT_V(2); PG8_BAR;
        PG8_STAGE(PG8_SB(1, 0), cB + kstep, voffB); PG8_STAGE(PG8_SA(1, 0), cA + kstep, voffA); PG8_STAGE(PG8_SB(1, 1), cB + hstep + kstep, voffB);
        PG8_WAIT_V(6); PG8_BAR;
    } else {
        PG8_STAGE(PG8_SB(0, 0), cB, voffB); PG8_STAGE(PG8_SA(0, 0), cA, voffA); PG8_STAGE(PG8_SB(0, 1), cB + hstep, voffB); PG8_STAGE(PG8_SA(0, 1), cA + hstep, voffA);
        if (wr == 1) PG8_BAR;
        PG8_WAIT_V(4); PG8_BAR;
        PG8_STAGE(PG8_SB(1, 0), cB + kstep, voffB); PG8_STAGE(PG8_SA(1, 0), cA + kstep, voffA); PG8_STAGE(PG8_SB(1, 1), cB + hstep + kstep, voffB);
        PG8_WAIT_V(6); PG8_BAR;
    }
    for (;;) {
        const bool has_next = S.next(ui + 1, nxt);
        const char* nA = has_next ? (const char*)g.A + (size_t)nxt.pm * tstep : cA; const char* nB = has_next ? (const char*)g.Bt + (size_t)nxt.pn * tstep : cB;
        for (int t = 0; t < nt; t += 2) {
            const bool last = (t == nt - 2);
            const char* a1 = cA + (size_t)(t + 1) * kstep;
            const char* a2 = last ? nA : cA + (size_t)(t + 2) * kstep; const char* b2 = last ? nB : cB + (size_t)(t + 2) * kstep;
            const char* a3 = a2 + kstep; const char* b3 = b2 + kstep;
            if (last && has_next) S.a_ready(nxt);
            if constexpr (SP2) {
            PG8_LDB(B0, 0, 0); PG8_LDB(B1, 0, 1); PG8_SCHED; PG8_LDA(At, 0, 0); PG8_STAGE(PG8_SA(1, 1), a1 + hstep, voffA);
            PG8_WAIT_V(8); PG8_WAIT_L(0); PG8_BAR; PG8_MMA(0, 0, At, B0); PG8_MMA(0, 1, At, B1); PG8_BAR; PG8_SCHED;
            PG8_LDA(At, 0, 1); PG8_STAGE(PG8_SB(0, 0), b2, voffB); PG8_STAGE(PG8_SB(0, 1), b2 + hstep, voffB); PG8_STAGE(PG8_SA(0, 0), a2, voffA);
            PG8_WAIT_V(8); PG8_WAIT_L(0); PG8_BAR; PG8_MMA(1, 0, At, B0); PG8_MMA(1, 1, At, B1); PG8_BAR; PG8_SCHED;
            PG8_LDB(B0, 1, 0); PG8_LDB(B1, 1, 1); PG8_SCHED; PG8_LDA(At, 1, 0); PG8_STAGE(PG8_SA(0, 1), a2 + hstep, voffA);
            PG8_WAIT_V(8); PG8_WAIT_L(0); PG8_BAR; PG8_MMA(0, 0, At, B0); PG8_MMA(0, 1, At, B1); PG8_BAR; PG8_SCHED;
            PG8_LDA(At, 1, 1); PG8_STAGE(PG8_SB(1, 0), b3, voffB); PG8_STAGE(PG8_SB(1, 1), b3 + hstep, voffB); PG8_STAGE(PG8_SA(1, 0), a3, voffA);
            PG8_WAIT_V(8); PG8_WAIT_L(0); PG8_BAR; PG8_MMA(1, 0, At, B0); PG8_MMA(1, 1, At, B1); PG8_BAR; PG8_SCHED;
            } else {
            PG8_LDB(B0, 0, 0); PG8_SCHED; PG8_LDA(At, 0, 0); PG8_STAGE(PG8_SA(1, 1), a1 + hstep, voffA);
            PG8_WAIT_L(8); PG8_BAR; PG8_WAIT_L(0); PG8_MMA(0, 0, At, B0); PG8_BAR; PG8_SCHED;
            PG8_LDB(B1, 0, 1); PG8_STAGE(PG8_SB(0, 0), b2, voffB);
            PG8_BAR; PG8_WAIT_L(0); PG8_MMA(0, 1, At, B1); PG8_BAR;
            PG8_LDA(At, 0, 1); PG8_STAGE(PG8_SA(0, 0), a2, voffA);
            PG8_BAR; PG8_WAIT_L(0); PG8_MMA(1, 0, At, B0); PG8_BAR; PG8_SCHED;
            PG8_STAGE(PG8_SB(0, 1), b2 + hstep, voffB);
            PG8_WAIT_V(6); PG8_BAR; PG8_MMA(1, 1, At, B1); PG8_BAR;
            PG8_LDB(B0, 1, 0); PG8_SCHED; PG8_LDA(At, 1, 0); PG8_STAGE(PG8_SA(0, 1), a2 + hstep, voffA);
            PG8_WAIT_L(8); PG8_BAR; PG8_WAIT_L(0); PG8_MMA(0, 0, At, B0); PG8_BAR; PG8_SCHED;
            PG8_LDB(B1, 1, 1); PG8_STAGE(PG8_SB(1, 0), b3, voffB);
            PG8_BAR; PG8_WAIT_L(0); PG8_MMA(0, 1, At, B1); PG8_BAR;
            PG8_LDA(At, 1, 1); PG8_STAGE(PG8_SA(1, 0), a3, voffA);
            PG8_BAR; PG8_WAIT_L(0); PG8_MMA(1, 0, At, B0); PG8_BAR; PG8_SCHED;
            PG8_STAGE(PG8_SB(1, 1), b3 + hstep, voffB);
            PG8_WAIT_V(6); PG8_BAR; PG8_MMA(1, 1, At, B1); PG8_BAR;
            }
        }
        if constexpr (ALIGN_EPI) { if (wr == 0) PG8_BAR; }
        if constexpr (!Epi::AFTER_DRAIN) { E(acc, cur, wr, wc, fr, fq); S.done(cur); }
        if (!has_next) break;
#pragma unroll
        for (int a = 0; a < 2; ++a)
#pragma unroll
            for (int b = 0; b < 2; ++b)
#pragma unroll
                for (int m = 0; m < 4; ++m)
#pragma unroll
                    for (int n = 0; n < 2; ++n) acc[a][b][m][n] = (f32x4){0.f, 0.f, 0.f, 0.f};
        cur = nxt; cA = nA; cB = nB; ++ui;
        if constexpr (ALIGN_EPI) { if (wr == 1) PG8_BAR; }
    }
    PG8_WAIT_V(0);
    if constexpr (!ALIGN_EPI) { if (wr == 0) PG8_BAR; }
    PG8_BAR;
    if constexpr (Epi::AFTER_DRAIN) { E.fused(acc, cur, wr, wc, fr, fq, lds, wid, lane); S.done(cur); }
#undef PG8_SA
#undef PG8_SB
#undef PG8_STAGE
#undef PG8_LDA
#undef PG8_LDB
#undef PG8_MMA
#undef PG8_WAIT_V
#undef PG8_WAIT_L
#undef PG8_BAR
#undef PG8_SCHED
}
}
#define GAS __attribute__((address_space(1)))
#define LAS __attribute__((address_space(3)))
typedef unsigned short bf16;
typedef unsigned v4u __attribute__((ext_vector_type(4)));
typedef float f32x4 __attribute__((ext_vector_type(4)));
typedef short bf16x8 __attribute__((ext_vector_type(8)));
typedef GAS unsigned gu32;
typedef GAS unsigned long long gu64;
#define RLX_AGENT __ATOMIC_RELAXED, __HIP_MEMORY_SCOPE_AGENT
#define LDS_WAIT() asm volatile("s_waitcnt lgkmcnt(0)" ::: "memory")
#define VM_WAIT() asm volatile("s_waitcnt vmcnt(0)" ::: "memory")
__device__ __forceinline__ unsigned long long rt() { return __builtin_amdgcn_s_memrealtime(); }
__device__ __forceinline__ unsigned f2bf(float f) { unsigned u = __builtin_bit_cast(unsigned, f); return (u + 0x7fffu + ((u >> 16) & 1u)) >> 16; }
__device__ __forceinline__ unsigned pk2(float lo, float hi) { return f2bf(lo) | (f2bf(hi) << 16); }

#define XB_TMO      128
#define XB_XCNT(j)  (256  + 64 * (j))
#define XB_XSUB(j)  (1280 + 64 * (j))
#define XB_XGEN(j)  (2304 + 64 * (j))
#define XB_TOP      3328
#define XB_TOPGEN   3392
#define XCD_BAR_WORDS 3456
#define XB_SPIN_CAP (1u << 18)

__device__ __forceinline__ unsigned xb_ld(unsigned* p)              { return __hip_atomic_load(p, __ATOMIC_RELAXED, __HIP_MEMORY_SCOPE_AGENT); }
__device__ __forceinline__ unsigned xb_add(unsigned* p, unsigned v) { return __hip_atomic_fetch_add(p, v, __ATOMIC_RELAXED, __HIP_MEMORY_SCOPE_AGENT); }
__device__ __forceinline__ unsigned xb_xcc_id() { return (unsigned)__builtin_amdgcn_s_getreg((3 << 11) | 20) & 0xFu; }
#define XB_SPIN(cond, bar) do { unsigned _sp = 0; while (cond) { __builtin_amdgcn_s_sleep(1); \
    if ((++_sp & 255u) == 0u) { if (xb_ld(&(bar)[XB_TMO])) break; if (_sp > XB_SPIN_CAP) { atomicAdd(&(bar)[XB_TMO], 1u); break; } } } } while (0)

struct XcdBarrier {
    unsigned* bar; unsigned x;
    volatile LAS unsigned* st;
};

__device__ __forceinline__ XcdBarrier xcd_barrier_post(unsigned* bar, volatile LAS unsigned* st) {
    XcdBarrier b; b.bar = bar; b.x = xb_xcc_id(); b.st = st;
    if (threadIdx.x == 0) (void)xb_add(&bar[XB_XCNT(b.x)], 1u);
    return b;
}
__device__ __forceinline__ void xcd_barrier_complete(unsigned* bar, unsigned x, unsigned& nloc, unsigned& nx) {
    const unsigned G = gridDim.x * gridDim.y * gridDim.z;
    unsigned sum, cnt, mine, sp = 0u;
    for (;;) {
        sum = 0u; cnt = 0u; mine = 0u;
#pragma unroll
        for (unsigned j = 0; j < 16; ++j) { const unsigned c = xb_ld(&bar[XB_XCNT(j)]); sum += c; cnt += (c > 0u) ? 1u : 0u; mine = (j == x) ? c : mine; }
        if (sum == G) break;
        __builtin_amdgcn_s_sleep(1);
        if ((++sp & 255u) == 0u) { if (xb_ld(&bar[XB_TMO])) break; if (sp > XB_SPIN_CAP) { atomicAdd(&bar[XB_TMO], 1u); break; } }
    }
    nloc = mine > 0u ? mine : 1u; nx = cnt > 0u ? cnt : 1u;
}

__device__ __forceinline__ void xcd_barrier(const XcdBarrier& b) {
    asm volatile("s_waitcnt vmcnt(0)" ::: "memory");
    __syncthreads();
    if (threadIdx.x == 0) {
        unsigned* bar = b.bar;
        __builtin_amdgcn_s_waitcnt(0);
        unsigned nloc = b.st[0], nx = b.st[1];
        if (nloc == 0u) { xcd_barrier_complete(bar, b.x, nloc, nx); b.st[0] = nloc; b.st[1] = nx; }
        const unsigned old = xb_add(&bar[XB_XSUB(b.x)], 1u);
        const unsigned gen = old / nloc;
        if (old + 1u == (gen + 1u) * nloc) {
            __builtin_amdgcn_fence(__ATOMIC_RELEASE, "agent");
            asm volatile("s_waitcnt vmcnt(0)" ::: "memory");
            const unsigned og = xb_add(&bar[XB_TOP], 1u);
            const unsigned tg = og / nx;
            if (og + 1u == (tg + 1u) * nx) xb_add(&bar[XB_TOPGEN], 1u);
            else XB_SPIN(xb_ld(&bar[XB_TOPGEN]) == tg, bar);
            __builtin_amdgcn_fence(__ATOMIC_ACQUIRE, "agent");
            xb_add(&bar[XB_XGEN(b.x)], 1u);
            asm volatile("s_waitcnt vmcnt(0)" ::: "memory");
        } else {
            XB_SPIN(xb_ld(&bar[XB_XGEN(b.x)]) == gen, bar);
            __builtin_amdgcn_fence(__ATOMIC_ACQUIRE, "agent");
            asm volatile("s_waitcnt vmcnt(0)" ::: "memory");
        }
    }
    __syncthreads();
}
__device__ __forceinline__ float bf2f(unsigned short u) { return __builtin_bit_cast(float, (unsigned)u << 16); }
__device__ __forceinline__ float bflo(unsigned u) { return __builtin_bit_cast(float, u << 16); }
__device__ __forceinline__ float bfhi(unsigned u) { return __builtin_bit_cast(float, u & 0xffff0000u); }
__device__ __forceinline__ float wave_sum(float v) {
#pragma unroll
    for (int o = 1; o < 64; o <<= 1) v += __shfl_xor(v, o);
    return v;
}


namespace cs {
typedef short bf16x8 __attribute__((ext_vector_type(8)));
typedef short s16x4 __attribute__((ext_vector_type(4)));
typedef float f32x16 __attribute__((ext_vector_type(16)));
typedef float f32x2 __attribute__((ext_vector_type(2)));
typedef __bf16 bf16x2_t __attribute__((ext_vector_type(2)));
typedef unsigned u32x2 __attribute__((ext_vector_type(2)));
#define CS_MFMA(a, b, c) __builtin_amdgcn_mfma_f32_32x32x16_bf16((a), (b), (c), 0, 0, 0)
__device__ __forceinline__ unsigned pkbf(float lo, float hi) { return __builtin_bit_cast(unsigned, __builtin_convertvector((f32x2){lo, hi}, bf16x2_t)); }
template <int NCH> __device__ __forceinline__ unsigned img_off(unsigned row, unsigned ch) { return (128u * NCH) * (row >> 3) + 512u * (ch >> 2) + 64u * (row & 7) + 16u * ((ch & 3) ^ ((row >> 2) & 3)); }
template <int NCH> __device__ __forceinline__ bf16x8 row_read(LAS unsigned char* img, unsigned rowbase, int s, int r, int h) {
    return *(const LAS bf16x8*)(img + img_off<NCH>(rowbase + r, 2 * s + h));
}
template <int NCH> __device__ __forceinline__ unsigned tr_addr(unsigned lane, unsigned c, unsigned ks, unsigned t) {
    const unsigned h = lane >> 5, blk = (lane >> 4) & 1, q = (lane & 15) >> 2, p = lane & 3;
    return img_off<NCH>(16 * ks + 8 * h + 4 * t + q, 4 * c + 2 * blk + (p >> 1)) + 8 * (p & 1);
}
__device__ __forceinline__ void tr_read_ab(unsigned a0, unsigned a1, unsigned b0, unsigned b1, bf16x8& a, bf16x8& b) {
    s16x4 alo, ahi, blo, bhi;
    asm volatile("ds_read_b64_tr_b16 %0, %4\n\tds_read_b64_tr_b16 %1, %5\n\tds_read_b64_tr_b16 %2, %6\n\tds_read_b64_tr_b16 %3, %7\n\ts_waitcnt lgkmcnt(0)"
                 : "=&v"(alo), "=&v"(ahi), "=&v"(blo), "=&v"(bhi) : "v"(a0), "v"(a1), "v"(b0), "v"(b1) : "memory");
    a = __builtin_shufflevector(alo, ahi, 0, 1, 2, 3, 4, 5, 6, 7); b = __builtin_shufflevector(blo, bhi, 0, 1, 2, 3, 4, 5, 6, 7);
}
__device__ __forceinline__ bf16x8 tr_read_1(unsigned a0, unsigned a1) {
    s16x4 alo, ahi;
    asm volatile("ds_read_b64_tr_b16 %0, %2\n\tds_read_b64_tr_b16 %1, %3\n\ts_waitcnt lgkmcnt(0)" : "=&v"(alo), "=&v"(ahi) : "v"(a0), "v"(a1) : "memory");
    return __builtin_shufflevector(alo, ahi, 0, 1, 2, 3, 4, 5, 6, 7);
}
__device__ __forceinline__ int crow(int reg, int h) { return (reg & 3) + 8 * (reg >> 2) + 4 * h; }

struct ScanIO {
    const bf16* Qd; const bf16* Kd; int qk_ld;
    const bf16* V; int v_ld;
    const float* dec;
    float dec_const;
    bf16* Out; int out_ld;
    const bf16* SG; int sg_ld;
};

struct RR { unsigned e, o; };
template <int NCH> __device__ __forceinline__ RR rr_make(unsigned imgbase, unsigned row, unsigned h) { RR b; b.e = imgbase + img_off<NCH>(row, h); b.o = imgbase + img_off<NCH>(row, 2 + h); return b; }
__device__ __forceinline__ bf16x8 rr_read(LAS unsigned char* lds, const RR b, int s) { return *(const LAS bf16x8*)(lds + ((s & 1) ? b.o : b.e) + 512 * (s >> 1)); }

template <int DK, int DV, bool HGRN> __device__ __forceinline__ void chunk_scan(LAS unsigned char* lds, const ScanIO io) {
    constexpr int C = 64, NCHUNKS = 2048 / C, KS = DK / 16, NVT = DV / 32, NCHK = DK / 8, NCHV = DV / 8;
    constexpr int QD = 0, KD = C * DK * 2, V0 = 2 * C * DK * 2, VSZ = C * DV * 2, SDT = V0 + 2 * VSZ, PIM = SDT + DV * DK * 2, OB = PIM + C * C * 2, END = OB + C * DV * 4;
    static_assert(END <= 146944, "scan LDS map");
    constexpr int NQ = (C * NCHK) / 512, NV = (C * NCHV) / 512;
    static_assert(NQ * 512 == C * NCHK && NV * 512 == C * NCHV, "staging split");
    constexpr unsigned KSTEP_K = 2 * 128 * NCHK, KSTEP_V = 2 * 128 * NCHV;
    const int wave0 = __builtin_amdgcn_readfirstlane(threadIdx.x >> 6); const unsigned lane0 = threadIdx.x & 63;
    f32x16 S0, S1, Z;
#pragma unroll
    for (int i = 0; i < 16; ++i) { S0[i] = 0.f; S1[i] = 0.f; Z[i] = 0.f; }
    v4u pq[NQ], pk[NQ], pv[NV];
#define CS_IDS() int wave = wave0; unsigned lane = lane0; asm volatile("" : "+s"(wave)); asm volatile("" : "+v"(lane)); \
        const unsigned r = lane & 31, h = lane >> 5; const int tid = wave * 64 + (int)lane; \
        const bool zw = HGRN ? true : (wave < 4); const int z_it = HGRN ? (wave >> 2) : (wave >> 1), z_vt = HGRN ? (wave & 3) : (wave & 1); \
        const int xw0 = HGRN ? 0 : 4; const bool xw = (wave >= xw0 && wave < xw0 + 3); const int xt = wave - xw0; const int x_jt = (xt == 2) ? 1 : 0, x_it = (xt == 0) ? 0 : 1; \
        const int s_kt = (2 * wave) / NVT, s_vt0 = (2 * wave) % NVT; (void)r; (void)h; (void)tid; (void)zw; (void)z_it; (void)z_vt; (void)xw; (void)x_jt; (void)x_it; (void)s_kt; (void)s_vt0
#define CS_LOAD_CHUNK(n_) do { const size_t rowb_ = (size_t)(n_) * C; \
        _Pragma("unroll") for (int i_ = 0; i_ < NQ; ++i_) { const int c_ = tid + 512 * i_, row_ = c_ / NCHK, ch_ = c_ % NCHK; \
            pq[i_] = *(const GAS v4u*)(io.Qd + (rowb_ + row_) * io.qk_ld + ch_ * 8); pk[i_] = *(const GAS v4u*)(io.Kd + (rowb_ + row_) * io.qk_ld + ch_ * 8); } \
        _Pragma("unroll") for (int i_ = 0; i_ < NV; ++i_) { const int c_ = tid + 512 * i_, row_ = c_ / NCHV, ch_ = c_ % NCHV; \
            pv[i_] = *(const GAS v4u*)(io.V + (rowb_ + row_) * io.v_ld + ch_ * 8); } } while (0)
#define CS_STAGE_CHUNK(vbuf_) do { \
        _Pragma("unroll") for (int i_ = 0; i_ < NQ; ++i_) { const int c_ = tid + 512 * i_, row_ = c_ / NCHK, ch_ = c_ % NCHK; const unsigned o_ = img_off<NCHK>(row_, ch_); \
            *(LAS v4u*)(lds + o_ + QD) = pq[i_]; *(LAS v4u*)(lds + o_ + KD) = pk[i_]; } \
        _Pragma("unroll") for (int i_ = 0; i_ < NV; ++i_) { const int c_ = tid + 512 * i_, row_ = c_ / NCHV, ch_ = c_ % NCHV; \
            *(LAS v4u*)(lds + img_off<NCHV>(row_, ch_) + V0 + (vbuf_) * VSZ) = pv[i_]; } } while (0)
#define CS_WRITE_SDT() do { \
        _Pragma("unroll") for (int g_ = 0; g_ < 4; ++g_) { \
            u32x2 w0_, w1_; w0_.x = pkbf(S0[4 * g_], S0[4 * g_ + 1]); w0_.y = pkbf(S0[4 * g_ + 2], S0[4 * g_ + 3]); w1_.x = pkbf(S1[4 * g_], S1[4 * g_ + 1]); w1_.y = pkbf(S1[4 * g_ + 2], S1[4 * g_ + 3]); \
            *(LAS u32x2*)(lds + SDT + img_off<NCHK>(32 * s_vt0 + r, 4 * s_kt + g_) + 8 * h) = w0_; \
            *(LAS u32x2*)(lds + SDT + img_off<NCHK>(32 * (s_vt0 + 1) + r, 4 * s_kt + g_) + 8 * h) = w1_; } } while (0)
#define CS_OUTPUT(n_) do { const size_t rowb_ = (size_t)(n_) * C; const LAS float* ob_ = (const LAS float*)(lds + OB); \
        if (HGRN) { _Pragma("unroll") for (int j_ = 0; j_ < 8; ++j_) { const int row_ = 8 * wave + j_; const f32x2 x_ = *(const LAS f32x2*)(ob_ + row_ * DV + 2 * lane); \
                const float ss_ = wave_sum(x_.x * x_.x + x_.y * x_.y); const float rstd_ = 1.0f / sqrtf(ss_ * (1.0f / DV) + 1e-6f); \
                const unsigned g_ = *(const GAS unsigned*)(io.SG + (rowb_ + row_) * io.sg_ld + 2 * lane); \
                *(GAS unsigned*)(io.Out + (rowb_ + row_) * io.out_ld + 2 * lane) = pkbf(x_.x * rstd_ * bflo(g_), x_.y * rstd_ * bfhi(g_)); } } \
        else { const int row_ = tid >> 3, c8_ = (tid & 7) * 8; const f32x4 a_ = *(const LAS f32x4*)(ob_ + row_ * DV + c8_), b_ = *(const LAS f32x4*)(ob_ + row_ * DV + c8_ + 4); \
            v4u w_; w_.x = pkbf(a_[0], a_[1]); w_.y = pkbf(a_[2], a_[3]); w_.z = pkbf(b_[0], b_[1]); w_.w = pkbf(b_[2], b_[3]); \
            *(GAS v4u*)(io.Out + (rowb_ + row_) * io.out_ld + c8_) = w_; } } while (0)

    { CS_IDS(); CS_WRITE_SDT(); CS_LOAD_CHUNK(0); CS_STAGE_CHUNK(0); }
    __syncthreads();
    const unsigned ldsb = (unsigned)(size_t)lds;
    for (int n = 0; n < NCHUNKS; ++n) {
        CS_IDS();
        const unsigned vb = ldsb + V0 + (n & 1) * VSZ;
        if (n + 1 < NCHUNKS) CS_LOAD_CHUNK(n + 1);
        f32x4 dv4[4];
        if (HGRN && n + 1 < NCHUNKS) {
#pragma unroll
            for (int g = 0; g < 4; ++g) dv4[g] = *(const GAS f32x4*)(io.dec + (size_t)(n + 1) * 512 + 32 * s_kt + 8 * g + 4 * h);
        }
        if (n > 0) CS_OUTPUT(n - 1);
        if (xw) {
            f32x16 x;
#pragma unroll
            for (int i = 0; i < 16; ++i) x[i] = 0.f;
            const RR ra = rr_make<NCHK>(KD, 32 * x_jt + r, h), rb = rr_make<NCHK>(QD, 32 * x_it + r, h);
#pragma unroll
            for (int s = 0; s < KS; ++s) { const bf16x8 a = rr_read(lds, ra, s), b = rr_read(lds, rb, s); x = CS_MFMA(a, b, x); }
            if (x_jt == x_it) {
#pragma unroll
                for (int i = 0; i < 16; ++i) x[i] = ((unsigned)crow(i, h) > r) ? 0.f : x[i];
            }
#pragma unroll
            for (int g = 0; g < 4; ++g) { u32x2 w; w.x = pkbf(x[4 * g], x[4 * g + 1]); w.y = pkbf(x[4 * g + 2], x[4 * g + 3]);
                *(LAS u32x2*)(lds + PIM + img_off<8>(32 * x_it + r, 4 * x_jt + g) + 8 * h) = w; }
        }
        if (zw) {
#pragma unroll
            for (int i = 0; i < 16; ++i) Z[i] = 0.f;
            const RR ra = rr_make<NCHK>(QD, 32 * z_it + r, h), rb = rr_make<NCHK>(SDT, 32 * z_vt + r, h);
#pragma unroll
            for (int s = 0; s < KS; ++s) { const bf16x8 a = rr_read(lds, ra, s), b = rr_read(lds, rb, s); Z = CS_MFMA(a, b, Z); }
        }
        {
            const unsigned tk0 = ldsb + KD + tr_addr<NCHK>(lane, s_kt, 0, 0), tk1 = ldsb + KD + tr_addr<NCHK>(lane, s_kt, 0, 1);
            const unsigned t0a = vb + tr_addr<NCHV>(lane, s_vt0, 0, 0), t0b = vb + tr_addr<NCHV>(lane, s_vt0, 0, 1);
            const unsigned t1a = vb + tr_addr<NCHV>(lane, s_vt0 + 1, 0, 0), t1b = vb + tr_addr<NCHV>(lane, s_vt0 + 1, 0, 1);
#pragma unroll
            for (int ks = 0; ks < C / 16; ++ks) { bf16x8 a, b0, b1;
                tr_read_ab(tk0 + ks * KSTEP_K, tk1 + ks * KSTEP_K, t0a + ks * KSTEP_V, t0b + ks * KSTEP_V, a, b0);
                b1 = tr_read_1(t1a + ks * KSTEP_V, t1b + ks * KSTEP_V);
                S0 = CS_MFMA(a, b0, S0); S1 = CS_MFMA(a, b1, S1); }
        }
        __syncthreads();
        if (zw) {
            const RR rp = rr_make<8>(PIM, 32 * z_it + r, h);
            const unsigned tza = vb + tr_addr<NCHV>(lane, z_vt, 0, 0), tzb = vb + tr_addr<NCHV>(lane, z_vt, 0, 1);
#pragma unroll
            for (int s = 0; s < 4; ++s) { if (s < 2 * (z_it + 1)) { const bf16x8 a = rr_read(lds, rp, s);
                    const bf16x8 b = tr_read_1(tza + s * KSTEP_V, tzb + s * KSTEP_V); Z = CS_MFMA(a, b, Z); } }
            LAS float* ob = (LAS float*)(lds + OB) + (32 * z_it + 4 * h) * DV + 32 * z_vt + r;
#pragma unroll
            for (int i = 0; i < 16; ++i) ob[((i & 3) + 8 * (i >> 2)) * DV] = Z[i];
        }
        if (n + 1 < NCHUNKS) {
            if (HGRN) {
#pragma unroll
                for (int i = 0; i < 16; ++i) { const float d = dv4[i >> 2][i & 3]; S0[i] *= d; S1[i] *= d; }
            } else {
#pragma unroll
                for (int i = 0; i < 16; ++i) { S0[i] *= io.dec_const; S1[i] *= io.dec_const; }
            }
            CS_WRITE_SDT();
            CS_STAGE_CHUNK((n + 1) & 1);
        }
        __syncthreads();
    }
    { CS_IDS(); CS_OUTPUT(NCHUNKS - 1); }
    __syncthreads();
#undef CS_IDS
#undef CS_LOAD_CHUNK
#undef CS_STAGE_CHUNK
#undef CS_WRITE_SDT
#undef CS_OUTPUT
}
}

constexpr int NWAVES = 8;
using pg8::RMS_EPS;
constexpr int BATCH = 8, SEQ = 2048, D = 1024, M = BATCH * SEQ;
constexpr int EVEN_IN = 3584, ODD_IN = 6144, FFH = 2816, FF2 = 5632;
constexpr int N_PHASES = 14;
#ifndef MK_N_LAUNCHES
#define MK_N_LAUNCHES 1
#endif
constexpr int N_LAUNCHES = MK_N_LAUNCHES;
#ifndef PROBE_MASK
#define PROBE_MASK 0
#endif
#ifndef PROBE_REPS
#define PROBE_REPS 1
#endif

constexpr size_t MiB = 1u << 20;
constexpr size_t WS_CTL = 0, CTL_ZERO_BYTES = 64 * 1024;
constexpr size_t WS_PART = 1 * MiB;
constexpr size_t WS_W_ODD_IN = 2 * MiB, WS_W_ODD_OUT = 14 * MiB, WS_W_FFN_IN1 = 18 * MiB, WS_W_FFN_OUT1 = 2 * MiB  ;
constexpr size_t WS_HB = 32 * MiB;
constexpr size_t WS_W_EVEN_IN = 64 * MiB, WS_W_EVEN_OUT = 71 * MiB, WS_W_FFN_IN0 = 73 * MiB, WS_W_FFN_OUT0 = 84 * MiB;
constexpr size_t WS_U = 96 * MiB, WS_BB = 112 * MiB, WS_SQ = 128 * MiB, WS_LOGF = 144 * MiB, WS_IV = 176 * MiB, WS_SG0 = 192 * MiB, WS_MIX0 = 208 * MiB;
constexpr size_t WS_KD = 240 * MiB;
constexpr size_t WS_DEC = 29 * MiB;
constexpr size_t WS_ACT0 = 96 * MiB;
constexpr size_t WS_Q = 64 * MiB, WS_K = 96 * MiB, WS_V = 128 * MiB, WS_G = 192 * MiB;
constexpr size_t WS_ACT1 = 64 * MiB;
constexpr size_t WS_END = 256 * MiB;
constexpr int CW_BAR = 4096;

constexpr int RING_OFF = 0, RING_BYTES = 131072;
constexpr int LDS_BYTES = 147456;
constexpr int LDSCTL_OFF = LDS_BYTES - 512, MISC_OFF = LDSCTL_OFF + 320;

struct Args { const float* in[15]; float* out; unsigned char* ws; int ph_lo, ph_hi, li, pad; };

struct MatDesc { const float* W; int K, N; bf16* WT; const float* scale; int scale_from; int map; };
__device__ __forceinline__ int map_col(int map, int n) {
    if (map == 1) { const int seg = n >> 9, c = n & 511; if (seg == 0) return 256 * (c >> 7) + (c & 127); if (seg == 2) return 256 * (c >> 7) + 128 + (c & 127); if (seg == 1) return 1024 + c; return n; }
    if (map == 2) { if (n < FFH) return 256 * (n >> 7) + (n & 127); const int c = n - FFH; return 256 * (c >> 7) + 128 + (c & 127); }
    return n;
}
__device__ __forceinline__ void transpose_item(const MatDesc& md, LAS float* scr, int item, int lane) {
    const int N = md.N, K = md.K, nblk = N / 32, kb = item / nblk, nb = item % nblk, k0 = 64 * kb, n0 = 32 * nb;
#pragma unroll 8
    for (int i = 0; i < 32; ++i) { const int kk = 2 * i + (lane >> 5); const int k = k0 + kk; float w = md.W[(size_t)k * N + n0 + (lane & 31)];
        if (md.scale && k >= md.scale_from) w *= md.scale[k - md.scale_from];
        scr[kk * 33 + (lane & 31)] = w; }
    LDS_WAIT(); asm volatile("" ::: "memory");
    const int c = lane & 7; const int d0 = map_col(md.map, n0);
#pragma unroll
    for (int j = 0; j < 4; ++j) { const int n = (lane >> 3) + 8 * j; const LAS float* s = scr + (8 * c) * 33 + n;
        v4u o; o.x = pk2(s[0 * 33], s[1 * 33]); o.y = pk2(s[2 * 33], s[3 * 33]); o.z = pk2(s[4 * 33], s[5 * 33]); o.w = pk2(s[6 * 33], s[7 * 33]);
        *(GAS v4u*)(md.WT + (size_t)(d0 + n) * K + k0 + 8 * c) = o; }
    LDS_WAIT(); asm volatile("" ::: "memory");
}
__device__ __forceinline__ MatDesc mat_desc(const Args& a, int mat) {
    unsigned char* ws = a.ws; MatDesc d;
    switch (mat) {
    case 0: d = MatDesc{a.in[5], D, EVEN_IN, (bf16*)(ws + WS_W_EVEN_IN), a.in[2], 0, 1}; break;
    case 1: d = MatDesc{a.in[9], D, D, (bf16*)(ws + WS_W_EVEN_OUT), a.in[8], 512, 0}; break;
    case 2: d = MatDesc{a.in[13], D, FF2, (bf16*)(ws + WS_W_FFN_IN0), a.in[3], 0, 2}; break;
    case 3: d = MatDesc{a.in[14], FFH, D, (bf16*)(ws + WS_W_FFN_OUT0), nullptr, 0, 0}; break;
    case 4: d = MatDesc{a.in[10], D, ODD_IN, (bf16*)(ws + WS_W_ODD_IN), a.in[2] + D, 0, 0}; break;
    case 5: d = MatDesc{a.in[12], 2048, D, (bf16*)(ws + WS_W_ODD_OUT), a.in[11], 0, 0}; break;
    case 6: d = MatDesc{a.in[13] + (size_t)D * FF2, D, FF2, (bf16*)(ws + WS_W_FFN_IN1), a.in[3] + D, 0, 2}; break;
    default: d = MatDesc{a.in[14] + (size_t)FFH * D, FFH, D, (bf16*)(ws + WS_W_FFN_OUT1), nullptr, 0, 0}; break;
    }
    return d;
}
__device__ __forceinline__ void convert_mats(const Args& a, int mat_lo, int mat_hi, LAS float* scr, int gw, int NGW, int lane) {
    for (int mat = mat_lo; mat < mat_hi; ++mat) { const MatDesc md = mat_desc(a, mat); const int nitems = (md.K / 64) * (md.N / 32);
        for (int it = gw; it < nitems; it += NGW) transpose_item(md, scr, it, lane); }
}
__device__ __forceinline__ void x_row_prep(const float* xrow, bf16* orow, float* prow, int lane) {
    const GAS f32x4* xr = (const GAS f32x4*)xrow + lane; f32x4 v[4]; float s = 0.f;
#pragma unroll
    for (int j = 0; j < 4; ++j) { v[j] = xr[64 * j]; s += (v[j].x * v[j].x + v[j].y * v[j].y) + (v[j].z * v[j].z + v[j].w * v[j].w); }
    s = wave_sum(s);
    GAS unsigned long long* o8 = (GAS unsigned long long*)orow + lane;
#pragma unroll
    for (int j = 0; j < 4; ++j) o8[64 * j] = (unsigned long long)pk2(v[j].x, v[j].y) | ((unsigned long long)pk2(v[j].z, v[j].w) << 32);
    if (lane < 16) prow[lane] = (lane == 0) ? s : 0.f;
}

__device__ __forceinline__ float exp_fast(float x) { return __builtin_amdgcn_exp2f(x * 1.44269504089f); }
__device__ __forceinline__ void hgrn_prep(LAS unsigned char* lds, unsigned char* ws, int unit) {
    const int tid = threadIdx.x, k = tid & 127, tq = tid >> 7; const int b = unit >> 7, h = (unit >> 5) & 3, n = unit & 31;
    LAS float* part = (LAS float*)lds;
    const size_t row0 = (size_t)b * SEQ + n * 64 + 16 * tq; const int col = h * 128 + k;
    const float* LF = (const float*)(ws + WS_LOGF); bf16* SQ = (bf16*)(ws + WS_SQ); bf16* KDG = (bf16*)(ws + WS_KD);
    float l[16], c[16]; float run = 0.f;
#pragma unroll
    for (int j = 0; j < 16; ++j) { l[j] = LF[(row0 + j) * 512 + col]; run += l[j]; c[j] = run; }
    part[tq * 128 + k] = run;
    __syncthreads();
    const float p0 = part[k], p1 = part[128 + k], p2 = part[256 + k], p3 = part[384 + k];
    const float bl = (p0 + p1) + (p2 + p3); const float pre = (tq > 0 ? p0 : 0.f) + (tq > 1 ? p1 : 0.f) + (tq > 2 ? p2 : 0.f);
#pragma unroll
    for (int j = 0; j < 16; ++j) { const float bt = pre + c[j]; const float q = bf2f(SQ[(row0 + j) * 512 + col]); const float f = exp_fast(l[j]);
        SQ[(row0 + j) * 512 + col] = (bf16)f2bf(q * exp_fast(bt - bl)); KDG[(row0 + j) * 512 + col] = (bf16)f2bf((1.0f - f) * exp_fast(bl - bt)); }
    if (tq == 0) ((float*)(ws + WS_DEC))[(size_t)(b * 32 + n) * 512 + col] = exp_fast(bl);
    __syncthreads();
}

template <int K> __device__ __forceinline__ void run_phase(const Args& args, LAS unsigned char* lds, float* Hout) {
    const int tid = threadIdx.x, lane = tid & 63, wave = __builtin_amdgcn_readfirstlane(tid >> 6);
    const int G = gridDim.x; const int bx = blockIdx.x; const int vcu = (G % 8 == 0) ? (bx % 8) * (G / 8) + bx / 8 : bx;
    unsigned char* ws = args.ws;
    const int gw = vcu * NWAVES + wave, NGW = G * NWAVES;
    float* PART = (float*)(ws + WS_PART);
    bf16* HB = (bf16*)(ws + WS_HB);
    const float* x = args.in[0];
    (void)lane; (void)gw; (void)NGW; (void)PART; (void)HB; (void)x; (void)Hout;
    if constexpr (K == 0) {
        LAS float* scr = (LAS float*)(lds + RING_OFF + wave * 16384);
        convert_mats(args, 0, 7, scr, gw, NGW, lane);
        for (int m = gw; m < M; m += NGW) x_row_prep(x + (size_t)m * D, HB + (size_t)m * D, PART + (size_t)m * 16, lane);
    }
    if constexpr (K == 1) {
        pg8::Gemm g{HB, (const bf16*)(ws + WS_W_EVEN_IN), M, EVEN_IN, D}; pg8::StaticOrder S; S.init(M, EVEN_IN, G, bx);
        pg8::EpiL0In E{PART, (bf16*)(ws + WS_U), (bf16*)(ws + WS_BB), (bf16*)(ws + WS_SQ), (bf16*)(ws + WS_IV), (bf16*)(ws + WS_SG0), (float*)(ws + WS_LOGF), args.in[7]};
        pg8::gemm_phase<pg8::EpiL0In, pg8::StaticOrder, true, true>(lds + RING_OFF, g, S, E);
    }
    if constexpr (K == 2) {
        for (int u = bx; u < BATCH * 4 * 32; u += G) hgrn_prep(lds, ws, u);
    }
    if constexpr (K == 3) {
        for (int u = bx; u < 32; u += G) { const int b = u >> 2, h = u & 3; const size_t r5 = (size_t)b * SEQ * 512 + h * 128;
            cs::ScanIO io; io.Qd = (const bf16*)(ws + WS_SQ) + r5; io.Kd = (const bf16*)(ws + WS_KD) + r5; io.qk_ld = 512; io.V = (const bf16*)(ws + WS_IV) + r5; io.v_ld = 512;
            io.dec = (const float*)(ws + WS_DEC) + (size_t)b * 32 * 512 + h * 128; io.dec_const = 0.f;
            io.Out = (bf16*)(ws + WS_MIX0) + (size_t)b * SEQ * 1024 + 512 + h * 128; io.out_ld = 1024; io.SG = (const bf16*)(ws + WS_SG0) + r5; io.sg_ld = 512;
            cs::chunk_scan<128, 128, true>(lds, io); }
        { int cb, ncb; if (G > 32) { cb = bx - 32; ncb = G - 32; } else { cb = bx; ncb = G; }
          if (cb >= 0) { const bf16* U = (const bf16*)(ws + WS_U); const bf16* Bb = (const bf16*)(ws + WS_BB); bf16* MIX = (bf16*)(ws + WS_MIX0); const float* cw = args.in[6];
            for (int it = cb * 512 + tid; it < M * 64; it += ncb * 512) { const int row = it >> 6, c0 = (it & 63) * 8, t = row & (SEQ - 1);
                const v4u u0 = *(const GAS v4u*)(U + (size_t)row * 512 + c0); v4u u1 = (v4u){0u, 0u, 0u, 0u}, u2 = u1;
                if (t >= 1) u1 = *(const GAS v4u*)(U + (size_t)(row - 1) * 512 + c0);
                if (t >= 2) u2 = *(const GAS v4u*)(U + (size_t)(row - 2) * 512 + c0);
                const v4u bb = *(const GAS v4u*)(Bb + (size_t)row * 512 + c0);
                float y[8];
#pragma unroll
                for (int p = 0; p < 4; ++p) { const int c = c0 + 2 * p;
                    y[2 * p] = bflo(bb[p]) * (cw[c] * bflo(u2[p]) + cw[512 + c] * bflo(u1[p]) + cw[1024 + c] * bflo(u0[p]));
                    y[2 * p + 1] = bfhi(bb[p]) * (cw[c + 1] * bfhi(u2[p]) + cw[512 + c + 1] * bfhi(u1[p]) + cw[1024 + c + 1] * bfhi(u0[p])); }
                v4u o; o.x = pk2(y[0], y[1]); o.y = pk2(y[2], y[3]); o.z = pk2(y[4], y[5]); o.w = pk2(y[6], y[7]);
                *(GAS v4u*)(MIX + (size_t)row * 1024 + c0) = o; } } }
    }
    if constexpr (K == 4) {
        pg8::Gemm g{(const bf16*)(ws + WS_MIX0), (const bf16*)(ws + WS_W_EVEN_OUT), M, D, D}; pg8::StaticOrder S; S.init(M, D, G, bx);
        pg8::EpiResid E{x, Hout, HB, PART};
        pg8::gemm_phase<pg8::EpiResid, pg8::StaticOrder, true, true>(lds + RING_OFF, g, S, E);
    }
    if constexpr (K == 5) {
        pg8::Gemm g{HB, (const bf16*)(ws + WS_W_FFN_IN0), M, FF2, D}; pg8::StaticOrder S; S.init(M, FF2, G, bx);
        pg8::EpiSwiGLU E{PART, (bf16*)(ws + WS_ACT0)};
        pg8::gemm_phase<pg8::EpiSwiGLU, pg8::StaticOrder, true, true>(lds + RING_OFF, g, S, E);
    }
    if constexpr (K == 6) {
        pg8::Gemm g{(const bf16*)(ws + WS_ACT0), (const bf16*)(ws + WS_W_FFN_OUT0), M, D, FFH}; pg8::StaticOrder S; S.init(M, D, G, bx);
        pg8::EpiResid E{args.out, Hout, HB, PART};
        pg8::gemm_phase<pg8::EpiResid, pg8::StaticOrder, true, true>(lds + RING_OFF, g, S, E);
    }
    if constexpr (K == 7) {
        pg8::Gemm g{HB, (const bf16*)(ws + WS_W_ODD_IN), M, ODD_IN, D}; pg8::StaticOrder S; S.init(M, ODD_IN, G, bx);
        pg8::EpiL1In E{PART, (const int*)args.in[1], (bf16*)(ws + WS_Q), (bf16*)(ws + WS_K), (bf16*)(ws + WS_V), (bf16*)(ws + WS_G)};
        pg8::gemm_phase<pg8::EpiL1In, pg8::StaticOrder, true, true>(lds + RING_OFF, g, S, E);
    }
    if constexpr (K == 8) {
        for (int u = bx; u < 256; u += G) { const int b = u >> 5, h = (u >> 3) & 3, vs = u & 7;
            const float lg = __builtin_amdgcn_logf(1.0f - exp2f(-5.0f - (float)h));
            cs::ScanIO io; io.Qd = (const bf16*)(ws + WS_Q) + (size_t)b * SEQ * 1024 + h * 256; io.Kd = (const bf16*)(ws + WS_K) + (size_t)b * SEQ * 1024 + h * 256; io.qk_ld = 1024;
            io.V = (const bf16*)(ws + WS_V) + (size_t)b * SEQ * 2048 + h * 512 + vs * 64; io.v_ld = 2048; io.dec = nullptr; io.dec_const = __builtin_amdgcn_exp2f(64.0f * lg);
            io.Out = (bf16*)(ws + WS_V) + (size_t)b * SEQ * 2048 + h * 512 + vs * 64; io.out_ld = 2048; io.SG = nullptr; io.sg_ld = 0;
            cs::chunk_scan<256, 64, false>(lds, io); }
    }
    if constexpr (K == 9) {
        LAS float* scr = (LAS float*)(lds + RING_OFF + wave * 16384);
        convert_mats(args, 7, 8, scr, gw, NGW, lane);
        const bf16* O = (const bf16*)(ws + WS_V); bf16* Gp = (bf16*)(ws + WS_G);
        for (int it = gw; it < M * 4; it += NGW) { const size_t off = (size_t)(it >> 2) * 2048 + (it & 3) * 512 + lane * 8;
            const v4u ov = *(const GAS v4u*)(O + off); const v4u gv = *(const GAS v4u*)(Gp + off);
            float o[8]; float s = 0.f;
#pragma unroll
            for (int p = 0; p < 4; ++p) { o[2 * p] = bflo(ov[p]); o[2 * p + 1] = bfhi(ov[p]); s += o[2 * p] + o[2 * p + 1]; }
            const float mu = wave_sum(s) * (1.0f / 512.0f); float q = 0.f;
#pragma unroll
            for (int e = 0; e < 8; ++e) { o[e] -= mu; q += o[e] * o[e]; }
            const float rstd = 1.0f / sqrtf(wave_sum(q) * (1.0f / 512.0f) + RMS_EPS);
            v4u w;
#pragma unroll
            for (int p = 0; p < 4; ++p) w[p] = pk2(o[2 * p] * rstd * bflo(gv[p]), o[2 * p + 1] * rstd * bfhi(gv[p]));
            *(GAS v4u*)(Gp + off) = w; }
    }
    if constexpr (K == 10) {
        pg8::Gemm g{(const bf16*)(ws + WS_G), (const bf16*)(ws + WS_W_ODD_OUT), M, D, 2048}; pg8::StaticOrder S; S.init(M, D, G, bx);
        pg8::EpiResid E{args.out, Hout, HB, PART};
        pg8::gemm_phase<pg8::EpiResid, pg8::StaticOrder, true, true>(lds + RING_OFF, g, S, E);
    }
    if constexpr (K == 11) {
        pg8::Gemm g{HB, (const bf16*)(ws + WS_W_FFN_IN1), M, FF2, D}; pg8::StaticOrder S; S.init(M, FF2, G, bx);
        pg8::EpiSwiGLU E{PART, (bf16*)(ws + WS_ACT1)};
        pg8::gemm_phase<pg8::EpiSwiGLU, pg8::StaticOrder, true, true>(lds + RING_OFF, g, S, E);
    }
    if constexpr (K == 12) {
        pg8::Gemm g{(const bf16*)(ws + WS_ACT1), (const bf16*)(ws + WS_W_FFN_OUT1), M, D, FFH}; pg8::StaticOrder S; S.init(M, D, G, bx);
        pg8::EpiResid E{args.out, Hout, HB, PART};
        pg8::gemm_phase<pg8::EpiResid, pg8::StaticOrder, true, true>(lds + RING_OFF, g, S, E);
    }
    if constexpr (K == 13) {
        const float* wf = args.in[4];
        for (int m = gw; m < M; m += NGW) { GAS f32x4* hr = (GAS f32x4*)(args.out + (size_t)m * D) + lane; f32x4 v[4]; float s = 0.f;
#pragma unroll
            for (int j = 0; j < 4; ++j) { v[j] = hr[64 * j]; s += (v[j].x * v[j].x + v[j].y * v[j].y) + (v[j].z * v[j].z + v[j].w * v[j].w); }
            const float rs = 1.0f / sqrtf(wave_sum(s) * (1.0f / 1024.0f) + RMS_EPS);
#pragma unroll
            for (int j = 0; j < 4; ++j) { const f32x4 w = *((const GAS f32x4*)wf + lane + 64 * j); hr[64 * j] = v[j] * rs * w; } }
    }
}

__global__ void __launch_bounds__(NWAVES * 64, 2) fwd_kernel(Args args) {
    extern __shared__ __attribute__((aligned(16))) unsigned char lds_raw[];
    LAS unsigned char* lds = (LAS unsigned char*)lds_raw;
    volatile LAS unsigned* MISC = (volatile LAS unsigned*)(lds + MISC_OFF);
    gu32* ctl = (gu32*)(args.ws + WS_CTL);
    for (int u = threadIdx.x; u < (LDS_BYTES - LDSCTL_OFF) / 4; u += NWAVES * 64) ((LAS unsigned*)(lds + LDSCTL_OFF))[u] = 0u;
    __syncthreads();
    XcdBarrier bar; bar.bar = (unsigned*)(ctl + CW_BAR); bar.x = 0; bar.st = nullptr;
    if (N_LAUNCHES == 1) bar = xcd_barrier_post((unsigned*)(ctl + CW_BAR), MISC + 8);
#define GRID_BAR() do { if (N_LAUNCHES == 1) xcd_barrier(bar); } while (0)
    const int lo = args.ph_lo, hi = args.ph_hi;
#define IN(k) (lo <= (k) && (k) < hi)
#define PHASE(k) do { if (IN(k)) { run_phase<k>(args, lds, args.out); if ((k) + 1 < N_PHASES && IN((k) + 1)) GRID_BAR(); } } while (0)
    PHASE(0); PHASE(1); PHASE(2); PHASE(3); PHASE(4); PHASE(5); PHASE(6); PHASE(7); PHASE(8); PHASE(9); PHASE(10); PHASE(11); PHASE(12); PHASE(13);
#define REPLAY(k) do { if ((PROBE_MASK >> (k)) & 1) { for (int rep_ = 0; rep_ < PROBE_REPS; ++rep_) { GRID_BAR(); run_phase<k>(args, lds, (float*)(args.ws + 192 * MiB)); } } } while (0)
    REPLAY(0); REPLAY(1); REPLAY(2); REPLAY(3); REPLAY(4); REPLAY(5); REPLAY(6); REPLAY(7); REPLAY(8); REPLAY(9); REPLAY(10); REPLAY(11); REPLAY(12);
#undef IN
#undef PHASE
#undef REPLAY
#undef GRID_BAR
}

extern "C" void kernel_launch(void* const* d_in, const int* in_sizes, int n_in, void* d_out, int out_size, void* d_ws, size_t ws_size, hipStream_t stream) {
    static int grid = 0;
    if (grid == 0) {
        if (n_in != 15 || in_sizes[0] != M * D || out_size != M * D || ws_size < WS_END) { fprintf(stderr, "kernel_launch: unexpected problem shape (n_in %d, in0 %d, out %d, ws %zu); nothing launched\n", n_in, n_in > 0 ? in_sizes[0] : -1, out_size, ws_size); grid = -1; return; }
        int dev = 0, cus = 0, per_cu = 0;
        if (hipGetDevice(&dev) != hipSuccess || hipDeviceGetAttribute(&cus, hipDeviceAttributeMultiprocessorCount, dev) != hipSuccess) { grid = -1; return; }
        if (hipFuncSetAttribute((const void*)fwd_kernel, hipFuncAttributeMaxDynamicSharedMemorySize, LDS_BYTES) != hipSuccess) { fprintf(stderr, "kernel_launch: hipFuncSetAttribute failed\n"); grid = -1; return; }
        if (hipOccupancyMaxActiveBlocksPerMultiprocessor(&per_cu, (const void*)fwd_kernel, NWAVES * 64, LDS_BYTES) != hipSuccess || per_cu < 1)
            fprintf(stderr, "kernel_launch: note: occupancy query reports %d workgroups per CU\n", per_cu);
        (void)hipGetLastError();
        grid = cus;
    }
    if (grid < 0) return;
    if (hipMemsetAsync((char*)d_ws + WS_CTL, 0, CTL_ZERO_BYTES, stream) != hipSuccess) { fprintf(stderr, "kernel_launch: hipMemsetAsync failed\n"); return; }
    Args a{};
    for (int i = 0; i < 15; ++i) a.in[i] = (const float*)d_in[i];
    a.out = (float*)d_out; a.ws = (unsigned char*)d_ws;
    for (int li = 0; li < N_LAUNCHES; ++li) {
        if (N_LAUNCHES == 1) { a.ph_lo = 0; a.ph_hi = N_PHASES; } else { a.ph_lo = li; a.ph_hi = li + 1; }
        a.li = li;
        hipLaunchKernelGGL(fwd_kernel, dim3(grid), dim3(NWAVES * 64), LDS_BYTES, stream, a);
        const hipError_t le = hipPeekAtLastError();
        if (le != hipSuccess) { fprintf(stderr, "kernel_launch: launch %d failed: %s\n", li, hipGetErrorName(le)); break; }
    }
}
```

```cpp
#include <hip/hip_runtime.h>
#include <cstdio>
#include <cstdint>
namespace pg8 {
#define PG8_LAS __attribute__((address_space(3)))
typedef unsigned short bf16_t;
typedef short bf16x8 __attribute__((ext_vector_type(8)));
typedef float f32x4 __attribute__((ext_vector_type(4)));
typedef unsigned u32x4 __attribute__((ext_vector_type(4)));
constexpr int BM = 256, BK = 64, HALF = 128, HTB = HALF * BK * 2  , STAGE_BYTES = 8 * HTB, NXCD = 8, WGM = 8;

__host__ __device__ __forceinline__ int lds_byte(int r, int c) { const int st = (r >> 4) * 2 + (c >> 5), rr = r & 15, cc = c & 31, ob = rr * 64 + cc * 2; return st * 1024 + (ob ^ (((ob >> 9) & 1) << 5)); }
__host__ __device__ __forceinline__ void stage_rc(int b, int& R, int& C) { const int st = b / 1024, sb = b % 1024, swz = sb ^ (((sb >> 9) & 1) << 5); R = (st >> 1) * 16 + swz / 64; C = (st & 1) * 32 + (swz % 64) / 2; }
__host__ __device__ __forceinline__ int perm32(int rho) { const int n = rho >> 4, i = rho & 15; return 8 * (i >> 2) + 4 * n + (i & 3); }

struct Unit { int pm, pn; };
struct Gemm { const bf16_t* A; const bf16_t* Bt; int M, N, K; };

struct StaticOrder {
    int nM, nN, nwg, G, c;
    __host__ __device__ void init(int M, int N, int G_, int c_) { nM = M / BM; nN = N / BM; nwg = nM * nN; G = G_; c = c_; }
    __host__ __device__ bool next(int i, Unit& u) const {
        const long L = (long)i * G + c; if (L >= nwg) return false;
        int wgid = (int)L; { const int q = nwg / NXCD, r = nwg % NXCD, xcd = wgid % NXCD, off = wgid / NXCD; wgid = (xcd < r ? xcd * (q + 1) : r * (q + 1) + (xcd - r) * q) + off; }
        const int nig = WGM * nN, gid = wgid / nig, fm = gid * WGM, gsz = (nM - fm) < WGM ? (nM - fm) : WGM;
        u.pm = fm + ((wgid % nig) % gsz); u.pn = (wgid % nig) / gsz; return true;
    }
    __device__ __forceinline__ void a_ready(const Unit&) const {}
    __device__ __forceinline__ void done(const Unit&) const {}
};

__device__ __forceinline__ unsigned cvt_pk_bf16(float lo, float hi) { unsigned r; asm volatile("v_cvt_pk_bf16_f32 %0, %1, %2" : "=v"(r) : "v"(lo), "v"(hi)); return r; }
__device__ __forceinline__ float fast_rcp(float x) { return __builtin_amdgcn_rcpf(x); }
__device__ __forceinline__ float fast_exp(float x) { return __builtin_amdgcn_exp2f(x * 1.44269504089f); }
__device__ __forceinline__ float fast_log(float x) { return __builtin_amdgcn_logf(x) * 0.69314718056f; }
__device__ __forceinline__ float silu_f(float x) { return x * fast_rcp(1.0f + fast_exp(-x)); }
__device__ __forceinline__ float sigmoid_f(float x) { return fast_rcp(1.0f + fast_exp(-x)); }
constexpr float RMS_EPS = 1e-6f;
__device__ __forceinline__ float row_rs(const float* part, int row) {
    const f32x4* p = (const f32x4*)(part + (size_t)row * 16);
    const f32x4 a = p[0], b = p[1], c = p[2], d = p[3];
    const float s = ((a[0] + a[1]) + (a[2] + a[3])) + ((b[0] + b[1]) + (b[2] + b[3])) + ((c[0] + c[1]) + (c[2] + c[3])) + ((d[0] + d[1]) + (d[2] + d[3]));
    return 1.0f / sqrtf(s * (1.0f / 1024.0f) + RMS_EPS);
}
__device__ __forceinline__ void store_bf16x8(bf16_t* p, const f32x4 v0, const f32x4 v1) {
    u32x4 w; w.x = cvt_pk_bf16(v0[0], v0[1]); w.y = cvt_pk_bf16(v0[2], v0[3]); w.z = cvt_pk_bf16(v1[0], v1[1]); w.w = cvt_pk_bf16(v1[2], v1[3]);
    *(u32x4*)p = w;
}

struct EpiL0In {
    static constexpr bool PERM = true, AFTER_DRAIN = false;
    const float* part;
    bf16_t *U, *Bb, *SQ, *IV, *SG; float* LOGF; const float* lbl;
    __device__ __forceinline__ void operator()(const f32x4 (&acc)[2][2][4][2], const Unit& u, int wr, int wc, int fr, int fq) const {
        const int row0 = u.pm * BM + wr * 64 + fr, cw = wc * 32 + 8 * fq, pn = u.pn;
        if (pn < 4) {
#pragma unroll
            for (int ai = 0; ai < 2; ++ai)
#pragma unroll
                for (int m = 0; m < 4; ++m) { const int row = row0 + ai * HALF + m * 16; const float r = row_rs(part, row), r2 = r * r;
                    const f32x4 v0 = acc[ai][0][m][0] * acc[ai][1][m][0] * r2, v1 = acc[ai][0][m][1] * acc[ai][1][m][1] * r2;
                    store_bf16x8(U + (size_t)row * 512 + pn * 128 + cw, v0, v1); }
        } else {
            const int seg = (pn - 4) >> 1, cb = ((pn - 4) & 1) * 256;
            float lb[2][8];
            if (seg == 2) {
#pragma unroll
                for (int bj = 0; bj < 2; ++bj)
#pragma unroll
                    for (int e = 0; e < 8; ++e) { const int c = cb + bj * HALF + cw + e; lb[bj][e] = fast_rcp(1.0f + fast_exp(lbl[512 + c] - lbl[c])); }
            }
#pragma unroll
            for (int ai = 0; ai < 2; ++ai)
#pragma unroll
                for (int m = 0; m < 4; ++m) { const int row = row0 + ai * HALF + m * 16; const float r = row_rs(part, row);
#pragma unroll
                    for (int bj = 0; bj < 2; ++bj) { const int col = cb + bj * HALF + cw; f32x4 v0 = acc[ai][bj][m][0] * r, v1 = acc[ai][bj][m][1] * r; const size_t off = (size_t)row * 512 + col;
                        if (seg == 0) store_bf16x8(Bb + off, v0, v1);
                        else if (seg == 1) { _Pragma("unroll") for (int e = 0; e < 4; ++e) { v0[e] = silu_f(v0[e]); v1[e] = silu_f(v1[e]); } store_bf16x8(SQ + off, v0, v1); }
                        else if (seg == 2) { _Pragma("unroll") for (int e = 0; e < 4; ++e) { const float l0 = lb[bj][e], l1 = lb[bj][4 + e];
                                v0[e] = fast_log(l0 + (1.0f - l0) * sigmoid_f(v0[e])); v1[e] = fast_log(l1 + (1.0f - l1) * sigmoid_f(v1[e])); }
                            *(f32x4*)(LOGF + off) = v0; *(f32x4*)(LOGF + off + 4) = v1; }
                        else if (seg == 3) store_bf16x8(IV + off, v0, v1);
                        else { _Pragma("unroll") for (int e = 0; e < 4; ++e) { v0[e] = silu_f(v0[e]); v1[e] = silu_f(v1[e]); } store_bf16x8(SG + off, v0, v1); }
                    } }
        }
    }
};

struct EpiSwiGLU {
    static constexpr bool PERM = true, AFTER_DRAIN = false;
    const float* part; bf16_t* ACT;
    __device__ __forceinline__ void operator()(const f32x4 (&acc)[2][2][4][2], const Unit& u, int wr, int wc, int fr, int fq) const {
        const int row0 = u.pm * BM + wr * 64 + fr, cw = wc * 32 + 8 * fq;
#pragma unroll
        for (int ai = 0; ai < 2; ++ai)
#pragma unroll
            for (int m = 0; m < 4; ++m) { const int row = row0 + ai * HALF + m * 16; const float r = row_rs(part, row);
                f32x4 g0 = acc[ai][0][m][0] * r, g1 = acc[ai][0][m][1] * r; const f32x4 u0 = acc[ai][1][m][0] * r, u1 = acc[ai][1][m][1] * r;
#pragma unroll
                for (int e = 0; e < 4; ++e) { g0[e] = silu_f(g0[e]) * u0[e]; g1[e] = silu_f(g1[e]) * u1[e]; }
                store_bf16x8(ACT + (size_t)row * 2816 + u.pn * 128 + cw, g0, g1); }
    }
};

struct EpiResid {
    static constexpr bool PERM = false, AFTER_DRAIN = false;
    const float* BASE; float* H; bf16_t* HB; float* PART;
    __device__ __forceinline__ void operator()(const f32x4 (&acc)[2][2][4][2], const Unit& u, int wr, int wc, int fr, int fq) const {
        const int row0 = u.pm * BM + wr * 64 + fr, col0 = u.pn * BM + wc * 32 + 4 * fq;
        typedef unsigned u32x2v __attribute__((ext_vector_type(2)));
#pragma unroll
        for (int ai = 0; ai < 2; ++ai)
#pragma unroll
            for (int m = 0; m < 4; ++m) { const int row = row0 + ai * HALF + m * 16; const size_t off = (size_t)row * 1024 + col0; float s = 0.f;
#pragma unroll
                for (int bj = 0; bj < 2; ++bj)
#pragma unroll
                    for (int n = 0; n < 2; ++n) { const size_t o = off + bj * HALF + n * 16; const f32x4 h = *(const f32x4*)(BASE + o) + acc[ai][bj][m][n];
                        *(f32x4*)(H + o) = h; u32x2v w; w.x = cvt_pk_bf16(h[0], h[1]); w.y = cvt_pk_bf16(h[2], h[3]); *(u32x2v*)(HB + o) = w;
                        s += (h[0] * h[0] + h[1] * h[1]) + (h[2] * h[2] + h[3] * h[3]); }
                s += __shfl_xor(s, 16); s += __shfl_xor(s, 32);
                if (fq == 0) PART[(size_t)row * 16 + u.pn * 4 + wc] = s; }
    }
};

struct EpiL1In {
    static constexpr bool PERM = true, AFTER_DRAIN = false;
    const float* part; const int* pos; bf16_t *Q, *Kk, *V, *G;
    __device__ __forceinline__ void operator()(const f32x4 (&acc)[2][2][4][2], const Unit& u, int wr, int wc, int fr, int fq) const {
        const int row0 = u.pm * BM + wr * 64 + fr, cw = wc * 32 + 8 * fq, pn = u.pn;
        if (pn < 8) {
            const int head = pn & 3; bf16_t* O = (pn < 4) ? Q : Kk; const float sc = (pn < 4) ? 1.0f : 0.0625f;
            const float lgam = __builtin_amdgcn_logf(1.0f - __builtin_amdgcn_exp2f(-5.0f - (float)head)) * ((pn < 4) ? 1.0f : -1.0f);
            float fr_rev[8];
#pragma unroll
            for (int e = 0; e < 8; ++e) fr_rev[e] = __builtin_amdgcn_exp2f((float)(cw + e) * (-13.287712379549449f / 128.0f)) * 0.15915494309189535f;
#pragma unroll
            for (int ai = 0; ai < 2; ++ai)
#pragma unroll
                for (int m = 0; m < 4; ++m) { const int row = row0 + ai * HALF + m * 16; const float r = row_rs(part, row) * sc * __builtin_amdgcn_exp2f((float)((row & 63) - 63) * lgam); const float p = (float)pos[row];
                    f32x4 o1[2], o2[2];
#pragma unroll
                    for (int n = 0; n < 2; ++n)
#pragma unroll
                        for (int e = 0; e < 4; ++e) { const float rev = p * fr_rev[4 * n + e]; const float fr_ = rev - floorf(rev);
                            const float sn = __builtin_amdgcn_sinf(fr_), cs = __builtin_amdgcn_cosf(fr_);
                            const float x1 = acc[ai][0][m][n][e] * r, x2 = acc[ai][1][m][n][e] * r;
                            o1[n][e] = x1 * cs - x2 * sn; o2[n][e] = x1 * sn + x2 * cs; }
                    bf16_t* rp = O + (size_t)row * 1024 + head * 256 + cw;
                    store_bf16x8(rp, o1[0], o1[1]); store_bf16x8(rp + 128, o2[0], o2[1]); }
        } else {
            const bool isg = pn >= 16; bf16_t* O = isg ? G : V; const int cb = ((pn - 8) & 7) * 256;
#pragma unroll
            for (int ai = 0; ai < 2; ++ai)
#pragma unroll
                for (int m = 0; m < 4; ++m) { const int row = row0 + ai * HALF + m * 16; const float r = row_rs(part, row);
#pragma unroll
                    for (int bj = 0; bj < 2; ++bj) { f32x4 v0 = acc[ai][bj][m][0] * r, v1 = acc[ai][bj][m][1] * r;
                        if (isg) { _Pragma("unroll") for (int e = 0; e < 4; ++e) { v0[e] = silu_f(v0[e]); v1[e] = silu_f(v1[e]); } }
                        store_bf16x8(O + (size_t)row * 2048 + cb + bj * HALF + cw, v0, v1); } }
        }
    }
};

template <class Epi, class Sched, bool ALIGN_EPI = false, bool SP2 = false>
__device__ __forceinline__ void gemm_phase(PG8_LAS unsigned char* lds, const Gemm g, const Sched& S, const Epi& E) {
    const int tid = threadIdx.x, wid = __builtin_amdgcn_readfirstlane(tid >> 6), lane = tid & 63, wr = wid >> 2, wc = wid & 3, fr = lane & 15, fq = lane >> 4;
    const int K = g.K, nt = K / BK;
    unsigned voffA[2], voffB[2];
#pragma unroll
    for (int i = 0; i < 2; ++i) { int R, C; stage_rc(tid * 16 + i * 8192, R, C); const int Rb = Epi::PERM ? ((R & ~31) + perm32(R & 31)) : R;
        voffA[i] = (unsigned)(R * K + C) * 2u; voffB[i] = (unsigned)(Rb * K + C) * 2u; }
    const size_t kstep = (size_t)(BK * 2);
    const size_t hstep = (size_t)HALF * K * 2;
    const size_t tstep = 2 * hstep;
    const unsigned ldsw = (unsigned)wid * 1024u;
    const int aoff = lds_byte(wr * 64 + fr, fq * 8), boff = lds_byte(wc * 32 + fr, fq * 8);
#define PG8_SA(b, h) (((b) * 2 + (h)) * HTB)
#define PG8_SB(b, h) ((4 + (b) * 2 + (h)) * HTB)
#define PG8_STAGE(bufoff, gbase, voff) do { _Pragma("unroll") for (int _i = 0; _i < 2; ++_i) \
        __builtin_amdgcn_global_load_lds((const unsigned*)((const char*)(gbase) + (voff)[_i]), (PG8_LAS unsigned*)(lds + (bufoff) + ldsw + _i * 8192), 16, 0, 0); } while (0)
#define PG8_LDA(dst, b, h) do { _Pragma("unroll") for (int m = 0; m < 4; ++m) _Pragma("unroll") for (int k = 0; k < 2; ++k) dst[m][k] = *(const PG8_LAS bf16x8*)(lds + PG8_SA(b, h) + aoff + m * 2048 + k * 1024); } while (0)
#define PG8_LDB(dst, b, h) do { _Pragma("unroll") for (int n = 0; n < 2; ++n) _Pragma("unroll") for (int k = 0; k < 2; ++k) dst[n][k] = *(const PG8_LAS bf16x8*)(lds + PG8_SB(b, h) + boff + n * 2048 + k * 1024); } while (0)
#define PG8_MMA(ai, bj, At, Bt) do { __builtin_amdgcn_s_setprio(1); _Pragma("unroll") for (int m = 0; m < 4; ++m) _Pragma("unroll") for (int n = 0; n < 2; ++n) _Pragma("unroll") for (int k = 0; k < 2; ++k) \
        acc[ai][bj][m][n] = __builtin_amdgcn_mfma_f32_16x16x32_bf16(Bt[n][k], At[m][k], acc[ai][bj][m][n], 0, 0, 0); __builtin_amdgcn_s_setprio(0); } while (0)
#define PG8_WAIT_V(n) asm volatile("s_waitcnt vmcnt(" #n ")" ::: "memory")
#define PG8_WAIT_L(n) asm volatile("s_waitcnt lgkmcnt(" #n ")" ::: "memory")
#define PG8_BAR __builtin_amdgcn_s_barrier()
#define PG8_SCHED __builtin_amdgcn_sched_barrier(0)
    Unit cur, nxt; int ui = 0;
    if (!S.next(0, cur)) return;
    f32x4 acc[2][2][4][2];
#pragma unroll
    for (int a = 0; a < 2; ++a)
#pragma unroll
        for (int b = 0; b < 2; ++b)
#pragma unroll
            for (int m = 0; m < 4; ++m)
#pragma unroll
                for (int n = 0; n < 2; ++n) acc[a][b][m][n] = (f32x4){0.f, 0.f, 0.f, 0.f};
    bf16x8 At[4][2], B0[2][2], B1[2][2];
    const char* cA = (const char*)g.A + (size_t)cur.pm * tstep; const char* cB = (const char*)g.Bt + (size_t)cur.pn * tstep;
    S.a_ready(cur);
    if constexpr (SP2) {
        PG8_STAGE(PG8_SB(0, 0), cB, voffB); PG8_STAGE(PG8_SB(0, 1), cB + hstep, voffB); PG8_STAGE(PG8_SA(0, 0), cA, voffA); PG8_STAGE(PG8_SA(0, 1), cA + hstep, voffA);
        if (wr == 1) PG8_BAR;
        PG8_WAIT_V(2); PG8_BAR;
        PG8_STAGE(PG8_SB(1, 0), cB + kstep, voffB); PG8_STAGE(PG8_SA(1, 0), cA + kstep, voffA); PG8_STAGE(PG8_SB(1, 1), cB + hstep + kstep, voffB);
        PG8_WAIT_V(6); PG8_BAR;
    } else {
        PG8_STAGE(PG8_SB(0, 0), cB, voffB); PG8_STAGE(PG8_SA(0, 0), cA, voffA); PG8_STAGE(PG8_SB(0, 1), cB + hstep, voffB); PG8_STAGE(PG8_SA(0, 1), cA + hstep, voffA);
        if (wr == 1) PG8_BAR;
        PG8_WAIT_V(4); PG8_BAR;
        PG8_STAGE(PG8_SB(1, 0), cB + kstep, voffB); PG8_STAGE(PG8_SA(1, 0), cA + kstep, voffA); PG8_STAGE(PG8_SB(1, 1), cB + hstep + kstep, voffB);
        PG8_WAIT_V(6); PG8_BAR;
    }
    for (;;) {
        const bool has_next = S.next(ui + 1, nxt);
        const char* nA = has_next ? (const char*)g.A + (size_t)nxt.pm * tstep : cA; const char* nB = has_next ? (const char*)g.Bt + (size_t)nxt.pn * tstep : cB;
        for (int t = 0; t < nt; t += 2) {
            const bool last = (t == nt - 2);
            const char* a1 = cA + (size_t)(t + 1) * kstep;
            const char* a2 = last ? nA : cA + (size_t)(t + 2) * kstep; const char* b2 = last ? nB : cB + (size_t)(t + 2) * kstep;
            const char* a3 = a2 + kstep; const char* b3 = b2 + kstep;
            if (last && has_next) S.a_ready(nxt);
            if constexpr (SP2) {
            PG8_LDB(B0, 0, 0); PG8_LDB(B1, 0, 1); PG8_SCHED; PG8_LDA(At, 0, 0); PG8_STAGE(PG8_SA(1, 1), a1 + hstep, voffA);
            PG8_WAIT_V(8); PG8_WAIT_L(0); PG8_BAR; PG8_MMA(0, 0, At, B0); PG8_MMA(0, 1, At, B1); PG8_BAR; PG8_SCHED;
            PG8_LDA(At, 0, 1); PG8_STAGE(PG8_SB(0, 0), b2, voffB); PG8_STAGE(PG8_SB(0, 1), b2 + hstep, voffB); PG8_STAGE(PG8_SA(0, 0), a2, voffA);
            PG8_WAIT_V(8); PG8_WAIT_L(0); PG8_BAR; PG8_MMA(1, 0, At, B0); PG8_MMA(1, 1, At, B1); PG8_BAR; PG8_SCHED;
            PG8_LDB(B0, 1, 0); PG8_LDB(B1, 1, 1); PG8_SCHED; PG8_LDA(At, 1, 0); PG8_STAGE(PG8_SA(0, 1), a2 + hstep, voffA);
            PG8_WAIT_V(8); PG8_WAIT_L(0); PG8_BAR; PG8_MMA(0, 0, At, B0); PG8_MMA(0, 1, At, B1); PG8_BAR; PG8_SCHED;
            PG8_LDA(At, 1, 1); PG8_STAGE(PG8_SB(1, 0), b3, voffB); PG8_STAGE(PG8_SB(1, 1), b3 + hstep, voffB); PG8_STAGE(PG8_SA(1, 0), a3, voffA);
            PG8_WAIT_V(8); PG8_WAIT_L(0); PG8_BAR; PG8_MMA(1, 0, At, B0); PG8_MMA(1, 1, At, B1); PG8_BAR; PG8_SCHED;
            } else {
            PG8_LDB(B0, 0, 0); PG8_SCHED; PG8_LDA(At, 0, 0); PG8_STAGE(PG8_SA(1, 1), a1 + hstep, voffA);
            PG8_WAIT_L(8); PG8_BAR; PG8_WAIT_L(0); PG8_MMA(0, 0, At, B0); PG8_BAR; PG8_SCHED;
            PG8_LDB(B1, 0, 1); PG8_STAGE(PG8_SB(0, 0), b2, voffB);
            PG8_BAR; PG8_WAIT_L(0); PG8_MMA(0, 1, At, B1); PG8_BAR;
            PG8_LDA(At, 0, 1); PG8_STAGE(PG8_SA(0, 0), a2, voffA);
            PG8_BAR; PG8_WAIT_L(0); PG8_MMA(1, 0, At, B0); PG8_BAR; PG8_SCHED;
            PG8_STAGE(PG8_SB(0, 1), b2 + hstep, voffB);
            PG8_WAIT_V(6); PG8_BAR; PG8_MMA(1, 1, At, B1); PG8_BAR;
            PG8_LDB(B0, 1, 0); PG8_SCHED; PG8_LDA(At, 1, 0); PG8_STAGE(PG8_SA(0, 1), a2 + hstep, voffA);
            PG8_WAIT_L(8); PG8_BAR; PG8_WAIT_L(0); PG8_MMA(0, 0, At, B0); PG8_BAR; PG8_SCHED;
            PG8_LDB(B1, 1, 1); PG8_STAGE(PG8_SB(1, 0), b3, voffB);
            PG8_BAR; PG8_WAIT_L(0); PG8_MMA(0, 1, At, B1); PG8_BAR;
            PG8_LDA(At, 1, 1); PG8_STAGE(PG8_SA(1, 0), a3, voffA);
            PG8_BAR; PG8_WAIT_L(0); PG8_MMA(1, 0, At, B0); PG8_BAR; PG8_SCHED;
            PG8_STAGE(PG8_SB(1, 1), b3 + hstep, voffB);
            PG8_WAIT_V(6); PG8_BAR; PG8_MMA(1, 1, At, B1); PG8_BAR;
            }
        }
        if constexpr (ALIGN_EPI) { if (wr == 0) PG8_BAR; }
        if constexpr (!Epi::AFTER_DRAIN) { E(acc, cur, wr, wc, fr, fq); S.done(cur); }
        if (!has_next) break;
#pragma unroll
        for (int a = 0; a < 2; ++a)
#pragma unroll
            for (int b = 0; b < 2; ++b)
#pragma unroll
                for (int m = 0; m < 4; ++m)
#pragma unroll
                    for (int n = 0; n < 2; ++n) acc[a][b][m][n] = (f32x4){0.f, 0.f, 0.f, 0.f};
        cur = nxt; cA = nA; cB = nB; ++ui;
        if constexpr (ALIGN_EPI) { if (wr == 1) PG8_BAR; }
    }
    PG8_WAIT_V(0);
    if constexpr (!ALIGN_EPI) { if (wr == 0) PG8_BAR; }
    PG8_BAR;
    if constexpr (Epi::AFTER_DRAIN) { E.fused(acc, cur, wr, wc, fr, fq, lds, wid, lane); S.done(cur); }
#undef PG8_SA
#undef PG8_SB
#undef PG8_STAGE
#undef PG8_LDA
#undef PG8_LDB
#undef PG8_MMA
#undef PG8_WAIT_V
#undef PG8_WAIT_L
#undef PG8_BAR
#undef PG8_SCHED
}
}
#define GAS __attribute__((address_space(1)))
#define LAS __attribute__((address_space(3)))
typedef unsigned short bf16;
typedef unsigned v4u __attribute__((ext_vector_type(4)));
typedef float f32x4 __attribute__((ext_vector_type(4)));
typedef short bf16x8 __attribute__((ext_vector_type(8)));
typedef GAS unsigned gu32;
typedef GAS unsigned long long gu64;
#define RLX_AGENT __ATOMIC_RELAXED, __HIP_MEMORY_SCOPE_AGENT
#define LDS_WAIT() asm volatile("s_waitcnt lgkmcnt(0)" ::: "memory")
#define VM_WAIT() asm volatile("s_waitcnt vmcnt(0)" ::: "memory")
__device__ __forceinline__ unsigned long long rt() { return __builtin_amdgcn_s_memrealtime(); }
__device__ __forceinline__ unsigned f2bf(float f) { unsigned u = __builtin_bit_cast(unsigned, f); return (u + 0x7fffu + ((u >> 16) & 1u)) >> 16; }
__device__ __forceinline__ unsigned pk2(float lo, float hi) { return f2bf(lo) | (f2bf(hi) << 16); }

#define XB_TMO      128
#define XB_XCNT(j)  (256  + 64 * (j))
#define XB_XSUB(j)  (1280 + 64 * (j))
#define XB_XGEN(j)  (2304 + 64 * (j))
#define XB_TOP      3328
#define XB_TOPGEN   3392
#define XCD_BAR_WORDS 3456
#define XB_SPIN_CAP (1u << 18)

__device__ __forceinline__ unsigned xb_ld(unsigned* p)              { return __hip_atomic_load(p, __ATOMIC_RELAXED, __HIP_MEMORY_SCOPE_AGENT); }
__device__ __forceinline__ unsigned xb_add(unsigned* p, unsigned v) { return __hip_atomic_fetch_add(p, v, __ATOMIC_RELAXED, __HIP_MEMORY_SCOPE_AGENT); }
__device__ __forceinline__ unsigned xb_xcc_id() { return (unsigned)__builtin_amdgcn_s_getreg((3 << 11) | 20) & 0xFu; }
#define XB_SPIN(cond, bar) do { unsigned _sp = 0; while (cond) { __builtin_amdgcn_s_sleep(1); \
    if ((++_sp & 255u) == 0u) { if (xb_ld(&(bar)[XB_TMO])) break; if (_sp > XB_SPIN_CAP) { atomicAdd(&(bar)[XB_TMO], 1u); break; } } } } while (0)

struct XcdBarrier {
    unsigned* bar; unsigned x;
    volatile LAS unsigned* st;
};

__device__ __forceinline__ XcdBarrier xcd_barrier_post(unsigned* bar, volatile LAS unsigned* st) {
    XcdBarrier b; b.bar = bar; b.x = xb_xcc_id(); b.st = st;
    if (threadIdx.x == 0) (void)xb_add(&bar[XB_XCNT(b.x)], 1u);
    return b;
}
__device__ __forceinline__ void xcd_barrier_complete(unsigned* bar, unsigned x, unsigned& nloc, unsigned& nx) {
    const unsigned G = gridDim.x * gridDim.y * gridDim.z;
    unsigned sum, cnt, mine, sp = 0u;
    for (;;) {
        sum = 0u; cnt = 0u; mine = 0u;
#pragma unroll
        for (unsigned j = 0; j < 16; ++j) { const unsigned c = xb_ld(&bar[XB_XCNT(j)]); sum += c; cnt += (c > 0u) ? 1u : 0u; mine = (j == x) ? c : mine; }
        if (sum == G) break;
        __builtin_amdgcn_s_sleep(1);
        if ((++sp & 255u) == 0u) { if (xb_ld(&bar[XB_TMO])) break; if (sp > XB_SPIN_CAP) { atomicAdd(&bar[XB_TMO], 1u); break; } }
    }
    nloc = mine > 0u ? mine : 1u; nx = cnt > 0u ? cnt : 1u;
}

__device__ __forceinline__ void xcd_barrier(const XcdBarrier& b) {
    asm volatile("s_waitcnt vmcnt(0)" ::: "memory");
    __syncthreads();
    if (threadIdx.x == 0) {
        unsigned* bar = b.bar;
        __builtin_amdgcn_s_waitcnt(0);
        unsigned nloc = b.st[0], nx = b.st[1];
        if (nloc == 0u) { xcd_barrier_complete(bar, b.x, nloc, nx); b.st[0] = nloc; b.st[1] = nx; }
        const unsigned old = xb_add(&bar[XB_XSUB(b.x)], 1u);
        const unsigned gen = old / nloc;
        if (old + 1u == (gen + 1u) * nloc) {
            __builtin_amdgcn_fence(__ATOMIC_RELEASE, "agent");
            asm volatile("s_waitcnt vmcnt(0)" ::: "memory");
            const unsigned og = xb_add(&bar[XB_TOP], 1u);
            const unsigned tg = og / nx;
            if (og + 1u == (tg + 1u) * nx) xb_add(&bar[XB_TOPGEN], 1u);
            else XB_SPIN(xb_ld(&bar[XB_TOPGEN]) == tg, bar);
            __builtin_amdgcn_fence(__ATOMIC_ACQUIRE, "agent");
            xb_add(&bar[XB_XGEN(b.x)], 1u);
            asm volatile("s_waitcnt vmcnt(0)" ::: "memory");
        } else {
            XB_SPIN(xb_ld(&bar[XB_XGEN(b.x)]) == gen, bar);
            __builtin_amdgcn_fence(__ATOMIC_ACQUIRE, "agent");
            asm volatile("s_waitcnt vmcnt(0)" ::: "memory");
        }
    }
    __syncthreads();
}
__device__ __forceinline__ float bf2f(unsigned short u) { return __builtin_bit_cast(float, (unsigned)u << 16); }
__device__ __forceinline__ float bflo(unsigned u) { return __builtin_bit_cast(float, u << 16); }
__device__ __forceinline__ float bfhi(unsigned u) { return __builtin_bit_cast(float, u & 0xffff0000u); }
__device__ __forceinline__ float wave_sum(float v) {
#pragma unroll
    for (int o = 1; o < 64; o <<= 1) v += __shfl_xor(v, o);
    return v;
}


namespace cs {
typedef short bf16x8 __attribute__((ext_vector_type(8)));
typedef short s16x4 __attribute__((ext_vector_type(4)));
typedef float f32x16 __attribute__((ext_vector_type(16)));
typedef float f32x2 __attribute__((ext_vector_type(2)));
typedef __bf16 bf16x2_t __attribute__((ext_vector_type(2)));
typedef unsigned u32x2 __attribute__((ext_vector_type(2)));
#define CS_MFMA(a, b, c) __builtin_amdgcn_mfma_f32_32x32x16_bf16((a), (b), (c), 0, 0, 0)
__device__ __forceinline__ unsigned pkbf(float lo, float hi) { return __builtin_bit_cast(unsigned, __builtin_convertvector((f32x2){lo, hi}, bf16x2_t)); }
template <int NCH> __device__ __forceinline__ unsigned img_off(unsigned row, unsigned ch) { return (128u * NCH) * (row >> 3) + 512u * (ch >> 2) + 64u * (row & 7) + 16u * ((ch & 3) ^ ((row >> 2) & 3)); }
template <int NCH> __device__ __forceinline__ bf16x8 row_read(LAS unsigned char* img, unsigned rowbase, int s, int r, int h) {
    return *(const LAS bf16x8*)(img + img_off<NCH>(rowbase + r, 2 * s + h));
}
template <int NCH> __device__ __forceinline__ unsigned tr_addr(unsigned lane, unsigned c, unsigned ks, unsigned t) {
    const unsigned h = lane >> 5, blk = (lane >> 4) & 1, q = (lane & 15) >> 2, p = lane & 3;
    return img_off<NCH>(16 * ks + 8 * h + 4 * t + q, 4 * c + 2 * blk + (p >> 1)) + 8 * (p & 1);
}
__device__ __forceinline__ void tr_read_ab(unsigned a0, unsigned a1, unsigned b0, unsigned b1, bf16x8& a, bf16x8& b) {
    s16x4 alo, ahi, blo, bhi;
    asm volatile("ds_read_b64_tr_b16 %0, %4\n\tds_read_b64_tr_b16 %1, %5\n\tds_read_b64_tr_b16 %2, %6\n\tds_read_b64_tr_b16 %3, %7\n\ts_waitcnt lgkmcnt(0)"
                 : "=&v"(alo), "=&v"(ahi), "=&v"(blo), "=&v"(bhi) : "v"(a0), "v"(a1), "v"(b0), "v"(b1) : "memory");
    a = __builtin_shufflevector(alo, ahi, 0, 1, 2, 3, 4, 5, 6, 7); b = __builtin_shufflevector(blo, bhi, 0, 1, 2, 3, 4, 5, 6, 7);
}
__device__ __forceinline__ bf16x8 tr_read_1(unsigned a0, unsigned a1) {
    s16x4 alo, ahi;
    asm volatile("ds_read_b64_tr_b16 %0, %2\n\tds_read_b64_tr_b16 %1, %3\n\ts_waitcnt lgkmcnt(0)" : "=&v"(alo), "=&v"(ahi) : "v"(a0), "v"(a1) : "memory");
    return __builtin_shufflevector(alo, ahi, 0, 1, 2, 3, 4, 5, 6, 7);
}
__device__ __forceinline__ int crow(int reg, int h) { return (reg & 3) + 8 * (reg >> 2) + 4 * h; }

struct ScanIO {
    const bf16* Qd; const bf16* Kd; int qk_ld;
    const bf16* V; int v_ld;
    const float* dec;
    float dec_const;
    bf16* Out; int out_ld;
    const bf16* SG; int sg_ld;
};

struct RR { unsigned e, o; };
template <int NCH> __device__ __forceinline__ RR rr_make(unsigned imgbase, unsigned row, unsigned h) { RR b; b.e = imgbase + img_off<NCH>(row, h); b.o = imgbase + img_off<NCH>(row, 2 + h); return b; }
__device__ __forceinline__ bf16x8 rr_read(LAS unsigned char* lds, const RR b, int s) { return *(const LAS bf16x8*)(lds + ((s & 1) ? b.o : b.e) + 512 * (s >> 1)); }
__device__ __forceinline__ bf16x8 tr8(LAS unsigned char* lds, unsigned a0, unsigned a1) {
    const s16x4 lo = __builtin_amdgcn_ds_read_tr16_b64_v4i16((LAS s16x4*)(lds + a0)), hi = __builtin_amdgcn_ds_read_tr16_b64_v4i16((LAS s16x4*)(lds + a1));
    return __builtin_shufflevector(lo, hi, 0, 1, 2, 3, 4, 5, 6, 7);
}

template <int DK, int DV, bool HGRN> __device__ __forceinline__ void chunk_scan(LAS unsigned char* lds, const ScanIO io) {
    constexpr int C = 64, NCHUNKS = 2048 / C, KS = DK / 16, NVT = DV / 32, NCHK = DK / 8, NCHV = DV / 8;
    constexpr int QD = 0, KD = C * DK * 2, V0 = 2 * C * DK * 2, VSZ = C * DV * 2, SDT = V0 + 2 * VSZ, PIM = SDT + DV * DK * 2, OB = PIM + C * C * 2, END = OB + C * DV * 4;
    static_assert(END <= 146944, "scan LDS map");
    constexpr int NQ = (C * NCHK) / 512, NV = (C * NCHV) / 512;
    static_assert(NQ * 512 == C * NCHK && NV * 512 == C * NCHV, "staging split");
    static_assert(NCHUNKS % 2 == 0, "the chunk loop is unrolled by two (two prefetch register sets)");
    constexpr unsigned KSTEP_K = 2 * 128 * NCHK, KSTEP_V = 2 * 128 * NCHV;
    const int wave0 = __builtin_amdgcn_readfirstlane(threadIdx.x >> 6); const unsigned lane0 = threadIdx.x & 63;
    f32x16 S0, S1, Z;
#pragma unroll
    for (int i = 0; i < 16; ++i) { S0[i] = 0.f; S1[i] = 0.f; Z[i] = 0.f; }
    v4u pqA[NQ], pkA[NQ], pvA[NV], pqB[NQ], pkB[NQ], pvB[NV];
    unsigned sgA[8], sgB[8]; f32x4 dvA[4], dvB[4];
#define CS_IDS() int wave = wave0; unsigned lane = lane0; asm volatile("" : "+s"(wave)); asm volatile("" : "+v"(lane)); \
        const unsigned r = lane & 31, h = lane >> 5; const int tid = wave * 64 + (int)lane; \
        const bool zw = HGRN ? true : (wave < 4); const int z_it = HGRN ? (wave >> 2) : (wave >> 1), z_vt = HGRN ? (wave & 3) : (wave & 1); \
        const int xw0 = HGRN ? 0 : 4; const bool xw = (wave >= xw0 && wave < xw0 + 3); const int xt = wave - xw0; const int x_jt = (xt == 2) ? 1 : 0, x_it = (xt == 0) ? 0 : 1; \
        const int s_kt = (2 * wave) / NVT, s_vt0 = (2 * wave) % NVT; (void)r; (void)h; (void)tid; (void)zw; (void)z_it; (void)z_vt; (void)xw; (void)x_jt; (void)x_it; (void)s_kt; (void)s_vt0
#define CS_LOAD_CHUNK(n_, pq, pk, pv, dv) do { const size_t rowb_ = (size_t)(n_) * C; \
        _Pragma("unroll") for (int i_ = 0; i_ < NQ; ++i_) { const int c_ = tid + 512 * i_, row_ = c_ / NCHK, ch_ = c_ % NCHK; \
            pq[i_] = *(const GAS v4u*)(io.Qd + (rowb_ + row_) * io.qk_ld + ch_ * 8); pk[i_] = *(const GAS v4u*)(io.Kd + (rowb_ + row_) * io.qk_ld + ch_ * 8); } \
        _Pragma("unroll") for (int i_ = 0; i_ < NV; ++i_) { const int c_ = tid + 512 * i_, row_ = c_ / NCHV, ch_ = c_ % NCHV; \
            pv[i_] = *(const GAS v4u*)(io.V + (rowb_ + row_) * io.v_ld + ch_ * 8); } \
        if (HGRN) { _Pragma("unroll") for (int g_ = 0; g_ < 4; ++g_) dv[g_] = *(const GAS f32x4*)(io.dec + (size_t)(n_) * 512 + 32 * s_kt + 8 * g_ + 4 * h); } } while (0)
#define CS_LOAD_SG(n_, sg) do { if (HGRN) { const size_t rowb_ = (size_t)(n_) * C; \
        _Pragma("unroll") for (int j_ = 0; j_ < 8; ++j_) sg[j_] = *(const GAS unsigned*)(io.SG + (rowb_ + 8 * wave + j_) * io.sg_ld + 2 * lane); } } while (0)
#define CS_STAGE_CHUNK(vbuf_, pq, pk, pv) do { \
        _Pragma("unroll") for (int i_ = 0; i_ < NQ; ++i_) { const int c_ = tid + 512 * i_, row_ = c_ / NCHK, ch_ = c_ % NCHK; const unsigned o_ = img_off<NCHK>(row_, ch_); \
            *(LAS v4u*)(lds + o_ + QD) = pq[i_]; *(LAS v4u*)(lds + o_ + KD) = pk[i_]; } \
        _Pragma("unroll") for (int i_ = 0; i_ < NV; ++i_) { const int c_ = tid + 512 * i_, row_ = c_ / NCHV, ch_ = c_ % NCHV; \
            *(LAS v4u*)(lds + img_off<NCHV>(row_, ch_) + V0 + (vbuf_) * VSZ) = pv[i_]; } } while (0)
#define CS_WRITE_SDT() do { \
        _Pragma("unroll") for (int g_ = 0; g_ < 4; ++g_) { \
            u32x2 w0_, w1_; w0_.x = pkbf(S0[4 * g_], S0[4 * g_ + 1]); w0_.y = pkbf(S0[4 * g_ + 2], S0[4 * g_ + 3]); w1_.x = pkbf(S1[4 * g_], S1[4 * g_ + 1]); w1_.y = pkbf(S1[4 * g_ + 2], S1[4 * g_ + 3]); \
            *(LAS u32x2*)(lds + SDT + img_off<NCHK>(32 * s_vt0 + r, 4 * s_kt + g_) + 8 * h) = w0_; \
            *(LAS u32x2*)(lds + SDT + img_off<NCHK>(32 * (s_vt0 + 1) + r, 4 * s_kt + g_) + 8 * h) = w1_; } } while (0)
#define CS_OUTPUT(n_, sg) do { const size_t rowb_ = (size_t)(n_) * C; const LAS float* ob_ = (const LAS float*)(lds + OB); \
        if (HGRN) { _Pragma("unroll") for (int j_ = 0; j_ < 8; ++j_) { const int row_ = 8 * wave + j_; const f32x2 x_ = *(const LAS f32x2*)(ob_ + row_ * DV + 2 * lane); \
                const float ss_ = wave_sum(x_.x * x_.x + x_.y * x_.y); const float rstd_ = 1.0f / sqrtf(ss_ * (1.0f / DV) + 1e-6f); \
                *(GAS unsigned*)(io.Out + (rowb_ + row_) * io.out_ld + 2 * lane) = pkbf(x_.x * rstd_ * bflo(sg[j_]), x_.y * rstd_ * bfhi(sg[j_])); } } \
        else { const int row_ = tid >> 3, c8_ = (tid & 7) * 8; const f32x4 a_ = *(const LAS f32x4*)(ob_ + row_ * DV + c8_), b_ = *(const LAS f32x4*)(ob_ + row_ * DV + c8_ + 4); \
            v4u w_; w_.x = pkbf(a_[0], a_[1]); w_.y = pkbf(a_[2], a_[3]); w_.z = pkbf(b_[0], b_[1]); w_.w = pkbf(b_[2], b_[3]); \
            *(GAS v4u*)(io.Out + (rowb_ + row_) * io.out_ld + c8_) = w_; } } while (0)

#define CS_ITER(n, pqX, pkX, pvX, sgX, dvX, pqY, pkY, pvY, sgY, dvY) do { \
        CS_IDS(); \
        const unsigned vb = V0 + ((n) & 1) * VSZ; \
          \
        if ((n) > 0) CS_OUTPUT((n) - 1, sgY);                          \
        CS_LOAD_SG((n), sgX);                                          \
        if ((n) + 2 < NCHUNKS) CS_LOAD_CHUNK((n) + 2, pqX, pkX, pvX, dvX); \
        if (xw) {                                                      \
            f32x16 x; \
            _Pragma("unroll") for (int i = 0; i < 16; ++i) x[i] = 0.f; \
            const RR ra = rr_make<NCHK>(KD, 32 * x_jt + r, h), rb = rr_make<NCHK>(QD, 32 * x_it + r, h); \
            _Pragma("unroll") for (int s = 0; s < KS; ++s) { const bf16x8 a = rr_read(lds, ra, s), b = rr_read(lds, rb, s); x = CS_MFMA(a, b, x); } \
            if (x_jt == x_it) { _Pragma("unroll") for (int i = 0; i < 16; ++i) x[i] = ((unsigned)crow(i, h) > r) ? 0.f : x[i]; } \
            _Pragma("unroll") for (int g = 0; g < 4; ++g) { u32x2 w; w.x = pkbf(x[4 * g], x[4 * g + 1]); w.y = pkbf(x[4 * g + 2], x[4 * g + 3]); \
                *(LAS u32x2*)(lds + PIM + img_off<8>(32 * x_it + r, 4 * x_jt + g) + 8 * h) = w; } \
        } \
        if (zw) {                                                      \
            _Pragma("unroll") for (int i = 0; i < 16; ++i) Z[i] = 0.f; \
            const RR ra = rr_make<NCHK>(QD, 32 * z_it + r, h), rb = rr_make<NCHK>(SDT, 32 * z_vt + r, h); \
            _Pragma("unroll") for (int s = 0; s < KS; ++s) { const bf16x8 a = rr_read(lds, ra, s), b = rr_read(lds, rb, s); Z = CS_MFMA(a, b, Z); } \
        } \
        {                                                              \
            const unsigned tk0 = KD + tr_addr<NCHK>(lane, s_kt, 0, 0), tk1 = KD + tr_addr<NCHK>(lane, s_kt, 0, 1); \
            const unsigned t0a = vb + tr_addr<NCHV>(lane, s_vt0, 0, 0), t0b = vb + tr_addr<NCHV>(lane, s_vt0, 0, 1); \
            const unsigned t1a = vb + tr_addr<NCHV>(lane, s_vt0 + 1, 0, 0), t1b = vb + tr_addr<NCHV>(lane, s_vt0 + 1, 0, 1); \
            _Pragma("unroll") for (int ks = 0; ks < C / 16; ++ks) { \
                const bf16x8 a = tr8(lds, tk0 + ks * KSTEP_K, tk1 + ks * KSTEP_K), b0 = tr8(lds, t0a + ks * KSTEP_V, t0b + ks * KSTEP_V), b1 = tr8(lds, t1a + ks * KSTEP_V, t1b + ks * KSTEP_V); \
                S0 = CS_MFMA(a, b0, S0); S1 = CS_MFMA(a, b1, S1); } \
        } \
        __syncthreads(); \
          \
        if (zw) {                                                      \
            const RR rp = rr_make<8>(PIM, 32 * z_it + r, h); \
            const unsigned tza = vb + tr_addr<NCHV>(lane, z_vt, 0, 0), tzb = vb + tr_addr<NCHV>(lane, z_vt, 0, 1); \
            _Pragma("unroll") for (int s = 0; s < 4; ++s) { if (s < 2 * (z_it + 1)) { const bf16x8 a = rr_read(lds, rp, s); \
                    const bf16x8 b = tr8(lds, tza + s * KSTEP_V, tzb + s * KSTEP_V); Z = CS_MFMA(a, b, Z); } } \
            LAS float* ob = (LAS float*)(lds + OB) + (32 * z_it + 4 * h) * DV + 32 * z_vt + r; \
            _Pragma("unroll") for (int i = 0; i < 16; ++i) ob[((i & 3) + 8 * (i >> 2)) * DV] = Z[i]; \
        } \
        if ((n) + 1 < NCHUNKS) { \
            if (HGRN) { _Pragma("unroll") for (int i = 0; i < 16; ++i) { const float d = dvY[i >> 2][i & 3]; S0[i] *= d; S1[i] *= d; } } \
            else { _Pragma("unroll") for (int i = 0; i < 16; ++i) { S0[i] *= io.dec_const; S1[i] *= io.dec_const; } } \
            CS_WRITE_SDT(); \
            CS_STAGE_CHUNK(((n) + 1) & 1, pqY, pkY, pvY); \
        } \
        __syncthreads(); \
    } while (0)

    { CS_IDS(); CS_WRITE_SDT(); CS_LOAD_CHUNK(0, pqA, pkA, pvA, dvA); CS_STAGE_CHUNK(0, pqA, pkA, pvA); CS_LOAD_CHUNK(1, pqB, pkB, pvB, dvB); }
    __syncthreads();
    for (int n = 0; n < NCHUNKS; n += 2) {
        CS_ITER(n, pqA, pkA, pvA, sgA, dvA, pqB, pkB, pvB, sgB, dvB);
        CS_ITER(n + 1, pqB, pkB, pvB, sgB, dvB, pqA, pkA, pvA, sgA, dvA);
    }
    { CS_IDS(); CS_OUTPUT(NCHUNKS - 1, sgB); }
    __syncthreads();
#undef CS_IDS
#undef CS_LOAD_CHUNK
#undef CS_LOAD_SG
#undef CS_STAGE_CHUNK
#undef CS_WRITE_SDT
#undef CS_OUTPUT
#undef CS_ITER
}
}

constexpr int NWAVES = 8;
using pg8::RMS_EPS;
constexpr int BATCH = 8, SEQ = 2048, D = 1024, M = BATCH * SEQ;
constexpr int EVEN_IN = 3584, ODD_IN = 6144, FFH = 2816, FF2 = 5632;
constexpr int N_PHASES = 14;
#ifndef MK_N_LAUNCHES
#define MK_N_LAUNCHES 1
#endif
constexpr int N_LAUNCHES = MK_N_LAUNCHES;
#ifndef PROBE_MASK
#define PROBE_MASK 0
#endif
#ifndef PROBE_REPS
#define PROBE_REPS 1
#endif

constexpr size_t MiB = 1u << 20;
constexpr size_t WS_CTL = 0, CTL_ZERO_BYTES = 64 * 1024;
constexpr size_t WS_PART = 1 * MiB;
constexpr size_t WS_W_ODD_IN = 2 * MiB, WS_W_ODD_OUT = 14 * MiB, WS_W_FFN_IN1 = 18 * MiB, WS_W_FFN_OUT1 = 2 * MiB  ;
constexpr size_t WS_HB = 32 * MiB;
constexpr size_t WS_W_EVEN_IN = 64 * MiB, WS_W_EVEN_OUT = 71 * MiB, WS_W_FFN_IN0 = 73 * MiB, WS_W_FFN_OUT0 = 84 * MiB;
constexpr size_t WS_U = 96 * MiB, WS_BB = 112 * MiB, WS_SQ = 128 * MiB, WS_LOGF = 144 * MiB, WS_IV = 176 * MiB, WS_SG0 = 192 * MiB, WS_MIX0 = 208 * MiB;
constexpr size_t WS_KD = 240 * MiB;
constexpr size_t WS_DEC = 29 * MiB;
constexpr size_t WS_ACT0 = 96 * MiB;
constexpr size_t WS_Q = 64 * MiB, WS_K = 96 * MiB, WS_V = 128 * MiB, WS_G = 192 * MiB;
constexpr size_t WS_ACT1 = 64 * MiB;
constexpr size_t WS_END = 256 * MiB;
constexpr int CW_BAR = 4096;

constexpr int RING_OFF = 0, RING_BYTES = 131072;
constexpr int LDS_BYTES = 147456;
constexpr int LDSCTL_OFF = LDS_BYTES - 512, MISC_OFF = LDSCTL_OFF + 320;

struct Args { const float* in[15]; float* out; unsigned char* ws; int ph_lo, ph_hi, li, pad; };

struct MatDesc { const float* W; int K, N; bf16* WT; const float* scale; int scale_from; int map; };
__device__ __forceinline__ int map_col(int map, int n) {
    if (map == 1) { const int seg = n >> 9, c = n & 511; if (seg == 0) return 256 * (c >> 7) + (c & 127); if (seg == 2) return 256 * (c >> 7) + 128 + (c & 127); if (seg == 1) return 1024 + c; return n; }
    if (map == 2) { if (n < FFH) return 256 * (n >> 7) + (n & 127); const int c = n - FFH; return 256 * (c >> 7) + 128 + (c & 127); }
    return n;
}
__device__ __forceinline__ void transpose_item(const MatDesc& md, LAS float* scr, int item, int lane) {
    const int N = md.N, K = md.K, nblk = N / 32, kb = item / nblk, nb = item % nblk, k0 = 64 * kb, n0 = 32 * nb;
#pragma unroll 8
    for (int i = 0; i < 32; ++i) { const int kk = 2 * i + (lane >> 5); const int k = k0 + kk; float w = md.W[(size_t)k * N + n0 + (lane & 31)];
        if (md.scale && k >= md.scale_from) w *= md.scale[k - md.scale_from];
        scr[kk * 33 + (lane & 31)] = w; }
    LDS_WAIT(); asm volatile("" ::: "memory");
    const int c = lane & 7; const int d0 = map_col(md.map, n0);
#pragma unroll
    for (int j = 0; j < 4; ++j) { const int n = (lane >> 3) + 8 * j; const LAS float* s = scr + (8 * c) * 33 + n;
        v4u o; o.x = pk2(s[0 * 33], s[1 * 33]); o.y = pk2(s[2 * 33], s[3 * 33]); o.z = pk2(s[4 * 33], s[5 * 33]); o.w = pk2(s[6 * 33], s[7 * 33]);
        *(GAS v4u*)(md.WT + (size_t)(d0 + n) * K + k0 + 8 * c) = o; }
    LDS_WAIT(); asm volatile("" ::: "memory");
}
__device__ __forceinline__ MatDesc mat_desc(const Args& a, int mat) {
    unsigned char* ws = a.ws; MatDesc d;
    switch (mat) {
    case 0: d = MatDesc{a.in[5], D, EVEN_IN, (bf16*)(ws + WS_W_EVEN_IN), a.in[2], 0, 1}; break;
    case 1: d = MatDesc{a.in[9], D, D, (bf16*)(ws + WS_W_EVEN_OUT), a.in[8], 512, 0}; break;
    case 2: d = MatDesc{a.in[13], D, FF2, (bf16*)(ws + WS_W_FFN_IN0), a.in[3], 0, 2}; break;
    case 3: d = MatDesc{a.in[14], FFH, D, (bf16*)(ws + WS_W_FFN_OUT0), nullptr, 0, 0}; break;
    case 4: d = MatDesc{a.in[10], D, ODD_IN, (bf16*)(ws + WS_W_ODD_IN), a.in[2] + D, 0, 0}; break;
    case 5: d = MatDesc{a.in[12], 2048, D, (bf16*)(ws + WS_W_ODD_OUT), a.in[11], 0, 0}; break;
    case 6: d = MatDesc{a.in[13] + (size_t)D * FF2, D, FF2, (bf16*)(ws + WS_W_FFN_IN1), a.in[3] + D, 0, 2}; break;
    default: d = MatDesc{a.in[14] + (size_t)FFH * D, FFH, D, (bf16*)(ws + WS_W_FFN_OUT1), nullptr, 0, 0}; break;
    }
    return d;
}
__device__ __forceinline__ void convert_mats(const Args& a, int mat_lo, int mat_hi, LAS float* scr, int gw, int NGW, int lane) {
    for (int mat = mat_lo; mat < mat_hi; ++mat) { const MatDesc md = mat_desc(a, mat); const int nitems = (md.K / 64) * (md.N / 32);
        for (int it = gw; it < nitems; it += NGW) transpose_item(md, scr, it, lane); }
}
__device__ __forceinline__ void x_row_prep(const float* xrow, bf16* orow, float* prow, int lane) {
    const GAS f32x4* xr = (const GAS f32x4*)xrow + lane; f32x4 v[4]; float s = 0.f;
#pragma unroll
    for (int j = 0; j < 4; ++j) { v[j] = xr[64 * j]; s += (v[j].x * v[j].x + v[j].y * v[j].y) + (v[j].z * v[j].z + v[j].w * v[j].w); }
    s = wave_sum(s);
    GAS unsigned long long* o8 = (GAS unsigned long long*)orow + lane;
#pragma unroll
    for (int j = 0; j < 4; ++j) o8[64 * j] = (unsigned long long)pk2(v[j].x, v[j].y) | ((unsigned long long)pk2(v[j].z, v[j].w) << 32);
    if (lane < 16) prow[lane] = (lane == 0) ? s : 0.f;
}

__device__ __forceinline__ float exp_fast(float x) { return __builtin_amdgcn_exp2f(x * 1.44269504089f); }
__device__ __forceinline__ void hgrn_prep(LAS unsigned char* lds, unsigned char* ws, int unit) {
    const int tid = threadIdx.x, k = tid & 127, tq = tid >> 7; const int b = unit >> 7, h = (unit >> 5) & 3, n = unit & 31;
    LAS float* part = (LAS float*)lds;
    const size_t row0 = (size_t)b * SEQ + n * 64 + 16 * tq; const int col = h * 128 + k;
    const float* LF = (const float*)(ws + WS_LOGF); bf16* SQ = (bf16*)(ws + WS_SQ); bf16* KDG = (bf16*)(ws + WS_KD);
    float l[16], c[16]; float run = 0.f;
#pragma unroll
    for (int j = 0; j < 16; ++j) { l[j] = LF[(row0 + j) * 512 + col]; run += l[j]; c[j] = run; }
    part[tq * 128 + k] = run;
    __syncthreads();
    const float p0 = part[k], p1 = part[128 + k], p2 = part[256 + k], p3 = part[384 + k];
    const float bl = (p0 + p1) + (p2 + p3); const float pre = (tq > 0 ? p0 : 0.f) + (tq > 1 ? p1 : 0.f) + (tq > 2 ? p2 : 0.f);
#pragma unroll
    for (int j = 0; j < 16; ++j) { const float bt = pre + c[j]; const float q = bf2f(SQ[(row0 + j) * 512 + col]); const float f = exp_fast(l[j]);
        SQ[(row0 + j) * 512 + col] = (bf16)f2bf(q * exp_fast(bt - bl)); KDG[(row0 + j) * 512 + col] = (bf16)f2bf((1.0f - f) * exp_fast(bl - bt)); }
    if (tq == 0) ((float*)(ws + WS_DEC))[(size_t)(b * 32 + n) * 512 + col] = exp_fast(bl);
    __syncthreads();
}

template <int K> __device__ __forceinline__ void run_phase(const Args& args, LAS unsigned char* lds, float* Hout) {
    const int tid = threadIdx.x, lane = tid & 63, wave = __builtin_amdgcn_readfirstlane(tid >> 6);
    const int G = gridDim.x; const int bx = blockIdx.x; const int vcu = (G % 8 == 0) ? (bx % 8) * (G / 8) + bx / 8 : bx;
    unsigned char* ws = args.ws;
    const int gw = vcu * NWAVES + wave, NGW = G * NWAVES;
    float* PART = (float*)(ws + WS_PART);
    bf16* HB = (bf16*)(ws + WS_HB);
    const float* x = args.in[0];
    (void)lane; (void)gw; (void)NGW; (void)PART; (void)HB; (void)x; (void)Hout;
    if constexpr (K == 0) {
        LAS float* scr = (LAS float*)(lds + RING_OFF + wave * 16384);
        convert_mats(args, 0, 7, scr, gw, NGW, lane);
        for (int m = gw; m < M; m += NGW) x_row_prep(x + (size_t)m * D, HB + (size_t)m * D, PART + (size_t)m * 16, lane);
    }
    if constexpr (K == 1) {
        pg8::Gemm g{HB, (const bf16*)(ws + WS_W_EVEN_IN), M, EVEN_IN, D}; pg8::StaticOrder S; S.init(M, EVEN_IN, G, bx);
        pg8::EpiL0In E{PART, (bf16*)(ws + WS_U), (bf16*)(ws + WS_BB), (bf16*)(ws + WS_SQ), (bf16*)(ws + WS_IV), (bf16*)(ws + WS_SG0), (float*)(ws + WS_LOGF), args.in[7]};
        pg8::gemm_phase<pg8::EpiL0In, pg8::StaticOrder, true, true>(lds + RING_OFF, g, S, E);
    }
    if constexpr (K == 2) {
        for (int u = bx; u < BATCH * 4 * 32; u += G) hgrn_prep(lds, ws, u);
    }
    if constexpr (K == 3) {
        for (int u = bx; u < 32; u += G) { const int b = u >> 2, h = u & 3; const size_t r5 = (size_t)b * SEQ * 512 + h * 128;
            cs::ScanIO io; io.Qd = (const bf16*)(ws + WS_SQ) + r5; io.Kd = (const bf16*)(ws + WS_KD) + r5; io.qk_ld = 512; io.V = (const bf16*)(ws + WS_IV) + r5; io.v_ld = 512;
            io.dec = (const float*)(ws + WS_DEC) + (size_t)b * 32 * 512 + h * 128; io.dec_const = 0.f;
            io.Out = (bf16*)(ws + WS_MIX0) + (size_t)b * SEQ * 1024 + 512 + h * 128; io.out_ld = 1024; io.SG = (const bf16*)(ws + WS_SG0) + r5; io.sg_ld = 512;
            cs::chunk_scan<128, 128, true>(lds, io); }
        { int cb, ncb; if (G > 32) { cb = bx - 32; ncb = G - 32; } else { cb = bx; ncb = G; }
          if (cb >= 0) { const bf16* U = (const bf16*)(ws + WS_U); const bf16* Bb = (const bf16*)(ws + WS_BB); bf16* MIX = (bf16*)(ws + WS_MIX0); const float* cw = args.in[6];
            for (int it = cb * 512 + tid; it < M * 64; it += ncb * 512) { const int row = it >> 6, c0 = (it & 63) * 8, t = row & (SEQ - 1);
                const v4u u0 = *(const GAS v4u*)(U + (size_t)row * 512 + c0); v4u u1 = (v4u){0u, 0u, 0u, 0u}, u2 = u1;
                if (t >= 1) u1 = *(const GAS v4u*)(U + (size_t)(row - 1) * 512 + c0);
                if (t >= 2) u2 = *(const GAS v4u*)(U + (size_t)(row - 2) * 512 + c0);
                const v4u bb = *(const GAS v4u*)(Bb + (size_t)row * 512 + c0);
                float y[8];
#pragma unroll
                for (int p = 0; p < 4; ++p) { const int c = c0 + 2 * p;
                    y[2 * p] = bflo(bb[p]) * (cw[c] * bflo(u2[p]) + cw[512 + c] * bflo(u1[p]) + cw[1024 + c] * bflo(u0[p]));
                    y[2 * p + 1] = bfhi(bb[p]) * (cw[c + 1] * bfhi(u2[p]) + cw[512 + c + 1] * bfhi(u1[p]) + cw[1024 + c + 1] * bfhi(u0[p])); }
                v4u o; o.x = pk2(y[0], y[1]); o.y = pk2(y[2], y[3]); o.z = pk2(y[4], y[5]); o.w = pk2(y[6], y[7]);
                *(GAS v4u*)(MIX + (size_t)row * 1024 + c0) = o; } } }
    }
    if constexpr (K == 4) {
        pg8::Gemm g{(const bf16*)(ws + WS_MIX0), (const bf16*)(ws + WS_W_EVEN_OUT), M, D, D}; pg8::StaticOrder S; S.init(M, D, G, bx);
        pg8::EpiResid E{x, Hout, HB, PART};
        pg8::gemm_phase<pg8::EpiResid, pg8::StaticOrder, true, true>(lds + RING_OFF, g, S, E);
    }
    if constexpr (K == 5) {
        pg8::Gemm g{HB, (const bf16*)(ws + WS_W_FFN_IN0), M, FF2, D}; pg8::StaticOrder S; S.init(M, FF2, G, bx);
        pg8::EpiSwiGLU E{PART, (bf16*)(ws + WS_ACT0)};
        pg8::gemm_phase<pg8::EpiSwiGLU, pg8::StaticOrder, true, true>(lds + RING_OFF, g, S, E);
    }
    if constexpr (K == 6) {
        pg8::Gemm g{(const bf16*)(ws + WS_ACT0), (const bf16*)(ws + WS_W_FFN_OUT0), M, D, FFH}; pg8::StaticOrder S; S.init(M, D, G, bx);
        pg8::EpiResid E{args.out, Hout, HB, PART};
        pg8::gemm_phase<pg8::EpiResid, pg8::StaticOrder, true, true>(lds + RING_OFF, g, S, E);
    }
    if constexpr (K == 7) {
        pg8::Gemm g{HB, (const bf16*)(ws + WS_W_ODD_IN), M, ODD_IN, D}; pg8::StaticOrder S; S.init(M, ODD_IN, G, bx);
        pg8::EpiL1In E{PART, (const int*)args.in[1], (bf16*)(ws + WS_Q), (bf16*)(ws + WS_K), (bf16*)(ws + WS_V), (bf16*)(ws + WS_G)};
        pg8::gemm_phase<pg8::EpiL1In, pg8::StaticOrder, true, true>(lds + RING_OFF, g, S, E);
    }
    if constexpr (K == 8) {
        for (int u0 = bx; u0 < 256; u0 += G) { const int u = (G == 256) ? (((u0 & 7) * 4 + (u0 >> 6)) * 8 + ((u0 >> 3) & 7)) : u0;
            const int b = u >> 5, h = (u >> 3) & 3, vs = u & 7;
            const float lg = __builtin_amdgcn_logf(1.0f - exp2f(-5.0f - (float)h));
            cs::ScanIO io; io.Qd = (const bf16*)(ws + WS_Q) + (size_t)b * SEQ * 1024 + h * 256; io.Kd = (const bf16*)(ws + WS_K) + (size_t)b * SEQ * 1024 + h * 256; io.qk_ld = 1024;
            io.V = (const bf16*)(ws + WS_V) + (size_t)b * SEQ * 2048 + h * 512 + vs * 64; io.v_ld = 2048; io.dec = nullptr; io.dec_const = __builtin_amdgcn_exp2f(64.0f * lg);
            io.Out = (bf16*)(ws + WS_V) + (size_t)b * SEQ * 2048 + h * 512 + vs * 64; io.out_ld = 2048; io.SG = nullptr; io.sg_ld = 0;
            cs::chunk_scan<256, 64, false>(lds, io); }
    }
    if constexpr (K == 9) {
        LAS float* scr = (LAS float*)(lds + RING_OFF + wave * 16384);
        convert_mats(args, 7, 8, scr, gw, NGW, lane);
        const bf16* O = (const bf16*)(ws + WS_V); bf16* Gp = (bf16*)(ws + WS_G);
        for (int it = gw; it < M * 4; it += NGW) { const size_t off = (size_t)(it >> 2) * 2048 + (it & 3) * 512 + lane * 8;
            const v4u ov = *(const GAS v4u*)(O + off); const v4u gv = *(const GAS v4u*)(Gp + off);
            float o[8]; float s = 0.f;
#pragma unroll
            for (int p = 0; p < 4; ++p) { o[2 * p] = bflo(ov[p]); o[2 * p + 1] = bfhi(ov[p]); s += o[2 * p] + o[2 * p + 1]; }
            const float mu = wave_sum(s) * (1.0f / 512.0f); float q = 0.f;
#pragma unroll
            for (int e = 0; e < 8; ++e) { o[e] -= mu; q += o[e] * o[e]; }
            const float rstd = 1.0f / sqrtf(wave_sum(q) * (1.0f / 512.0f) + RMS_EPS);
            v4u w;
#pragma unroll
            for (int p = 0; p < 4; ++p) w[p] = pk2(o[2 * p] * rstd * bflo(gv[p]), o[2 * p + 1] * rstd * bfhi(gv[p]));
            *(GAS v4u*)(Gp + off) = w; }
    }
    if constexpr (K == 10) {
        pg8::Gemm g{(const bf16*)(ws + WS_G), (const bf16*)(ws + WS_W_ODD_OUT), M, D, 2048}; pg8::StaticOrder S; S.init(M, D, G, bx);
        pg8::EpiResid E{args.out, Hout, HB, PART};
        pg8::gemm_phase<pg8::EpiResid, pg8::StaticOrder, true, true>(lds + RING_OFF, g, S, E);
    }
    if constexpr (K == 11) {
        pg8::Gemm g{HB, (const bf16*)(ws + WS_W_FFN_IN1), M, FF2, D}; pg8::StaticOrder S; S.init(M, FF2, G, bx);
        pg8::EpiSwiGLU E{PART, (bf16*)(ws + WS_ACT1)};
        pg8::gemm_phase<pg8::EpiSwiGLU, pg8::StaticOrder, true, true>(lds + RING_OFF, g, S, E);
    }
    if constexpr (K == 12) {
        pg8::Gemm g{(const bf16*)(ws + WS_ACT1), (const bf16*)(ws + WS_W_FFN_OUT1), M, D, FFH}; pg8::StaticOrder S; S.init(M, D, G, bx);
        pg8::EpiResid E{args.out, Hout, HB, PART};
        pg8::gemm_phase<pg8::EpiResid, pg8::StaticOrder, true, true>(lds + RING_OFF, g, S, E);
    }
    if constexpr (K == 13) {
        const float* wf = args.in[4];
        for (int m = gw; m < M; m += NGW) { GAS f32x4* hr = (GAS f32x4*)(args.out + (size_t)m * D) + lane; f32x4 v[4]; float s = 0.f;
#pragma unroll
            for (int j = 0; j < 4; ++j) { v[j] = hr[64 * j]; s += (v[j].x * v[j].x + v[j].y * v[j].y) + (v[j].z * v[j].z + v[j].w * v[j].w); }
            const float rs = 1.0f / sqrtf(wave_sum(s) * (1.0f / 1024.0f) + RMS_EPS);
#pragma unroll
            for (int j = 0; j < 4; ++j) { const f32x4 w = *((const GAS f32x4*)wf + lane + 64 * j); hr[64 * j] = v[j] * rs * w; } }
    }
}

__global__ void __launch_bounds__(NWAVES * 64, 2) fwd_kernel(Args args) {
    extern __shared__ __attribute__((aligned(16))) unsigned char lds_raw[];
    LAS unsigned char* lds = (LAS unsigned char*)lds_raw;
    volatile LAS unsigned* MISC = (volatile LAS unsigned*)(lds + MISC_OFF);
    gu32* ctl = (gu32*)(args.ws + WS_CTL);
    for (int u = threadIdx.x; u < (LDS_BYTES - LDSCTL_OFF) / 4; u += NWAVES * 64) ((LAS unsigned*)(lds + LDSCTL_OFF))[u] = 0u;
    __syncthreads();
    XcdBarrier bar; bar.bar = (unsigned*)(ctl + CW_BAR); bar.x = 0; bar.st = nullptr;
    if (N_LAUNCHES == 1) bar = xcd_barrier_post((unsigned*)(ctl + CW_BAR), MISC + 8);
#define GRID_BAR() do { if (N_LAUNCHES == 1) xcd_barrier(bar); } while (0)
    const int lo = args.ph_lo, hi = args.ph_hi;
#define IN(k) (lo <= (k) && (k) < hi)
#define PHASE(k) do { if (IN(k)) { run_phase<k>(args, lds, args.out); if ((k) + 1 < N_PHASES && IN((k) + 1)) GRID_BAR(); } } while (0)
    PHASE(0); PHASE(1); PHASE(2); PHASE(3); PHASE(4); PHASE(5); PHASE(6); PHASE(7); PHASE(8); PHASE(9); PHASE(10); PHASE(11); PHASE(12); PHASE(13);
#define REPLAY(k) do { if ((PROBE_MASK >> (k)) & 1) { for (int rep_ = 0; rep_ < PROBE_REPS; ++rep_) { GRID_BAR(); run_phase<k>(args, lds, (float*)(args.ws + 192 * MiB)); } } } while (0)
    REPLAY(0); REPLAY(1); REPLAY(2); REPLAY(3); REPLAY(4); REPLAY(5); REPLAY(6); REPLAY(7); REPLAY(8); REPLAY(9); REPLAY(10); REPLAY(11); REPLAY(12);
#undef IN
#undef PHASE
#undef REPLAY
#undef GRID_BAR
}

extern "C" void kernel_launch(void* const* d_in, const int* in_sizes, int n_in, void* d_out, int out_size, void* d_ws, size_t ws_size, hipStream_t stream) {
    static int grid = 0;
    if (grid == 0) {
        if (n_in != 15 || in_sizes[0] != M * D || out_size != M * D || ws_size < WS_END) { fprintf(stderr, "kernel_launch: unexpected problem shape (n_in %d, in0 %d, out %d, ws %zu); nothing launched\n", n_in, n_in > 0 ? in_sizes[0] : -1, out_size, ws_size); grid = -1; return; }
        int dev = 0, cus = 0, per_cu = 0;
        if (hipGetDevice(&dev) != hipSuccess || hipDeviceGetAttribute(&cus, hipDeviceAttributeMultiprocessorCount, dev) != hipSuccess) { grid = -1; return; }
        if (hipFuncSetAttribute((const void*)fwd_kernel, hipFuncAttributeMaxDynamicSharedMemorySize, LDS_BYTES) != hipSuccess) { fprintf(stderr, "kernel_launch: hipFuncSetAttribute failed\n"); grid = -1; return; }
        if (hipOccupancyMaxActiveBlocksPerMultiprocessor(&per_cu, (const void*)fwd_kernel, NWAVES * 64, LDS_BYTES) != hipSuccess || per_cu < 1)
            fprintf(stderr, "kernel_launch: note: occupancy query reports %d workgroups per CU\n", per_cu);
        (void)hipGetLastError();
        grid = cus;
    }
    if (grid < 0) return;
    if (hipMemsetAsync((char*)d_ws + WS_CTL, 0, CTL_ZERO_BYTES, stream) != hipSuccess) { fprintf(stderr, "kernel_launch: hipMemsetAsync failed\n"); return; }
    Args a{};
    for (int i = 0; i < 15; ++i) a.in[i] = (const float*)d_in[i];
    a.out = (float*)d_out; a.ws = (unsigned char*)d_ws;
    for (int li = 0; li < N_LAUNCHES; ++li) {
        if (N_LAUNCHES == 1) { a.ph_lo = 0; a.ph_hi = N_PHASES; } else { a.ph_lo = li; a.ph_hi = li + 1; }
        a.li = li;
        hipLaunchKernelGGL(fwd_kernel, dim3(grid), dim3(NWAVES * 64), LDS_BYTES, stream, a);
        const hipError_t le = hipPeekAtLastError();
        if (le != hipSuccess) { fprintf(stderr, "kernel_launch: launch %d failed: %s\n", li, hipGetErrorName(le)); break; }
    }
}
```

```cpp
#include <hip/hip_runtime.h>
#include <cstdio>
#include <cstdint>
namespace pg8 {
#define PG8_LAS __attribute__((address_space(3)))
typedef unsigned short bf16_t;
typedef short bf16x8 __attribute__((ext_vector_type(8)));
typedef float f32x4 __attribute__((ext_vector_type(4)));
typedef unsigned u32x4 __attribute__((ext_vector_type(4)));
constexpr int BM = 256, BK = 64, HALF = 128, HTB = HALF * BK * 2  , STAGE_BYTES = 8 * HTB, NXCD = 8, WGM = 8;

__host__ __device__ __forceinline__ int lds_byte(int r, int c) { const int st = (r >> 4) * 2 + (c >> 5), rr = r & 15, cc = c & 31, ob = rr * 64 + cc * 2; return st * 1024 + (ob ^ (((ob >> 9) & 1) << 5)); }
__host__ __device__ __forceinline__ void stage_rc(int b, int& R, int& C) { const int st = b / 1024, sb = b % 1024, swz = sb ^ (((sb >> 9) & 1) << 5); R = (st >> 1) * 16 + swz / 64; C = (st & 1) * 32 + (swz % 64) / 2; }
__host__ __device__ __forceinline__ int perm32(int rho) { const int n = rho >> 4, i = rho & 15; return 8 * (i >> 2) + 4 * n + (i & 3); }

struct Unit { int pm, pn; };
struct Gemm { const bf16_t* A; const bf16_t* Bt; int M, N, K; };

struct StaticOrder {
    int nM, nN, nwg, G, c;
    __host__ __device__ void init(int M, int N, int G_, int c_) { nM = M / BM; nN = N / BM; nwg = nM * nN; G = G_; c = c_; }
    __host__ __device__ bool next(int i, Unit& u) const {
        const long L = (long)i * G + c; if (L >= nwg) return false;
        int wgid = (int)L; { const int q = nwg / NXCD, r = nwg % NXCD, xcd = wgid % NXCD, off = wgid / NXCD; wgid = (xcd < r ? xcd * (q + 1) : r * (q + 1) + (xcd - r) * q) + off; }
        const int nig = WGM * nN, gid = wgid / nig, fm = gid * WGM, gsz = (nM - fm) < WGM ? (nM - fm) : WGM;
        u.pm = fm + ((wgid % nig) % gsz); u.pn = (wgid % nig) / gsz; return true;
    }
    __device__ __forceinline__ void a_ready(const Unit&) const {}
    __device__ __forceinline__ void done(const Unit&) const {}
};

__device__ __forceinline__ unsigned cvt_pk_bf16(float lo, float hi) { unsigned r; asm volatile("v_cvt_pk_bf16_f32 %0, %1, %2" : "=v"(r) : "v"(lo), "v"(hi)); return r; }
__device__ __forceinline__ float fast_rcp(float x) { return __builtin_amdgcn_rcpf(x); }
__device__ __forceinline__ float fast_exp(float x) { return __builtin_amdgcn_exp2f(x * 1.44269504089f); }
__device__ __forceinline__ float fast_log(float x) { return __builtin_amdgcn_logf(x) * 0.69314718056f; }
__device__ __forceinline__ float silu_f(float x) { return x * fast_rcp(1.0f + fast_exp(-x)); }
__device__ __forceinline__ float sigmoid_f(float x) { return fast_rcp(1.0f + fast_exp(-x)); }
constexpr float RMS_EPS = 1e-6f;
__device__ __forceinline__ float row_rs(const float* part, int row) {
    const f32x4* p = (const f32x4*)(part + (size_t)row * 16);
    const f32x4 a = p[0], b = p[1], c = p[2], d = p[3];
    const float s = ((a[0] + a[1]) + (a[2] + a[3])) + ((b[0] + b[1]) + (b[2] + b[3])) + ((c[0] + c[1]) + (c[2] + c[3])) + ((d[0] + d[1]) + (d[2] + d[3]));
    return 1.0f / sqrtf(s * (1.0f / 1024.0f) + RMS_EPS);
}
__device__ __forceinline__ void store_bf16x8(bf16_t* p, const f32x4 v0, const f32x4 v1) {
    u32x4 w; w.x = cvt_pk_bf16(v0[0], v0[1]); w.y = cvt_pk_bf16(v0[2], v0[3]); w.z = cvt_pk_bf16(v1[0], v1[1]); w.w = cvt_pk_bf16(v1[2], v1[3]);
    *(u32x4*)p = w;
}

struct EpiL0In {
    static constexpr bool PERM = true, AFTER_DRAIN = false;
    const float* part;
    bf16_t *U, *Bb, *SQ, *IV, *SG; float* LOGF; const float* lbl;
    __device__ __forceinline__ void operator()(const f32x4 (&acc)[2][2][4][2], const Unit& u, int wr, int wc, int fr, int fq) const {
        const int row0 = u.pm * BM + wr * 64 + fr, cw = wc * 32 + 8 * fq, pn = u.pn;
        if (pn < 4) {
#pragma unroll
            for (int ai = 0; ai < 2; ++ai)
#pragma unroll
                for (int m = 0; m < 4; ++m) { const int row = row0 + ai * HALF + m * 16; const float r = row_rs(part, row), r2 = r * r;
                    const f32x4 v0 = acc[ai][0][m][0] * acc[ai][1][m][0] * r2, v1 = acc[ai][0][m][1] * acc[ai][1][m][1] * r2;
                    store_bf16x8(U + (size_t)row * 512 + pn * 128 + cw, v0, v1); }
        } else {
            const int seg = (pn - 4) >> 1, cb = ((pn - 4) & 1) * 256;
            float lb[2][8];
            if (seg == 2) {
#pragma unroll
                for (int bj = 0; bj < 2; ++bj)
#pragma unroll
                    for (int e = 0; e < 8; ++e) { const int c = cb + bj * HALF + cw + e; lb[bj][e] = fast_rcp(1.0f + fast_exp(lbl[512 + c] - lbl[c])); }
            }
#pragma unroll
            for (int ai = 0; ai < 2; ++ai)
#pragma unroll
                for (int m = 0; m < 4; ++m) { const int row = row0 + ai * HALF + m * 16; const float r = row_rs(part, row);
#pragma unroll
                    for (int bj = 0; bj < 2; ++bj) { const int col = cb + bj * HALF + cw; f32x4 v0 = acc[ai][bj][m][0] * r, v1 = acc[ai][bj][m][1] * r; const size_t off = (size_t)row * 512 + col;
                        if (seg == 0) store_bf16x8(Bb + off, v0, v1);
                        else if (seg == 1) { _Pragma("unroll") for (int e = 0; e < 4; ++e) { v0[e] = silu_f(v0[e]); v1[e] = silu_f(v1[e]); } store_bf16x8(SQ + off, v0, v1); }
                        else if (seg == 2) { _Pragma("unroll") for (int e = 0; e < 4; ++e) { const float l0 = lb[bj][e], l1 = lb[bj][4 + e];
                                v0[e] = fast_log(l0 + (1.0f - l0) * sigmoid_f(v0[e])); v1[e] = fast_log(l1 + (1.0f - l1) * sigmoid_f(v1[e])); }
                            *(f32x4*)(LOGF + off) = v0; *(f32x4*)(LOGF + off + 4) = v1; }
                        else if (seg == 3) store_bf16x8(IV + off, v0, v1);
                        else { _Pragma("unroll") for (int e = 0; e < 4; ++e) { v0[e] = silu_f(v0[e]); v1[e] = silu_f(v1[e]); } store_bf16x8(SG + off, v0, v1); }
                    } }
        }
    }
};

struct EpiSwiGLU {
    static constexpr bool PERM = true, AFTER_DRAIN = false;
    const float* part; bf16_t* ACT;
    __device__ __forceinline__ void operator()(const f32x4 (&acc)[2][2][4][2], const Unit& u, int wr, int wc, int fr, int fq) const {
        const int row0 = u.pm * BM + wr * 64 + fr, cw = wc * 32 + 8 * fq;
#pragma unroll
        for (int ai = 0; ai < 2; ++ai)
#pragma unroll
            for (int m = 0; m < 4; ++m) { const int row = row0 + ai * HALF + m * 16; const float r = row_rs(part, row);
                f32x4 g0 = acc[ai][0][m][0] * r, g1 = acc[ai][0][m][1] * r; const f32x4 u0 = acc[ai][1][m][0] * r, u1 = acc[ai][1][m][1] * r;
#pragma unroll
                for (int e = 0; e < 4; ++e) { g0[e] = silu_f(g0[e]) * u0[e]; g1[e] = silu_f(g1[e]) * u1[e]; }
                store_bf16x8(ACT + (size_t)row * 2816 + u.pn * 128 + cw, g0, g1); }
    }
};

struct EpiResid {
    static constexpr bool PERM = false, AFTER_DRAIN = false;
    const float* BASE; float* H; bf16_t* HB; float* PART;
    __device__ __forceinline__ void operator()(const f32x4 (&acc)[2][2][4][2], const Unit& u, int wr, int wc, int fr, int fq) const {
        const int row0 = u.pm * BM + wr * 64 + fr, col0 = u.pn * BM + wc * 32 + 4 * fq;
        typedef unsigned u32x2v __attribute__((ext_vector_type(2)));
#pragma unroll
        for (int ai = 0; ai < 2; ++ai)
#pragma unroll
            for (int m = 0; m < 4; ++m) { const int row = row0 + ai * HALF + m * 16; const size_t off = (size_t)row * 1024 + col0; float s = 0.f;
#pragma unroll
                for (int bj = 0; bj < 2; ++bj)
#pragma unroll
                    for (int n = 0; n < 2; ++n) { const size_t o = off + bj * HALF + n * 16; const f32x4 h = *(const f32x4*)(BASE + o) + acc[ai][bj][m][n];
                        *(f32x4*)(H + o) = h; u32x2v w; w.x = cvt_pk_bf16(h[0], h[1]); w.y = cvt_pk_bf16(h[2], h[3]); *(u32x2v*)(HB + o) = w;
                        s += (h[0] * h[0] + h[1] * h[1]) + (h[2] * h[2] + h[3] * h[3]); }
                s += __shfl_xor(s, 16); s += __shfl_xor(s, 32);
                if (fq == 0) PART[(size_t)row * 16 + u.pn * 4 + wc] = s; }
    }
};

struct EpiL1In {
    static constexpr bool PERM = true, AFTER_DRAIN = false;
    const float* part; const int* pos; bf16_t *Q, *Kk, *V, *G;
    __device__ __forceinline__ void operator()(const f32x4 (&acc)[2][2][4][2], const Unit& u, int wr, int wc, int fr, int fq) const {
        const int row0 = u.pm * BM + wr * 64 + fr, cw = wc * 32 + 8 * fq, pn = u.pn;
        if (pn < 8) {
            const int head = pn & 3; bf16_t* O = (pn < 4) ? Q : Kk; const float sc = (pn < 4) ? 1.0f : 0.0625f;
            const float lgam = __builtin_amdgcn_logf(1.0f - __builtin_amdgcn_exp2f(-5.0f - (float)head)) * ((pn < 4) ? 1.0f : -1.0f);
            float fr_rev[8];
#pragma unroll
            for (int e = 0; e < 8; ++e) fr_rev[e] = __builtin_amdgcn_exp2f((float)(cw + e) * (-13.287712379549449f / 128.0f)) * 0.15915494309189535f;
#pragma unroll
            for (int ai = 0; ai < 2; ++ai)
#pragma unroll
                for (int m = 0; m < 4; ++m) { const int row = row0 + ai * HALF + m * 16; const float r = row_rs(part, row) * sc * __builtin_amdgcn_exp2f((float)((row & 63) - 63) * lgam); const float p = (float)pos[row];
                    f32x4 o1[2], o2[2];
#pragma unroll
                    for (int n = 0; n < 2; ++n)
#pragma unroll
                        for (int e = 0; e < 4; ++e) { const float rev = p * fr_rev[4 * n + e]; const float fr_ = rev - floorf(rev);
                            const float sn = __builtin_amdgcn_sinf(fr_), cs = __builtin_amdgcn_cosf(fr_);
                            const float x1 = acc[ai][0][m][n][e] * r, x2 = acc[ai][1][m][n][e] * r;
                            o1[n][e] = x1 * cs - x2 * sn; o2[n][e] = x1 * sn + x2 * cs; }
                    bf16_t* rp = O + (size_t)row * 1024 + head * 256 + cw;
                    store_bf16x8(rp, o1[0], o1[1]); store_bf16x8(rp + 128, o2[0], o2[1]); }
        } else {
            const bool isg = pn >= 16; bf16_t* O = isg ? G : V; const int cb = ((pn - 8) & 7) * 256;
#pragma unroll
            for (int ai = 0; ai < 2; ++ai)
#pragma unroll
                for (int m = 0; m < 4; ++m) { const int row = row0 + ai * HALF + m * 16; const float r = row_rs(part, row);
#pragma unroll
                    for (int bj = 0; bj < 2; ++bj) { f32x4 v0 = acc[ai][bj][m][0] * r, v1 = acc[ai][bj][m][1] * r;
                        if (isg) { _Pragma("unroll") for (int e = 0; e < 4; ++e) { v0[e] = silu_f(v0[e]); v1[e] = silu_f(v1[e]); } }
                        store_bf16x8(O + (size_t)row * 2048 + cb + bj * HALF + cw, v0, v1); } }
        }
    }
};

template <class Epi, class Sched, bool ALIGN_EPI = false, bool SP2 = false>
__device__ __forceinline__ void gemm_phase(PG8_LAS unsigned char* lds, const Gemm g, const Sched& S, const Epi& E) {
    const int tid = threadIdx.x, wid = __builtin_amdgcn_readfirstlane(tid >> 6), lane = tid & 63, wr = wid >> 2, wc = wid & 3, fr = lane & 15, fq = lane >> 4;
    const int K = g.K, nt = K / BK;
    unsigned voffA[2], voffB[2];
#pragma unroll
    for (int i = 0; i < 2; ++i) { int R, C; stage_rc(tid * 16 + i * 8192, R, C); const int Rb = Epi::PERM ? ((R & ~31) + perm32(R & 31)) : R;
        voffA[i] = (unsigned)(R * K + C) * 2u; voffB[i] = (unsigned)(Rb * K + C) * 2u; }
    const size_t kstep = (size_t)(BK * 2);
    const size_t hstep = (size_t)HALF * K * 2;
    const size_t tstep = 2 * hstep;
    const unsigned ldsw = (unsigned)wid * 1024u;
    const int aoff = lds_byte(wr * 64 + fr, fq * 8), boff = lds_byte(wc * 32 + fr, fq * 8);
#define PG8_SA(b, h) (((b) * 2 + (h)) * HTB)
#define PG8_SB(b, h) ((4 + (b) * 2 + (h)) * HTB)
#define PG8_STAGE(bufoff, gbase, voff) do { _Pragma("unroll") for (int _i = 0; _i < 2; ++_i) \
        __builtin_amdgcn_global_load_lds((const unsigned*)((const char*)(gbase) + (voff)[_i]), (PG8_LAS unsigned*)(lds + (bufoff) + ldsw + _i * 8192), 16, 0, 0); } while (0)
#define PG8_LDA(dst, b, h) do { _Pragma("unroll") for (int m = 0; m < 4; ++m) _Pragma("unroll") for (int k = 0; k < 2; ++k) dst[m][k] = *(const PG8_LAS bf16x8*)(lds + PG8_SA(b, h) + aoff + m * 2048 + k * 1024); } while (0)
#define PG8_LDB(dst, b, h) do { _Pragma("unroll") for (int n = 0; n < 2; ++n) _Pragma("unroll") for (int k = 0; k < 2; ++k) dst[n][k] = *(const PG8_LAS bf16x8*)(lds + PG8_SB(b, h) + boff + n * 2048 + k * 1024); } while (0)
#define PG8_MMA(ai, bj, At, Bt) do { __builtin_amdgcn_s_setprio(1); _Pragma("unroll") for (int m = 0; m < 4; ++m) _Pragma("unroll") for (int n = 0; n < 2; ++n) _Pragma("unroll") for (int k = 0; k < 2; ++k) \
        acc[ai][bj][m][n] = __builtin_amdgcn_mfma_f32_16x16x32_bf16(Bt[n][k], At[m][k], acc[ai][bj][m][n], 0, 0, 0); __builtin_amdgcn_s_setprio(0); } while (0)
#define PG8_WAIT_V(n) asm volatile("s_waitcnt vmcnt(" #n ")" ::: "memory")
#define PG8_WAIT_L(n) asm volatile("s_waitcnt lgkmcnt(" #n ")" ::: "memory")
#define PG8_BAR __builtin_amdgcn_s_barrier()
#define PG8_SCHED __builtin_amdgcn_sched_barrier(0)
    Unit cur, nxt; int ui = 0;
    if (!S.next(0, cur)) return;
    f32x4 acc[2][2][4][2];
#pragma unroll
    for (int a = 0; a < 2; ++a)
#pragma unroll
        for (int b = 0; b < 2; ++b)
#pragma unroll
            for (int m = 0; m < 4; ++m)
#pragma unroll
                for (int n = 0; n < 2; ++n) acc[a][b][m][n] = (f32x4){0.f, 0.f, 0.f, 0.f};
    bf16x8 At[4][2], B0[2][2], B1[2][2];
    const char* cA = (const char*)g.A + (size_t)cur.pm * tstep; const char* cB = (const char*)g.Bt + (size_t)cur.pn * tstep;
    S.a_ready(cur);
    if constexpr (SP2) {
        PG8_STAGE(PG8_SB(0, 0), cB, voffB); PG8_STAGE(PG8_SB(0, 1), cB + hstep, voffB); PG8_STAGE(PG8_SA(0, 0), cA, voffA); PG8_STAGE(PG8_SA(0, 1), cA + hstep, voffA);
        if (wr == 1) PG8_BAR;
        PG8_WAIT_V(2); PG8_BAR;
        PG8_STAGE(PG8_SB(1, 0), cB + kstep, voffB); PG8_STAGE(PG8_SA(1, 0), cA + kstep, voffA); PG8_STAGE(PG8_SB(1, 1), cB + hstep + kstep, voffB);
        PG8_WAIT_V(6); PG8_BAR;
    } else {
        PG8_STAGE(PG8_SB(0, 0), cB, voffB); PG8_STAGE(PG8_SA(0, 0), cA, voffA); PG8_STAGE(PG8_SB(0, 1), cB + hstep, voffB); PG8_STAGE(PG8_SA(0, 1), cA + hstep, voffA);
        if (wr == 1) PG8_BAR;
        PG8_WAIT_V(4); PG8_BAR;
        PG8_STAGE(PG8_SB(1, 0), cB + kstep, voffB); PG8_STAGE(PG8_SA(1, 0), cA + kstep, voffA); PG8_STAGE(PG8_SB(1, 1), cB + hstep + kstep, voffB);
        PG8_WAIT_V(6); PG8_BAR;
    }
    for (;;) {
        const bool has_next = S.next(ui + 1, nxt);
        const char* nA = has_next ? (const char*)g.A + (size_t)nxt.pm * tstep : cA; const char* nB = has_next ? (const char*)g.Bt + (size_t)nxt.pn * tstep : cB;
        for (int t = 0; t < nt; t += 2) {
            const bool last = (t == nt - 2);
            const char* a1 = cA + (size_t)(t + 1) * kstep;
            const char* a2 = last ? nA : cA + (size_t)(t + 2) * kstep; const char* b2 = last ? nB : cB + (size_t)(t + 2) * kstep;
            const char* a3 = a2 + kstep; const char* b3 = b2 + kstep;
            if (last && has_next) S.a_ready(nxt);
            if constexpr (SP2) {
            PG8_LDB(B0, 0, 0); PG8_LDB(B1, 0, 1); PG8_SCHED; PG8_LDA(At, 0, 0); PG8_STAGE(PG8_SA(1, 1), a1 + hstep, voffA);
            PG8_WAIT_V(8); PG8_WAIT_L(0); PG8_BAR; PG8_MMA(0, 0, At, B0); PG8_MMA(0, 1, At, B1); PG8_BAR; PG8_SCHED;
            PG8_LDA(At, 0, 1); PG8_STAGE(PG8_SB(0, 0), b2, voffB); PG8_STAGE(PG8_SB(0, 1), b2 + hstep, voffB); PG8_STAGE(PG8_SA(0, 0), a2, voffA);
            PG8_WAIT_V(8); PG8_WAIT_L(0); PG8_BAR; PG8_MMA(1, 0, At, B0); PG8_MMA(1, 1, At, B1); PG8_BAR; PG8_SCHED;
            PG8_LDB(B0, 1, 0); PG8_LDB(B1, 1, 1); PG8_SCHED; PG8_LDA(At, 1, 0); PG8_STAGE(PG8_SA(0, 1), a2 + hstep, voffA);
            PG8_WAIT_V(8); PG8_WAIT_L(0); PG8_BAR; PG8_MMA(0, 0, At, B0); PG8_MMA(0, 1, At, B1); PG8_BAR; PG8_SCHED;
            PG8_LDA(At, 1, 1); PG8_STAGE(PG8_SB(1, 0), b3, voffB); PG8_STAGE(PG8_SB(1, 1), b3 + hstep, voffB); PG8_STAGE(PG8_SA(1, 0), a3, voffA);
            PG8_WAIT_V(8); PG8_WAIT_L(0); PG8_BAR; PG8_MMA(1, 0, At, B0); PG8_MMA(1, 1, At, B1); PG8_BAR; PG8_SCHED;
            } else {
            PG8_LDB(B0, 0, 0); PG8_SCHED; PG8_LDA(At, 0, 0); PG8_STAGE(PG8_SA(1, 1), a1 + hstep, voffA);
            PG8_WAIT_L(8); PG8_BAR; PG8_WAIT_L(0); PG8_MMA(0, 0, At, B0); PG8_BAR; PG8_SCHED;
            PG8_LDB(B1, 0, 1); PG8_STAGE(PG8_SB(0, 0), b2, voffB);
            PG8_BAR; PG8_WAIT_L(0); PG8_MMA(0, 1, At, B1); PG8_BAR;
            PG8_LDA(At, 0, 1); PG8_STAGE(PG8_SA(0, 0), a2, voffA);
            PG8_BAR; PG8_WAIT_L(0); PG8_MMA(1, 0, At, B0); PG8_BAR; PG8_SCHED;
            PG8_STAGE(PG8_SB(0, 1), b2 + hstep, voffB);
            PG8_WAIT_V(6); PG8_BAR; PG8_MMA(1, 1, At, B1); PG8_BAR;
            PG8_LDB(B0, 1, 0); PG8_SCHED; PG8_LDA(At, 1, 0); PG8_STAGE(PG8_SA(0, 1), a2 + hstep, voffA);
            PG8_WAIT_L(8); PG8_BAR; PG8_WAIT_L(0); PG8_MMA(0, 0, At, B0); PG8_BAR; PG8_SCHED;
            PG8_LDB(B1, 1, 1); PG8_STAGE(PG8_SB(1, 0), b3, voffB);
            PG8_BAR; PG8_WAIT_L(0); PG8_MMA(0, 1, At, B1); PG8_BAR;
            PG8_LDA(At, 1, 1); PG8_STAGE(PG8_SA(1, 0), a3, voffA);
            PG8_BAR; PG8_WAIT_L(0); PG8_MMA(1, 0, At, B0); PG8_BAR; PG8_SCHED;
            PG8_STAGE(PG8_SB(1, 1), b3 + hstep, voffB);
            PG8_WAIT_V(6); PG8_BAR; PG8_MMA(1, 1, At, B1); PG8_BAR;
            }
        }
        if constexpr (ALIGN_EPI) { if (wr == 0) PG8_BAR; }
        if constexpr (!Epi::AFTER_DRAIN) { E(acc, cur, wr, wc, fr, fq); S.done(cur); }
        if (!has_next) break;
#pragma unroll
        for (int a = 0; a < 2; ++a)
#pragma unroll
            for (int b = 0; b < 2; ++b)
#pragma unroll
                for (int m = 0; m < 4; ++m)
#pragma unroll
                    for (int n = 0; n < 2; ++n) acc[a][b][m][n] = (f32x4){0.f, 0.f, 0.f, 0.f};
        cur = nxt; cA = nA; cB = nB; ++ui;
        if constexpr (ALIGN_EPI) { if (wr == 1) PG8_BAR; }
    }
    PG8_WAIT_V(0);
    if constexpr (!ALIGN_EPI) { if (wr == 0) PG8_BAR; }
    PG8_BAR;
    if constexpr (Epi::AFTER_DRAIN) { E.fused(acc, cur, wr, wc, fr, fq, lds, wid, lane); S.done(cur); }
#undef PG8_SA
#undef PG8_SB
#undef PG8_STAGE
#undef PG8_LDA
#undef PG8_LDB
#undef PG8_MMA
#undef PG8_WAIT_V
#undef PG8_WAIT_L
#undef PG8_BAR
#undef PG8_SCHED
}
}
#define GAS __attribute__((address_space(1)))
#define LAS __attribute__((address_space(3)))
typedef unsigned short bf16;
typedef unsigned v4u __attribute__((ext_vector_type(4)));
typedef float f32x4 __attribute__((ext_vector_type(4)));
typedef short bf16x8 __attribute__((ext_vector_type(8)));
typedef GAS unsigned gu32;
typedef GAS unsigned long long gu64;
#define RLX_AGENT __ATOMIC_RELAXED, __HIP_MEMORY_SCOPE_AGENT
#define LDS_WAIT() asm volatile("s_waitcnt lgkmcnt(0)" ::: "memory")
#define VM_WAIT() asm volatile("s_waitcnt vmcnt(0)" ::: "memory")
__device__ __forceinline__ unsigned long long rt() { return __builtin_amdgcn_s_memrealtime(); }
__device__ __forceinline__ unsigned f2bf(float f) { unsigned u = __builtin_bit_cast(unsigned, f); return (u + 0x7fffu + ((u >> 16) & 1u)) >> 16; }
__device__ __forceinline__ unsigned pk2(float lo, float hi) { return f2bf(lo) | (f2bf(hi) << 16); }

#define XB_TMO      128
#define XB_XCNT(j)  (256  + 64 * (j))
#define XB_XSUB(j)  (1280 + 64 * (j))
#define XB_XGEN(j)  (2304 + 64 * (j))
#define XB_TOP      3328
#define XB_TOPGEN   3392
#define XCD_BAR_WORDS 3456
#define XB_SPIN_CAP (1u << 18)

__device__ __forceinline__ unsigned xb_ld(unsigned* p)              { return __hip_atomic_load(p, __ATOMIC_RELAXED, __HIP_MEMORY_SCOPE_AGENT); }
__device__ __forceinline__ unsigned xb_add(unsigned* p, unsigned v) { return __hip_atomic_fetch_add(p, v, __ATOMIC_RELAXED, __HIP_MEMORY_SCOPE_AGENT); }
__device__ __forceinline__ unsigned xb_xcc_id() { return (unsigned)__builtin_amdgcn_s_getreg((3 << 11) | 20) & 0xFu; }
#define XB_SPIN(cond, bar) do { unsigned _sp = 0; while (cond) { __builtin_amdgcn_s_sleep(1); \
    if ((++_sp & 255u) == 0u) { if (xb_ld(&(bar)[XB_TMO])) break; if (_sp > XB_SPIN_CAP) { atomicAdd(&(bar)[XB_TMO], 1u); break; } } } } while (0)

struct XcdBarrier {
    unsigned* bar; unsigned x;
    volatile LAS unsigned* st;
};

__device__ __forceinline__ XcdBarrier xcd_barrier_post(unsigned* bar, volatile LAS unsigned* st) {
    XcdBarrier b; b.bar = bar; b.x = xb_xcc_id(); b.st = st;
    if (threadIdx.x == 0) (void)xb_add(&bar[XB_XCNT(b.x)], 1u);
    return b;
}
__device__ __forceinline__ void xcd_barrier_complete(unsigned* bar, unsigned x, unsigned& nloc, unsigned& nx) {
    const unsigned G = gridDim.x * gridDim.y * gridDim.z;
    unsigned sum, cnt, mine, sp = 0u;
    for (;;) {
        sum = 0u; cnt = 0u; mine = 0u;
#pragma unroll
        for (unsigned j = 0; j < 16; ++j) { const unsigned c = xb_ld(&bar[XB_XCNT(j)]); sum += c; cnt += (c > 0u) ? 1u : 0u; mine = (j == x) ? c : mine; }
        if (sum == G) break;
        __builtin_amdgcn_s_sleep(1);
        if ((++sp & 255u) == 0u) { if (xb_ld(&bar[XB_TMO])) break; if (sp > XB_SPIN_CAP) { atomicAdd(&bar[XB_TMO], 1u); break; } }
    }
    nloc = mine > 0u ? mine : 1u; nx = cnt > 0u ? cnt : 1u;
}

__device__ __forceinline__ void xcd_barrier(const XcdBarrier& b) {
    asm volatile("s_waitcnt vmcnt(0)" ::: "memory");
    __syncthreads();
    if (threadIdx.x == 0) {
        unsigned* bar = b.bar;
        __builtin_amdgcn_s_waitcnt(0);
        unsigned nloc = b.st[0], nx = b.st[1];
        if (nloc == 0u) { xcd_barrier_complete(bar, b.x, nloc, nx); b.st[0] = nloc; b.st[1] = nx; }
        const unsigned old = xb_add(&bar[XB_XSUB(b.x)], 1u);
        const unsigned gen = old / nloc;
        if (old + 1u == (gen + 1u) * nloc) {
            __builtin_amdgcn_fence(__ATOMIC_RELEASE, "agent");
            asm volatile("s_waitcnt vmcnt(0)" ::: "memory");
            const unsigned og = xb_add(&bar[XB_TOP], 1u);
            const unsigned tg = og / nx;
            if (og + 1u == (tg + 1u) * nx) xb_add(&bar[XB_TOPGEN], 1u);
            else XB_SPIN(xb_ld(&bar[XB_TOPGEN]) == tg, bar);
            __builtin_amdgcn_fence(__ATOMIC_ACQUIRE, "agent");
            xb_add(&bar[XB_XGEN(b.x)], 1u);
            asm volatile("s_waitcnt vmcnt(0)" ::: "memory");
        } else {
            XB_SPIN(xb_ld(&bar[XB_XGEN(b.x)]) == gen, bar);
            __builtin_amdgcn_fence(__ATOMIC_ACQUIRE, "agent");
            asm volatile("s_waitcnt vmcnt(0)" ::: "memory");
        }
    }
    __syncthreads();
}
__device__ __forceinline__ float bf2f(unsigned short u) { return __builtin_bit_cast(float, (unsigned)u << 16); }
__device__ __forceinline__ float bflo(unsigned u) { return __builtin_bit_cast(float, u << 16); }
__device__ __forceinline__ float bfhi(unsigned u) { return __builtin_bit_cast(float, u & 0xffff0000u); }
__device__ __forceinline__ float wave_sum(float v) {
#pragma unroll
    for (int o = 1; o < 64; o <<= 1) v += __shfl_xor(v, o);
    return v;
}


namespace cs {
typedef short bf16x8 __attribute__((ext_vector_type(8)));
typedef short s16x4 __attribute__((ext_vector_type(4)));
typedef float f32x16 __attribute__((ext_vector_type(16)));
typedef float f32x2 __attribute__((ext_vector_type(2)));
typedef __bf16 bf16x2_t __attribute__((ext_vector_type(2)));
typedef unsigned u32x2 __attribute__((ext_vector_type(2)));
#define CS_MFMA(a, b, c) __builtin_amdgcn_mfma_f32_32x32x16_bf16((a), (b), (c), 0, 0, 0)
__device__ __forceinline__ unsigned pkbf(float lo, float hi) { return __builtin_bit_cast(unsigned, __builtin_convertvector((f32x2){lo, hi}, bf16x2_t)); }
template <int NCH> __device__ __forceinline__ unsigned img_off(unsigned row, unsigned ch) { return (128u * NCH) * (row >> 3) + 512u * (ch >> 2) + 64u * (row & 7) + 16u * ((ch & 3) ^ ((row >> 2) & 3)); }
template <int NCH> __device__ __forceinline__ bf16x8 row_read(LAS unsigned char* img, unsigned rowbase, int s, int r, int h) {
    return *(const LAS bf16x8*)(img + img_off<NCH>(rowbase + r, 2 * s + h));
}
template <int NCH> __device__ __forceinline__ unsigned tr_addr(unsigned lane, unsigned c, unsigned ks, unsigned t) {
    const unsigned h = lane >> 5, blk = (lane >> 4) & 1, q = (lane & 15) >> 2, p = lane & 3;
    return img_off<NCH>(16 * ks + 8 * h + 4 * t + q, 4 * c + 2 * blk + (p >> 1)) + 8 * (p & 1);
}
__device__ __forceinline__ void tr_read_ab(unsigned a0, unsigned a1, unsigned b0, unsigned b1, bf16x8& a, bf16x8& b) {
    s16x4 alo, ahi, blo, bhi;
    asm volatile("ds_read_b64_tr_b16 %0, %4\n\tds_read_b64_tr_b16 %1, %5\n\tds_read_b64_tr_b16 %2, %6\n\tds_read_b64_tr_b16 %3, %7\n\ts_waitcnt lgkmcnt(0)"
                 : "=&v"(alo), "=&v"(ahi), "=&v"(blo), "=&v"(bhi) : "v"(a0), "v"(a1), "v"(b0), "v"(b1) : "memory");
    a = __builtin_shufflevector(alo, ahi, 0, 1, 2, 3, 4, 5, 6, 7); b = __builtin_shufflevector(blo, bhi, 0, 1, 2, 3, 4, 5, 6, 7);
}
__device__ __forceinline__ bf16x8 tr_read_1(unsigned a0, unsigned a1) {
    s16x4 alo, ahi;
    asm volatile("ds_read_b64_tr_b16 %0, %2\n\tds_read_b64_tr_b16 %1, %3\n\ts_waitcnt lgkmcnt(0)" : "=&v"(alo), "=&v"(ahi) : "v"(a0), "v"(a1) : "memory");
    return __builtin_shufflevector(alo, ahi, 0, 1, 2, 3, 4, 5, 6, 7);
}
__device__ __forceinline__ int crow(int reg, int h) { return (reg & 3) + 8 * (reg >> 2) + 4 * h; }

struct ScanIO {
    const bf16* Qd; const bf16* Kd; int qk_ld;
    const bf16* V; int v_ld;
    const float* dec;
    float dec_const;
    bf16* Out; int out_ld;
    const bf16* SG; int sg_ld;
};

struct RR { unsigned e, o; };
template <int NCH> __device__ __forceinline__ RR rr_make(unsigned imgbase, unsigned row, unsigned h) { RR b; b.e = imgbase + img_off<NCH>(row, h); b.o = imgbase + img_off<NCH>(row, 2 + h); return b; }
__device__ __forceinline__ bf16x8 rr_read(LAS unsigned char* lds, const RR b, int s) { return *(const LAS bf16x8*)(lds + ((s & 1) ? b.o : b.e) + 512 * (s >> 1)); }
__device__ __forceinline__ bf16x8 tr8(LAS unsigned char* lds, unsigned a0, unsigned a1) {
    const s16x4 lo = __builtin_amdgcn_ds_read_tr16_b64_v4i16((LAS s16x4*)(lds + a0)), hi = __builtin_amdgcn_ds_read_tr16_b64_v4i16((LAS s16x4*)(lds + a1));
    return __builtin_shufflevector(lo, hi, 0, 1, 2, 3, 4, 5, 6, 7);
}

template <int DK, int DV, bool HGRN> __device__ __forceinline__ void chunk_scan(LAS unsigned char* lds, const ScanIO io) {
    constexpr int C = 64, NCHUNKS = 2048 / C, KS = DK / 16, NVT = DV / 32, NCHK = DK / 8, NCHV = DV / 8;
    constexpr int QD = 0, KD = C * DK * 2, V0 = 2 * C * DK * 2, VSZ = C * DV * 2, SDT = V0 + 2 * VSZ, PIM = SDT + DV * DK * 2, OB = PIM + C * C * 2, END = OB + C * DV * 4;
    static_assert(END <= 146944, "scan LDS map");
    constexpr int NQ = (C * NCHK) / 512, NV = (C * NCHV) / 512;
    static_assert(NQ * 512 == C * NCHK && NV * 512 == C * NCHV, "staging split");
    static_assert(NCHUNKS % 2 == 0, "the chunk loop is unrolled by two (two prefetch register sets)");
    constexpr unsigned KSTEP_K = 2 * 128 * NCHK, KSTEP_V = 2 * 128 * NCHV;
    const int wave0 = __builtin_amdgcn_readfirstlane(threadIdx.x >> 6); const unsigned lane0 = threadIdx.x & 63;
    f32x16 S0, S1, Z;
#pragma unroll
    for (int i = 0; i < 16; ++i) { S0[i] = 0.f; S1[i] = 0.f; Z[i] = 0.f; }
    v4u pqA[NQ], pkA[NQ], pvA[NV], pqB[NQ], pkB[NQ], pvB[NV];
    unsigned sgA[8], sgB[8]; f32x4 dvA[4], dvB[4];
#define CS_IDS() int wave = wave0; unsigned lane = lane0; asm volatile("" : "+s"(wave)); asm volatile("" : "+v"(lane)); \
        const unsigned r = lane & 31, h = lane >> 5; const int tid = wave * 64 + (int)lane; \
        const bool zw = HGRN ? true : (wave < 4); const int z_it = HGRN ? (wave >> 2) : (wave >> 1), z_vt = HGRN ? (wave & 3) : (wave & 1); \
        const int xw0 = HGRN ? 0 : 4; const bool xw = (wave >= xw0 && wave < xw0 + 3); const int xt = wave - xw0; const int x_jt = (xt == 2) ? 1 : 0, x_it = (xt == 0) ? 0 : 1; \
        const int s_kt = (2 * wave) / NVT, s_vt0 = (2 * wave) % NVT; (void)r; (void)h; (void)tid; (void)zw; (void)z_it; (void)z_vt; (void)xw; (void)x_jt; (void)x_it; (void)s_kt; (void)s_vt0
#define CS_LOAD_CHUNK(n_, pq, pk, pv, dv) do { const size_t rowb_ = (size_t)(n_) * C; \
        _Pragma("unroll") for (int i_ = 0; i_ < NQ; ++i_) { const int c_ = tid + 512 * i_, row_ = c_ / NCHK, ch_ = c_ % NCHK; \
            pq[i_] = *(const GAS v4u*)(io.Qd + (rowb_ + row_) * io.qk_ld + ch_ * 8); pk[i_] = *(const GAS v4u*)(io.Kd + (rowb_ + row_) * io.qk_ld + ch_ * 8); } \
        _Pragma("unroll") for (int i_ = 0; i_ < NV; ++i_) { const int c_ = tid + 512 * i_, row_ = c_ / NCHV, ch_ = c_ % NCHV; \
            pv[i_] = *(const GAS v4u*)(io.V + (rowb_ + row_) * io.v_ld + ch_ * 8); } \
        if (HGRN) { _Pragma("unroll") for (int g_ = 0; g_ < 4; ++g_) dv[g_] = *(const GAS f32x4*)(io.dec + (size_t)(n_) * 512 + 32 * s_kt + 8 * g_ + 4 * h); } } while (0)
#define CS_LOAD_SG(n_, sg) do { if (HGRN) { const size_t rowb_ = (size_t)(n_) * C; \
        _Pragma("unroll") for (int j_ = 0; j_ < 8; ++j_) sg[j_] = *(const GAS unsigned*)(io.SG + (rowb_ + 8 * wave + j_) * io.sg_ld + 2 * lane); } } while (0)
#define CS_STAGE_CHUNK(vbuf_, pq, pk, pv) do { \
        _Pragma("unroll") for (int i_ = 0; i_ < NQ; ++i_) { const int c_ = tid + 512 * i_, row_ = c_ / NCHK, ch_ = c_ % NCHK; const unsigned o_ = img_off<NCHK>(row_, ch_); \
            *(LAS v4u*)(lds + o_ + QD) = pq[i_]; *(LAS v4u*)(lds + o_ + KD) = pk[i_]; } \
        _Pragma("unroll") for (int i_ = 0; i_ < NV; ++i_) { const int c_ = tid + 512 * i_, row_ = c_ / NCHV, ch_ = c_ % NCHV; \
            *(LAS v4u*)(lds + img_off<NCHV>(row_, ch_) + V0 + (vbuf_) * VSZ) = pv[i_]; } } while (0)
#define CS_WRITE_SDT() do { \
        _Pragma("unroll") for (int g_ = 0; g_ < 4; ++g_) { \
            u32x2 w0_, w1_; w0_.x = pkbf(S0[4 * g_], S0[4 * g_ + 1]); w0_.y = pkbf(S0[4 * g_ + 2], S0[4 * g_ + 3]); w1_.x = pkbf(S1[4 * g_], S1[4 * g_ + 1]); w1_.y = pkbf(S1[4 * g_ + 2], S1[4 * g_ + 3]); \
            *(LAS u32x2*)(lds + SDT + img_off<NCHK>(32 * s_vt0 + r, 4 * s_kt + g_) + 8 * h) = w0_; \
            *(LAS u32x2*)(lds + SDT + img_off<NCHK>(32 * (s_vt0 + 1) + r, 4 * s_kt + g_) + 8 * h) = w1_; } } while (0)
#define CS_OUTPUT(n_, sg) do { const size_t rowb_ = (size_t)(n_) * C; const LAS float* ob_ = (const LAS float*)(lds + OB); \
        if (HGRN) { _Pragma("unroll") for (int j_ = 0; j_ < 8; ++j_) { const int row_ = 8 * wave + j_; const f32x2 x_ = *(const LAS f32x2*)(ob_ + row_ * DV + 2 * lane); \
                const float ss_ = wave_sum(x_.x * x_.x + x_.y * x_.y); const float rstd_ = 1.0f / sqrtf(ss_ * (1.0f / DV) + 1e-6f); \
                *(GAS unsigned*)(io.Out + (rowb_ + row_) * io.out_ld + 2 * lane) = pkbf(x_.x * rstd_ * bflo(sg[j_]), x_.y * rstd_ * bfhi(sg[j_])); } } \
        else { const int row_ = tid >> 3, c8_ = (tid & 7) * 8; const f32x4 a_ = *(const LAS f32x4*)(ob_ + row_ * DV + c8_), b_ = *(const LAS f32x4*)(ob_ + row_ * DV + c8_ + 4); \
            v4u w_; w_.x = pkbf(a_[0], a_[1]); w_.y = pkbf(a_[2], a_[3]); w_.z = pkbf(b_[0], b_[1]); w_.w = pkbf(b_[2], b_[3]); \
            *(GAS v4u*)(io.Out + (rowb_ + row_) * io.out_ld + c8_) = w_; } } while (0)

#define CS_ITER(n, pqX, pkX, pvX, sgX, dvX, pqY, pkY, pvY, sgY, dvY) do { \
        CS_IDS(); \
        const unsigned vb = V0 + ((n) & 1) * VSZ; \
          \
        if ((n) > 0) CS_OUTPUT((n) - 1, sgY);                          \
        CS_LOAD_SG((n), sgX);                                          \
        if ((n) + 2 < NCHUNKS) CS_LOAD_CHUNK((n) + 2, pqX, pkX, pvX, dvX); \
        if (xw) {                                                      \
            f32x16 x; \
            _Pragma("unroll") for (int i = 0; i < 16; ++i) x[i] = 0.f; \
            const RR ra = rr_make<NCHK>(KD, 32 * x_jt + r, h), rb = rr_make<NCHK>(QD, 32 * x_it + r, h); \
            _Pragma("unroll") for (int s = 0; s < KS; ++s) { const bf16x8 a = rr_read(lds, ra, s), b = rr_read(lds, rb, s); x = CS_MFMA(a, b, x); } \
            if (x_jt == x_it) { _Pragma("unroll") for (int i = 0; i < 16; ++i) x[i] = ((unsigned)crow(i, h) > r) ? 0.f : x[i]; } \
            _Pragma("unroll") for (int g = 0; g < 4; ++g) { u32x2 w; w.x = pkbf(x[4 * g], x[4 * g + 1]); w.y = pkbf(x[4 * g + 2], x[4 * g + 3]); \
                *(LAS u32x2*)(lds + PIM + img_off<8>(32 * x_it + r, 4 * x_jt + g) + 8 * h) = w; } \
        } \
        if (zw) {                                                      \
            _Pragma("unroll") for (int i = 0; i < 16; ++i) Z[i] = 0.f; \
            const RR ra = rr_make<NCHK>(QD, 32 * z_it + r, h), rb = rr_make<NCHK>(SDT, 32 * z_vt + r, h); \
            _Pragma("unroll") for (int s = 0; s < KS; ++s) { const bf16x8 a = rr_read(lds, ra, s), b = rr_read(lds, rb, s); Z = CS_MFMA(a, b, Z); } \
        } \
        {                                                              \
            const unsigned tk0 = KD + tr_addr<NCHK>(lane, s_kt, 0, 0), tk1 = KD + tr_addr<NCHK>(lane, s_kt, 0, 1); \
            const unsigned t0a = vb + tr_addr<NCHV>(lane, s_vt0, 0, 0), t0b = vb + tr_addr<NCHV>(lane, s_vt0, 0, 1); \
            const unsigned t1a = vb + tr_addr<NCHV>(lane, s_vt0 + 1, 0, 0), t1b = vb + tr_addr<NCHV>(lane, s_vt0 + 1, 0, 1); \
            _Pragma("unroll") for (int ks = 0; ks < C / 16; ++ks) { \
                const bf16x8 a = tr8(lds, tk0 + ks * KSTEP_K, tk1 + ks * KSTEP_K), b0 = tr8(lds, t0a + ks * KSTEP_V, t0b + ks * KSTEP_V), b1 = tr8(lds, t1a + ks * KSTEP_V, t1b + ks * KSTEP_V); \
                S0 = CS_MFMA(a, b0, S0); S1 = CS_MFMA(a, b1, S1); } \
        } \
        __syncthreads(); \
          \
        if (zw) {                                                      \
            const RR rp = rr_make<8>(PIM, 32 * z_it + r, h); \
            const unsigned tza = vb + tr_addr<NCHV>(lane, z_vt, 0, 0), tzb = vb + tr_addr<NCHV>(lane, z_vt, 0, 1); \
            _Pragma("unroll") for (int s = 0; s < 4; ++s) { if (s < 2 * (z_it + 1)) { const bf16x8 a = rr_read(lds, rp, s); \
                    const bf16x8 b = tr8(lds, tza + s * KSTEP_V, tzb + s * KSTEP_V); Z = CS_MFMA(a, b, Z); } } \
            LAS float* ob = (LAS float*)(lds + OB) + (32 * z_it + 4 * h) * DV + 32 * z_vt + r; \
            _Pragma("unroll") for (int i = 0; i < 16; ++i) ob[((i & 3) + 8 * (i >> 2)) * DV] = Z[i]; \
        } \
        if ((n) + 1 < NCHUNKS) { \
            if (HGRN) { _Pragma("unroll") for (int i = 0; i < 16; ++i) { const float d = dvY[i >> 2][i & 3]; S0[i] *= d; S1[i] *= d; } } \
            else { _Pragma("unroll") for (int i = 0; i < 16; ++i) { S0[i] *= io.dec_const; S1[i] *= io.dec_const; } } \
            CS_WRITE_SDT(); \
            CS_STAGE_CHUNK(((n) + 1) & 1, pqY, pkY, pvY); \
        } \
        __syncthreads(); \
    } while (0)

    { CS_IDS(); CS_WRITE_SDT(); CS_LOAD_CHUNK(0, pqA, pkA, pvA, dvA); CS_STAGE_CHUNK(0, pqA, pkA, pvA); CS_LOAD_CHUNK(1, pqB, pkB, pvB, dvB); }
    __syncthreads();
    for (int n = 0; n < NCHUNKS; n += 2) {
        CS_ITER(n, pqA, pkA, pvA, sgA, dvA, pqB, pkB, pvB, sgB, dvB);
        CS_ITER(n + 1, pqB, pkB, pvB, sgB, dvB, pqA, pkA, pvA, sgA, dvA);
    }
    { CS_IDS(); CS_OUTPUT(NCHUNKS - 1, sgB); }
    __syncthreads();
#undef CS_IDS
#undef CS_LOAD_CHUNK
#undef CS_LOAD_SG
#undef CS_STAGE_CHUNK
#undef CS_WRITE_SDT
#undef CS_OUTPUT
#undef CS_ITER
}
}

constexpr int NWAVES = 8;
using pg8::RMS_EPS;
constexpr int BATCH = 8, SEQ = 2048, D = 1024, M = BATCH * SEQ;
constexpr int EVEN_IN = 3584, ODD_IN = 6144, FFH = 2816, FF2 = 5632;
constexpr int N_PHASES = 14;
#ifndef MK_N_LAUNCHES
#define MK_N_LAUNCHES 1
#endif
constexpr int N_LAUNCHES = MK_N_LAUNCHES;
#ifndef PROBE_MASK
#define PROBE_MASK 0
#endif
#ifndef PROBE_REPS
#define PROBE_REPS 1
#endif

constexpr size_t MiB = 1u << 20;
constexpr size_t WS_CTL = 0, CTL_ZERO_BYTES = 64 * 1024;
constexpr size_t WS_PART = 1 * MiB;
constexpr size_t WS_W_ODD_IN = 2 * MiB, WS_W_ODD_OUT = 14 * MiB, WS_W_FFN_IN1 = 18 * MiB, WS_W_FFN_OUT1 = 2 * MiB  ;
constexpr size_t WS_HB = 32 * MiB;
constexpr size_t WS_W_EVEN_IN = 64 * MiB, WS_W_EVEN_OUT = 71 * MiB, WS_W_FFN_IN0 = 73 * MiB, WS_W_FFN_OUT0 = 84 * MiB;
constexpr size_t WS_U = 96 * MiB, WS_BB = 112 * MiB, WS_SQ = 128 * MiB, WS_LOGF = 144 * MiB, WS_IV = 176 * MiB, WS_SG0 = 192 * MiB, WS_MIX0 = 208 * MiB;
constexpr size_t WS_KD = 240 * MiB;
constexpr size_t WS_DEC = 29 * MiB;
constexpr size_t WS_ACT0 = 96 * MiB;
constexpr size_t WS_Q = 64 * MiB, WS_K = 96 * MiB, WS_V = 128 * MiB, WS_G = 192 * MiB;
constexpr size_t WS_ACT1 = 64 * MiB;
constexpr size_t WS_END = 256 * MiB;
constexpr int CW_BAR = 4096;

constexpr int RING_OFF = 0, RING_BYTES = 131072;
constexpr int LDS_BYTES = 147456;
constexpr int LDSCTL_OFF = LDS_BYTES - 512, MISC_OFF = LDSCTL_OFF + 320;

struct Args { const float* in[15]; float* out; unsigned char* ws; int ph_lo, ph_hi, li, pad; };

struct MatDesc { const float* W; int K, N; bf16* WT; const float* scale; int scale_from; int map; };
__device__ __forceinline__ int map_col(int map, int n) {
    if (map == 1) { const int seg = n >> 9, c = n & 511; if (seg == 0) return 256 * (c >> 7) + (c & 127); if (seg == 2) return 256 * (c >> 7) + 128 + (c & 127); if (seg == 1) return 1024 + c; return n; }
    if (map == 2) { if (n < FFH) return 256 * (n >> 7) + (n & 127); const int c = n - FFH; return 256 * (c >> 7) + 128 + (c & 127); }
    return n;
}
__device__ __forceinline__ void transpose_item(const MatDesc& md, LAS float* scr, int item, int lane) {
    const int N = md.N, K = md.K, nblk = N / 32, kb = item / nblk, nb = item % nblk, k0 = 64 * kb, n0 = 32 * nb;
    float wv[32];
#pragma unroll
    for (int i = 0; i < 32; ++i) wv[i] = md.W[(size_t)(k0 + 2 * i + (lane >> 5)) * N + n0 + (lane & 31)];
#pragma unroll
    for (int i = 0; i < 32; ++i) { const int kk = 2 * i + (lane >> 5); const int k = k0 + kk; float w = wv[i];
        if (md.scale && k >= md.scale_from) w *= md.scale[k - md.scale_from];
        scr[kk * 33 + (lane & 31)] = w; }
    LDS_WAIT(); asm volatile("" ::: "memory");
    const int c = lane & 7; const int d0 = map_col(md.map, n0);
#pragma unroll
    for (int j = 0; j < 4; ++j) { const int n = (lane >> 3) + 8 * j; const LAS float* s = scr + (8 * c) * 33 + n;
        v4u o; o.x = pk2(s[0 * 33], s[1 * 33]); o.y = pk2(s[2 * 33], s[3 * 33]); o.z = pk2(s[4 * 33], s[5 * 33]); o.w = pk2(s[6 * 33], s[7 * 33]);
        *(GAS v4u*)(md.WT + (size_t)(d0 + n) * K + k0 + 8 * c) = o; }
    LDS_WAIT(); asm volatile("" ::: "memory");
}
__device__ __forceinline__ MatDesc mat_desc(const Args& a, int mat) {
    unsigned char* ws = a.ws; MatDesc d;
    switch (mat) {
    case 0: d = MatDesc{a.in[5], D, EVEN_IN, (bf16*)(ws + WS_W_EVEN_IN), a.in[2], 0, 1}; break;
    case 1: d = MatDesc{a.in[9], D, D, (bf16*)(ws + WS_W_EVEN_OUT), a.in[8], 512, 0}; break;
    case 2: d = MatDesc{a.in[13], D, FF2, (bf16*)(ws + WS_W_FFN_IN0), a.in[3], 0, 2}; break;
    case 3: d = MatDesc{a.in[14], FFH, D, (bf16*)(ws + WS_W_FFN_OUT0), nullptr, 0, 0}; break;
    case 4: d = MatDesc{a.in[10], D, ODD_IN, (bf16*)(ws + WS_W_ODD_IN), a.in[2] + D, 0, 0}; break;
    case 5: d = MatDesc{a.in[12], 2048, D, (bf16*)(ws + WS_W_ODD_OUT), a.in[11], 0, 0}; break;
    case 6: d = MatDesc{a.in[13] + (size_t)D * FF2, D, FF2, (bf16*)(ws + WS_W_FFN_IN1), a.in[3] + D, 0, 2}; break;
    default: d = MatDesc{a.in[14] + (size_t)FFH * D, FFH, D, (bf16*)(ws + WS_W_FFN_OUT1), nullptr, 0, 0}; break;
    }
    return d;
}
__device__ __forceinline__ void convert_mats(const Args& a, int mat_lo, int mat_hi, LAS float* scr, int gw, int NGW, int lane) {
    for (int mat = mat_lo; mat < mat_hi; ++mat) { const MatDesc md = mat_desc(a, mat); const int nitems = (md.K / 64) * (md.N / 32);
        for (int it = gw; it < nitems; it += NGW) transpose_item(md, scr, it, lane); }
}
template <int NR> __device__ __forceinline__ void x_rows_prep(const float* x, bf16* hb, float* part, int m0, int stride, int lane) {
    f32x4 v[NR][4];
#pragma unroll
    for (int i = 0; i < NR; ++i) { const GAS f32x4* xr = (const GAS f32x4*)(x + (size_t)(m0 + i * stride) * D) + lane;
#pragma unroll
        for (int j = 0; j < 4; ++j) v[i][j] = xr[64 * j]; }
#pragma unroll
    for (int i = 0; i < NR; ++i) { const int m = m0 + i * stride; float s = 0.f;
#pragma unroll
        for (int j = 0; j < 4; ++j) s += (v[i][j].x * v[i][j].x + v[i][j].y * v[i][j].y) + (v[i][j].z * v[i][j].z + v[i][j].w * v[i][j].w);
        s = wave_sum(s);
        GAS unsigned long long* o8 = (GAS unsigned long long*)(hb + (size_t)m * D) + lane;
#pragma unroll
        for (int j = 0; j < 4; ++j) o8[64 * j] = (unsigned long long)pk2(v[i][j].x, v[i][j].y) | ((unsigned long long)pk2(v[i][j].z, v[i][j].w) << 32);
        if (lane < 16) part[(size_t)m * 16 + lane] = (lane == 0) ? s : 0.f; }
}

__device__ __forceinline__ float exp_fast(float x) { return __builtin_amdgcn_exp2f(x * 1.44269504089f); }
__device__ __forceinline__ void hgrn_prep(LAS unsigned char* lds, unsigned char* ws, int unit) {
    const int tid = threadIdx.x, k = tid & 127, tq = tid >> 7; const int b = unit >> 7, h = (unit >> 5) & 3, n = unit & 31;
    LAS float* part = (LAS float*)lds;
    const size_t row0 = (size_t)b * SEQ + n * 64 + 16 * tq; const int col = h * 128 + k;
    const float* LF = (const float*)(ws + WS_LOGF); bf16* SQ = (bf16*)(ws + WS_SQ); bf16* KDG = (bf16*)(ws + WS_KD);
    float l[16], c[16]; float run = 0.f;
#pragma unroll
    for (int j = 0; j < 16; ++j) l[j] = LF[(row0 + j) * 512 + col];
    unsigned short qh[16];
#pragma unroll
    for (int j = 0; j < 16; ++j) qh[j] = SQ[(row0 + j) * 512 + col];
#pragma unroll
    for (int j = 0; j < 16; ++j) { run += l[j]; c[j] = run; }
    part[tq * 128 + k] = run;
    __syncthreads();
    const float p0 = part[k], p1 = part[128 + k], p2 = part[256 + k], p3 = part[384 + k];
    const float bl = (p0 + p1) + (p2 + p3); const float pre = (tq > 0 ? p0 : 0.f) + (tq > 1 ? p1 : 0.f) + (tq > 2 ? p2 : 0.f);
#pragma unroll
    for (int j = 0; j < 16; ++j) { const float bt = pre + c[j]; const float q = bf2f(qh[j]); const float f = exp_fast(l[j]);
        SQ[(row0 + j) * 512 + col] = (bf16)f2bf(q * exp_fast(bt - bl)); KDG[(row0 + j) * 512 + col] = (bf16)f2bf((1.0f - f) * exp_fast(bl - bt)); }
    if (tq == 0) ((float*)(ws + WS_DEC))[(size_t)(b * 32 + n) * 512 + col] = exp_fast(bl);
    __syncthreads();
}

template <int K> __device__ __forceinline__ void run_phase(const Args& args, LAS unsigned char* lds, float* Hout) {
    const int tid = threadIdx.x, lane = tid & 63, wave = __builtin_amdgcn_readfirstlane(tid >> 6);
    const int G = gridDim.x; const int bx = blockIdx.x; const int vcu = (G % 8 == 0) ? (bx % 8) * (G / 8) + bx / 8 : bx;
    unsigned char* ws = args.ws;
    const int gw = vcu * NWAVES + wave, NGW = G * NWAVES;
    float* PART = (float*)(ws + WS_PART);
    bf16* HB = (bf16*)(ws + WS_HB);
    const float* x = args.in[0];
    (void)lane; (void)gw; (void)NGW; (void)PART; (void)HB; (void)x; (void)Hout;
    if constexpr (K == 0) {
        LAS float* scr = (LAS float*)(lds + RING_OFF + wave * 16384);
        convert_mats(args, 0, 7, scr, gw, NGW, lane);
        { int m = gw; for (; m + 3 * NGW < M; m += 4 * NGW) x_rows_prep<4>(x, HB, PART, m, NGW, lane); for (; m < M; m += NGW) x_rows_prep<1>(x, HB, PART, m, NGW, lane); }
    }
    if constexpr (K == 1) {
        pg8::Gemm g{HB, (const bf16*)(ws + WS_W_EVEN_IN), M, EVEN_IN, D}; pg8::StaticOrder S; S.init(M, EVEN_IN, G, bx);
        pg8::EpiL0In E{PART, (bf16*)(ws + WS_U), (bf16*)(ws + WS_BB), (bf16*)(ws + WS_SQ), (bf16*)(ws + WS_IV), (bf16*)(ws + WS_SG0), (float*)(ws + WS_LOGF), args.in[7]};
        pg8::gemm_phase<pg8::EpiL0In, pg8::StaticOrder, true, true>(lds + RING_OFF, g, S, E);
    }
    if constexpr (K == 2) {
        for (int u = bx; u < BATCH * 4 * 32; u += G) hgrn_prep(lds, ws, u);
    }
    if constexpr (K == 3) {
        for (int u = bx; u < 32; u += G) { const int b = u >> 2, h = u & 3; const size_t r5 = (size_t)b * SEQ * 512 + h * 128;
            cs::ScanIO io; io.Qd = (const bf16*)(ws + WS_SQ) + r5; io.Kd = (const bf16*)(ws + WS_KD) + r5; io.qk_ld = 512; io.V = (const bf16*)(ws + WS_IV) + r5; io.v_ld = 512;
            io.dec = (const float*)(ws + WS_DEC) + (size_t)b * 32 * 512 + h * 128; io.dec_const = 0.f;
            io.Out = (bf16*)(ws + WS_MIX0) + (size_t)b * SEQ * 1024 + 512 + h * 128; io.out_ld = 1024; io.SG = (const bf16*)(ws + WS_SG0) + r5; io.sg_ld = 512;
            cs::chunk_scan<128, 128, true>(lds, io); }
        { int cb, ncb; if (G > 32) { cb = bx - 32; ncb = G - 32; } else { cb = bx; ncb = G; }
          if (cb >= 0) { const bf16* U = (const bf16*)(ws + WS_U); const bf16* Bb = (const bf16*)(ws + WS_BB); bf16* MIX = (bf16*)(ws + WS_MIX0); const float* cw = args.in[6];
            for (int it = cb * 512 + tid; it < M * 64; it += ncb * 512) { const int row = it >> 6, c0 = (it & 63) * 8, t = row & (SEQ - 1);
                const v4u u0 = *(const GAS v4u*)(U + (size_t)row * 512 + c0); v4u u1 = (v4u){0u, 0u, 0u, 0u}, u2 = u1;
                if (t >= 1) u1 = *(const GAS v4u*)(U + (size_t)(row - 1) * 512 + c0);
                if (t >= 2) u2 = *(const GAS v4u*)(U + (size_t)(row - 2) * 512 + c0);
                const v4u bb = *(const GAS v4u*)(Bb + (size_t)row * 512 + c0);
                float y[8];
#pragma unroll
                for (int p = 0; p < 4; ++p) { const int c = c0 + 2 * p;
                    y[2 * p] = bflo(bb[p]) * (cw[c] * bflo(u2[p]) + cw[512 + c] * bflo(u1[p]) + cw[1024 + c] * bflo(u0[p]));
                    y[2 * p + 1] = bfhi(bb[p]) * (cw[c + 1] * bfhi(u2[p]) + cw[512 + c + 1] * bfhi(u1[p]) + cw[1024 + c + 1] * bfhi(u0[p])); }
                v4u o; o.x = pk2(y[0], y[1]); o.y = pk2(y[2], y[3]); o.z = pk2(y[4], y[5]); o.w = pk2(y[6], y[7]);
                *(GAS v4u*)(MIX + (size_t)row * 1024 + c0) = o; } } }
    }
    if constexpr (K == 4) {
        pg8::Gemm g{(const bf16*)(ws + WS_MIX0), (const bf16*)(ws + WS_W_EVEN_OUT), M, D, D}; pg8::StaticOrder S; S.init(M, D, G, bx);
        pg8::EpiResid E{x, Hout, HB, PART};
        pg8::gemm_phase<pg8::EpiResid, pg8::StaticOrder, true, true>(lds + RING_OFF, g, S, E);
    }
    if constexpr (K == 5) {
        pg8::Gemm g{HB, (const bf16*)(ws + WS_W_FFN_IN0), M, FF2, D}; pg8::StaticOrder S; S.init(M, FF2, G, bx);
        pg8::EpiSwiGLU E{PART, (bf16*)(ws + WS_ACT0)};
        pg8::gemm_phase<pg8::EpiSwiGLU, pg8::StaticOrder, true, true>(lds + RING_OFF, g, S, E);
    }
    if constexpr (K == 6) {
        pg8::Gemm g{(const bf16*)(ws + WS_ACT0), (const bf16*)(ws + WS_W_FFN_OUT0), M, D, FFH}; pg8::StaticOrder S; S.init(M, D, G, bx);
        pg8::EpiResid E{args.out, Hout, HB, PART};
        pg8::gemm_phase<pg8::EpiResid, pg8::StaticOrder, true, true>(lds + RING_OFF, g, S, E);
    }
    if constexpr (K == 7) {
        pg8::Gemm g{HB, (const bf16*)(ws + WS_W_ODD_IN), M, ODD_IN, D}; pg8::StaticOrder S; S.init(M, ODD_IN, G, bx);
        pg8::EpiL1In E{PART, (const int*)args.in[1], (bf16*)(ws + WS_Q), (bf16*)(ws + WS_K), (bf16*)(ws + WS_V), (bf16*)(ws + WS_G)};
        pg8::gemm_phase<pg8::EpiL1In, pg8::StaticOrder, true, true>(lds + RING_OFF, g, S, E);
    }
    if constexpr (K == 8) {
        for (int u0 = bx; u0 < 256; u0 += G) { const int u = (G == 256) ? (((u0 & 7) * 4 + (u0 >> 6)) * 8 + ((u0 >> 3) & 7)) : u0;
            const int b = u >> 5, h = (u >> 3) & 3, vs = u & 7;
            const float lg = __builtin_amdgcn_logf(1.0f - exp2f(-5.0f - (float)h));
            cs::ScanIO io; io.Qd = (const bf16*)(ws + WS_Q) + (size_t)b * SEQ * 1024 + h * 256; io.Kd = (const bf16*)(ws + WS_K) + (size_t)b * SEQ * 1024 + h * 256; io.qk_ld = 1024;
            io.V = (const bf16*)(ws + WS_V) + (size_t)b * SEQ * 2048 + h * 512 + vs * 64; io.v_ld = 2048; io.dec = nullptr; io.dec_const = __builtin_amdgcn_exp2f(64.0f * lg);
            io.Out = (bf16*)(ws + WS_V) + (size_t)b * SEQ * 2048 + h * 512 + vs * 64; io.out_ld = 2048; io.SG = nullptr; io.sg_ld = 0;
            cs::chunk_scan<256, 64, false>(lds, io); }
    }
    if constexpr (K == 9) {
        LAS float* scr = (LAS float*)(lds + RING_OFF + wave * 16384);
        convert_mats(args, 7, 8, scr, gw, NGW, lane);
        const bf16* O = (const bf16*)(ws + WS_V); bf16* Gp = (bf16*)(ws + WS_G);
        for (int it0 = gw; it0 < M * 4; it0 += 4 * NGW) {
            v4u ov[4], gv[4]; size_t off[4];
#pragma unroll
            for (int i = 0; i < 4; ++i) { int it = it0 + i * NGW; if (it >= M * 4) it = it0; off[i] = (size_t)(it >> 2) * 2048 + (it & 3) * 512 + lane * 8;
                ov[i] = *(const GAS v4u*)(O + off[i]); gv[i] = *(const GAS v4u*)(Gp + off[i]); }
#pragma unroll
            for (int i = 0; i < 4; ++i) { float o[8]; float sm = 0.f;
#pragma unroll
                for (int p = 0; p < 4; ++p) { o[2 * p] = bflo(ov[i][p]); o[2 * p + 1] = bfhi(ov[i][p]); sm += o[2 * p] + o[2 * p + 1]; }
                const float mu = wave_sum(sm) * (1.0f / 512.0f); float q = 0.f;
#pragma unroll
                for (int e = 0; e < 8; ++e) { o[e] -= mu; q += o[e] * o[e]; }
                const float rstd = 1.0f / sqrtf(wave_sum(q) * (1.0f / 512.0f) + RMS_EPS);
                v4u w;
#pragma unroll
                for (int p = 0; p < 4; ++p) w[p] = pk2(o[2 * p] * rstd * bflo(gv[i][p]), o[2 * p + 1] * rstd * bfhi(gv[i][p]));
                if (it0 + i * NGW < M * 4) *(GAS v4u*)(Gp + off[i]) = w; } }
    }
    if constexpr (K == 10) {
        pg8::Gemm g{(const bf16*)(ws + WS_G), (const bf16*)(ws + WS_W_ODD_OUT), M, D, 2048}; pg8::StaticOrder S; S.init(M, D, G, bx);
        pg8::EpiResid E{args.out, Hout, HB, PART};
        pg8::gemm_phase<pg8::EpiResid, pg8::StaticOrder, true, true>(lds + RING_OFF, g, S, E);
    }
    if constexpr (K == 11) {
        pg8::Gemm g{HB, (const bf16*)(ws + WS_W_FFN_IN1), M, FF2, D}; pg8::StaticOrder S; S.init(M, FF2, G, bx);
        pg8::EpiSwiGLU E{PART, (bf16*)(ws + WS_ACT1)};
        pg8::gemm_phase<pg8::EpiSwiGLU, pg8::StaticOrder, true, true>(lds + RING_OFF, g, S, E);
    }
    if constexpr (K == 12) {
        pg8::Gemm g{(const bf16*)(ws + WS_ACT1), (const bf16*)(ws + WS_W_FFN_OUT1), M, D, FFH}; pg8::StaticOrder S; S.init(M, D, G, bx);
        pg8::EpiResid E{args.out, Hout, HB, PART};
        pg8::gemm_phase<pg8::EpiResid, pg8::StaticOrder, true, true>(lds + RING_OFF, g, S, E);
    }
    if constexpr (K == 13) {
        const float* wf = args.in[4];
        f32x4 wv[4];
#pragma unroll
        for (int j = 0; j < 4; ++j) wv[j] = *((const GAS f32x4*)wf + lane + 64 * j);
        for (int m0 = gw; m0 < M; m0 += 2 * NGW) { f32x4 v[2][4];
#pragma unroll
            for (int i = 0; i < 2; ++i) { const int m = (m0 + i * NGW < M) ? m0 + i * NGW : m0; const GAS f32x4* hr = (const GAS f32x4*)(args.out + (size_t)m * D) + lane;
#pragma unroll
                for (int j = 0; j < 4; ++j) v[i][j] = hr[64 * j]; }
#pragma unroll
            for (int i = 0; i < 2; ++i) { float sq = 0.f;
#pragma unroll
                for (int j = 0; j < 4; ++j) sq += (v[i][j].x * v[i][j].x + v[i][j].y * v[i][j].y) + (v[i][j].z * v[i][j].z + v[i][j].w * v[i][j].w);
                const float rs = 1.0f / sqrtf(wave_sum(sq) * (1.0f / 1024.0f) + RMS_EPS);
                if (m0 + i * NGW < M) { GAS f32x4* hw = (GAS f32x4*)(args.out + (size_t)(m0 + i * NGW) * D) + lane;
#pragma unroll
                    for (int j = 0; j < 4; ++j) hw[64 * j] = v[i][j] * rs * wv[j]; } } }
    }
}

__global__ void __launch_bounds__(NWAVES * 64, 2) fwd_kernel(Args args) {
    extern __shared__ __attribute__((aligned(16))) unsigned char lds_raw[];
    LAS unsigned char* lds = (LAS unsigned char*)lds_raw;
    volatile LAS unsigned* MISC = (volatile LAS unsigned*)(lds + MISC_OFF);
    gu32* ctl = (gu32*)(args.ws + WS_CTL);
    for (int u = threadIdx.x; u < (LDS_BYTES - LDSCTL_OFF) / 4; u += NWAVES * 64) ((LAS unsigned*)(lds + LDSCTL_OFF))[u] = 0u;
    __syncthreads();
    XcdBarrier bar; bar.bar = (unsigned*)(ctl + CW_BAR); bar.x = 0; bar.st = nullptr;
    if (N_LAUNCHES == 1) bar = xcd_barrier_post((unsigned*)(ctl + CW_BAR), MISC + 8);
#define GRID_BAR() do { if (N_LAUNCHES == 1) xcd_barrier(bar); } while (0)
    const int lo = args.ph_lo, hi = args.ph_hi;
#define IN(k) (lo <= (k) && (k) < hi)
#define PHASE(k) do { if (IN(k)) { run_phase<k>(args, lds, args.out); if ((k) + 1 < N_PHASES && IN((k) + 1)) GRID_BAR(); } } while (0)
    PHASE(0); PHASE(1); PHASE(2); PHASE(3); PHASE(4); PHASE(5); PHASE(6); PHASE(7); PHASE(8); PHASE(9); PHASE(10); PHASE(11); PHASE(12); PHASE(13);
#define REPLAY(k) do { if ((PROBE_MASK >> (k)) & 1) { for (int rep_ = 0; rep_ < PROBE_REPS; ++rep_) { GRID_BAR(); run_phase<k>(args, lds, (float*)(args.ws + 192 * MiB)); } } } while (0)
    REPLAY(0); REPLAY(1); REPLAY(2); REPLAY(3); REPLAY(4); REPLAY(5); REPLAY(6); REPLAY(7); REPLAY(8); REPLAY(9); REPLAY(10); REPLAY(11); REPLAY(12);
#undef IN
#undef PHASE
#undef REPLAY
#undef GRID_BAR
}

extern "C" void kernel_launch(void* const* d_in, const int* in_sizes, int n_in, void* d_out, int out_size, void* d_ws, size_t ws_size, hipStream_t stream) {
    static int grid = 0;
    if (grid == 0) {
        if (n_in != 15 || in_sizes[0] != M * D || out_size != M * D || ws_size < WS_END) { fprintf(stderr, "kernel_launch: unexpected problem shape (n_in %d, in0 %d, out %d, ws %zu); nothing launched\n", n_in, n_in > 0 ? in_sizes[0] : -1, out_size, ws_size); grid = -1; return; }
        int dev = 0, cus = 0, per_cu = 0;
        if (hipGetDevice(&dev) != hipSuccess || hipDeviceGetAttribute(&cus, hipDeviceAttributeMultiprocessorCount, dev) != hipSuccess) { grid = -1; return; }
        if (hipFuncSetAttribute((const void*)fwd_kernel, hipFuncAttributeMaxDynamicSharedMemorySize, LDS_BYTES) != hipSuccess) { fprintf(stderr, "kernel_launch: hipFuncSetAttribute failed\n"); grid = -1; return; }
        if (hipOccupancyMaxActiveBlocksPerMultiprocessor(&per_cu, (const void*)fwd_kernel, NWAVES * 64, LDS_BYTES) != hipSuccess || per_cu < 1)
            fprintf(stderr, "kernel_launch: note: occupancy query reports %d workgroups per CU\n", per_cu);
        (void)hipGetLastError();
        grid = cus;
    }
    if (grid < 0) return;
    if (hipMemsetAsync((char*)d_ws + WS_CTL, 0, CTL_ZERO_BYTES, stream) != hipSuccess) { fprintf(stderr, "kernel_launch: hipMemsetAsync failed\n"); return; }
    Args a{};
    for (int i = 0; i < 15; ++i) a.in[i] = (const float*)d_in[i];
    a.out = (float*)d_out; a.ws = (unsigned char*)d_ws;
    for (int li = 0; li < N_LAUNCHES; ++li) {
        if (N_LAUNCHES == 1) { a.ph_lo = 0; a.ph_hi = N_PHASES; } else { a.ph_lo = li; a.ph_hi = li + 1; }
        a.li = li;
        hipLaunchKernelGGL(fwd_kernel, dim3(grid), dim3(NWAVES * 64), LDS_BYTES, stream, a);
        const hipError_t le = hipPeekAtLastError();
        if (le != hipSuccess) { fprintf(stderr, "kernel_launch: launch %d failed: %s\n", li, hipGetErrorName(le)); break; }
    }
}
```

```cpp
#include <hip/hip_runtime.h>
#include <cstdio>
#include <cstdint>
namespace pg8 {
#define PG8_LAS __attribute__((address_space(3)))
typedef unsigned short bf16_t;
typedef short bf16x8 __attribute__((ext_vector_type(8)));
typedef float f32x4 __attribute__((ext_vector_type(4)));
typedef unsigned u32x4 __attribute__((ext_vector_type(4)));
constexpr int BM = 256, BK = 64, HALF = 128, HTB = HALF * BK * 2  , STAGE_BYTES = 8 * HTB, NXCD = 8, WGM = 8;

__host__ __device__ __forceinline__ int lds_byte(int r, int c) { const int st = (r >> 4) * 2 + (c >> 5), rr = r & 15, cc = c & 31, ob = rr * 64 + cc * 2; return st * 1024 + (ob ^ (((ob >> 9) & 1) << 5)); }
__host__ __device__ __forceinline__ void stage_rc(int b, int& R, int& C) { const int st = b / 1024, sb = b % 1024, swz = sb ^ (((sb >> 9) & 1) << 5); R = (st >> 1) * 16 + swz / 64; C = (st & 1) * 32 + (swz % 64) / 2; }
__host__ __device__ __forceinline__ int perm32(int rho) { const int n = rho >> 4, i = rho & 15; return 8 * (i >> 2) + 4 * n + (i & 3); }

struct Unit { int pm, pn; };
struct Gemm { const bf16_t* A; const bf16_t* Bt; int M, N, K; };

struct StaticOrder {
    int nM, nN, nwg, G, c;
    __host__ __device__ void init(int M, int N, int G_, int c_) { nM = M / BM; nN = N / BM; nwg = nM * nN; G = G_; c = c_; }
    __host__ __device__ bool next(int i, Unit& u) const {
        const long L = (long)i * G + c; if (L >= nwg) return false;
        int wgid = (int)L; { const int q = nwg / NXCD, r = nwg % NXCD, xcd = wgid % NXCD, off = wgid / NXCD; wgid = (xcd < r ? xcd * (q + 1) : r * (q + 1) + (xcd - r) * q) + off; }
        const int nig = WGM * nN, gid = wgid / nig, fm = gid * WGM, gsz = (nM - fm) < WGM ? (nM - fm) : WGM;
        u.pm = fm + ((wgid % nig) % gsz); u.pn = (wgid % nig) / gsz; return true;
    }
    __device__ __forceinline__ void a_ready(const Unit&) const {}
    __device__ __forceinline__ void done(const Unit&) const {}
};

__device__ __forceinline__ unsigned cvt_pk_bf16(float lo, float hi) { unsigned r; asm volatile("v_cvt_pk_bf16_f32 %0, %1, %2" : "=v"(r) : "v"(lo), "v"(hi)); return r; }
__device__ __forceinline__ float fast_rcp(float x) { return __builtin_amdgcn_rcpf(x); }
__device__ __forceinline__ float fast_exp(float x) { return __builtin_amdgcn_exp2f(x * 1.44269504089f); }
__device__ __forceinline__ float fast_log(float x) { return __builtin_amdgcn_logf(x) * 0.69314718056f; }
__device__ __forceinline__ float silu_f(float x) { return x * fast_rcp(1.0f + fast_exp(-x)); }
__device__ __forceinline__ float sigmoid_f(float x) { return fast_rcp(1.0f + fast_exp(-x)); }
constexpr float RMS_EPS = 1e-6f;
__device__ __forceinline__ float row_rs(const float* part, int row) {
    const f32x4* p = (const f32x4*)(part + (size_t)row * 16);
    const f32x4 a = p[0], b = p[1], c = p[2], d = p[3];
    const float s = ((a[0] + a[1]) + (a[2] + a[3])) + ((b[0] + b[1]) + (b[2] + b[3])) + ((c[0] + c[1]) + (c[2] + c[3])) + ((d[0] + d[1]) + (d[2] + d[3]));
    return 1.0f / sqrtf(s * (1.0f / 1024.0f) + RMS_EPS);
}
__device__ __forceinline__ void store_bf16x8(bf16_t* p, const f32x4 v0, const f32x4 v1) {
    u32x4 w; w.x = cvt_pk_bf16(v0[0], v0[1]); w.y = cvt_pk_bf16(v0[2], v0[3]); w.z = cvt_pk_bf16(v1[0], v1[1]); w.w = cvt_pk_bf16(v1[2], v1[3]);
    *(u32x4*)p = w;
}

struct EpiL0In {
    static constexpr bool PERM = true, AFTER_DRAIN = false;
    const float* part;
    bf16_t *U, *Bb, *SQ, *IV, *SG; float* LOGF; const float* lbl;
    __device__ __forceinline__ void operator()(const f32x4 (&acc)[2][2][4][2], const Unit& u, int wr, int wc, int fr, int fq) const {
        const int row0 = u.pm * BM + wr * 64 + fr, cw = wc * 32 + 8 * fq, pn = u.pn;
        if (pn < 4) {
#pragma unroll
            for (int ai = 0; ai < 2; ++ai)
#pragma unroll
                for (int m = 0; m < 4; ++m) { const int row = row0 + ai * HALF + m * 16; const float r = row_rs(part, row), r2 = r * r;
                    const f32x4 v0 = acc[ai][0][m][0] * acc[ai][1][m][0] * r2, v1 = acc[ai][0][m][1] * acc[ai][1][m][1] * r2;
                    store_bf16x8(U + (size_t)row * 512 + pn * 128 + cw, v0, v1); }
        } else {
            const int seg = (pn - 4) >> 1, cb = ((pn - 4) & 1) * 256;
            float lb[2][8];
            if (seg == 2) {
#pragma unroll
                for (int bj = 0; bj < 2; ++bj)
#pragma unroll
                    for (int e = 0; e < 8; ++e) { const int c = cb + bj * HALF + cw + e; lb[bj][e] = fast_rcp(1.0f + fast_exp(lbl[512 + c] - lbl[c])); }
            }
#pragma unroll
            for (int ai = 0; ai < 2; ++ai)
#pragma unroll
                for (int m = 0; m < 4; ++m) { const int row = row0 + ai * HALF + m * 16; const float r = row_rs(part, row);
#pragma unroll
                    for (int bj = 0; bj < 2; ++bj) { const int col = cb + bj * HALF + cw; f32x4 v0 = acc[ai][bj][m][0] * r, v1 = acc[ai][bj][m][1] * r; const size_t off = (size_t)row * 512 + col;
                        if (seg == 0) store_bf16x8(Bb + off, v0, v1);
                        else if (seg == 1) { _Pragma("unroll") for (int e = 0; e < 4; ++e) { v0[e] = silu_f(v0[e]); v1[e] = silu_f(v1[e]); } store_bf16x8(SQ + off, v0, v1); }
                        else if (seg == 2) { _Pragma("unroll") for (int e = 0; e < 4; ++e) { const float l0 = lb[bj][e], l1 = lb[bj][4 + e];
                                v0[e] = fast_log(l0 + (1.0f - l0) * sigmoid_f(v0[e])); v1[e] = fast_log(l1 + (1.0f - l1) * sigmoid_f(v1[e])); }
                            *(f32x4*)(LOGF + off) = v0; *(f32x4*)(LOGF + off + 4) = v1; }
                        else if (seg == 3) store_bf16x8(IV + off, v0, v1);
                        else { _Pragma("unroll") for (int e = 0; e < 4; ++e) { v0[e] = silu_f(v0[e]); v1[e] = silu_f(v1[e]); } store_bf16x8(SG + off, v0, v1); }
                    } }
        }
    }
};

struct EpiSwiGLU {
    static constexpr bool PERM = true, AFTER_DRAIN = false;
    const float* part; bf16_t* ACT;
    __device__ __forceinline__ void operator()(const f32x4 (&acc)[2][2][4][2], const Unit& u, int wr, int wc, int fr, int fq) const {
        const int row0 = u.pm * BM + wr * 64 + fr, cw = wc * 32 + 8 * fq;
#pragma unroll
        for (int ai = 0; ai < 2; ++ai)
#pragma unroll
            for (int m = 0; m < 4; ++m) { const int row = row0 + ai * HALF + m * 16; const float r = row_rs(part, row);
                f32x4 g0 = acc[ai][0][m][0] * r, g1 = acc[ai][0][m][1] * r; const f32x4 u0 = acc[ai][1][m][0] * r, u1 = acc[ai][1][m][1] * r;
#pragma unroll
                for (int e = 0; e < 4; ++e) { g0[e] = silu_f(g0[e]) * u0[e]; g1[e] = silu_f(g1[e]) * u1[e]; }
                store_bf16x8(ACT + (size_t)row * 2816 + u.pn * 128 + cw, g0, g1); }
    }
};

template <bool BASE_F32> struct EpiResid {
    static constexpr bool PERM = true, AFTER_DRAIN = false;
    const float* X; bf16_t* HB; float* PART;
    __device__ __forceinline__ void operator()(const f32x4 (&acc)[2][2][4][2], const Unit& u, int wr, int wc, int fr, int fq) const {
        const int row0 = u.pm * BM + wr * 64 + fr, col0 = u.pn * BM + wc * 32 + 8 * fq;
#pragma unroll
        for (int ai = 0; ai < 2; ++ai)
#pragma unroll
            for (int m = 0; m < 4; ++m) { const int row = row0 + ai * HALF + m * 16; const size_t off = (size_t)row * 1024 + col0; float s = 0.f;
#pragma unroll
                for (int bj = 0; bj < 2; ++bj) { const size_t o = off + bj * HALF; f32x4 h0, h1;
                    if (BASE_F32) { h0 = *(const f32x4*)(X + o) + acc[ai][bj][m][0]; h1 = *(const f32x4*)(X + o + 4) + acc[ai][bj][m][1]; }
                    else { const u32x4 bv = *(const u32x4*)(HB + o);
                        h0 = (f32x4){__builtin_bit_cast(float, bv.x << 16), __builtin_bit_cast(float, bv.x & 0xffff0000u), __builtin_bit_cast(float, bv.y << 16), __builtin_bit_cast(float, bv.y & 0xffff0000u)} + acc[ai][bj][m][0];
                        h1 = (f32x4){__builtin_bit_cast(float, bv.z << 16), __builtin_bit_cast(float, bv.z & 0xffff0000u), __builtin_bit_cast(float, bv.w << 16), __builtin_bit_cast(float, bv.w & 0xffff0000u)} + acc[ai][bj][m][1]; }
                    store_bf16x8(HB + o, h0, h1);
                    s += ((h0[0] * h0[0] + h0[1] * h0[1]) + (h0[2] * h0[2] + h0[3] * h0[3])) + ((h1[0] * h1[0] + h1[1] * h1[1]) + (h1[2] * h1[2] + h1[3] * h1[3])); }
                s += __shfl_xor(s, 16); s += __shfl_xor(s, 32);
                if (fq == 0) PART[(size_t)row * 16 + u.pn * 4 + wc] = s; }
    }
};

struct EpiL1In {
    static constexpr bool PERM = true, AFTER_DRAIN = false;
    const float* part; const int* pos; bf16_t *Q, *Kk, *V, *G;
    __device__ __forceinline__ void operator()(const f32x4 (&acc)[2][2][4][2], const Unit& u, int wr, int wc, int fr, int fq) const {
        const int row0 = u.pm * BM + wr * 64 + fr, cw = wc * 32 + 8 * fq, pn = u.pn;
        if (pn < 8) {
            const int head = pn & 3; bf16_t* O = (pn < 4) ? Q : Kk; const float sc = (pn < 4) ? 1.0f : 0.0625f;
            const float lgam = __builtin_amdgcn_logf(1.0f - __builtin_amdgcn_exp2f(-5.0f - (float)head)) * ((pn < 4) ? 1.0f : -1.0f);
            float fr_rev[8];
#pragma unroll
            for (int e = 0; e < 8; ++e) fr_rev[e] = __builtin_amdgcn_exp2f((float)(cw + e) * (-13.287712379549449f / 128.0f)) * 0.15915494309189535f;
#pragma unroll
            for (int ai = 0; ai < 2; ++ai)
#pragma unroll
                for (int m = 0; m < 4; ++m) { const int row = row0 + ai * HALF + m * 16; const float r = row_rs(part, row) * sc * __builtin_amdgcn_exp2f((float)((row & 63) - 63) * lgam); const float p = (float)pos[row];
                    f32x4 o1[2], o2[2];
#pragma unroll
                    for (int n = 0; n < 2; ++n)
#pragma unroll
                        for (int e = 0; e < 4; ++e) { const float rev = p * fr_rev[4 * n + e]; const float fr_ = rev - floorf(rev);
                            const float sn = __builtin_amdgcn_sinf(fr_), cs = __builtin_amdgcn_cosf(fr_);
                            const float x1 = acc[ai][0][m][n][e] * r, x2 = acc[ai][1][m][n][e] * r;
                            o1[n][e] = x1 * cs - x2 * sn; o2[n][e] = x1 * sn + x2 * cs; }
                    bf16_t* rp = O + (size_t)row * 1024 + head * 256 + cw;
                    store_bf16x8(rp, o1[0], o1[1]); store_bf16x8(rp + 128, o2[0], o2[1]); }
        } else {
            const bool isg = pn >= 16; bf16_t* O = isg ? G : V; const int cb = ((pn - 8) & 7) * 256;
#pragma unroll
            for (int ai = 0; ai < 2; ++ai)
#pragma unroll
                for (int m = 0; m < 4; ++m) { const int row = row0 + ai * HALF + m * 16; const float r = row_rs(part, row);
#pragma unroll
                    for (int bj = 0; bj < 2; ++bj) { f32x4 v0 = acc[ai][bj][m][0] * r, v1 = acc[ai][bj][m][1] * r;
                        if (isg) { _Pragma("unroll") for (int e = 0; e < 4; ++e) { v0[e] = silu_f(v0[e]); v1[e] = silu_f(v1[e]); } }
                        store_bf16x8(O + (size_t)row * 2048 + cb + bj * HALF + cw, v0, v1); } }
        }
    }
};

template <class Epi, class Sched, bool ALIGN_EPI = false, bool SP2 = false>
__device__ __forceinline__ void gemm_phase(PG8_LAS unsigned char* lds, const Gemm g, const Sched& S, const Epi& E) {
    const int tid = threadIdx.x, wid = __builtin_amdgcn_readfirstlane(tid >> 6), lane = tid & 63, wr = wid >> 2, wc = wid & 3, fr = lane & 15, fq = lane >> 4;
    const int K = g.K, nt = K / BK;
    unsigned voffA[2], voffB[2];
#pragma unroll
    for (int i = 0; i < 2; ++i) { int R, C; stage_rc(tid * 16 + i * 8192, R, C); const int Rb = Epi::PERM ? ((R & ~31) + perm32(R & 31)) : R;
        voffA[i] = (unsigned)(R * K + C) * 2u; voffB[i] = (unsigned)(Rb * K + C) * 2u; }
    const size_t kstep = (size_t)(BK * 2);
    const size_t hstep = (size_t)HALF * K * 2;
    const size_t tstep = 2 * hstep;
    const unsigned ldsw = (unsigned)wid * 1024u;
    const int aoff = lds_byte(wr * 64 + fr, fq * 8), boff = lds_byte(wc * 32 + fr, fq * 8);
#define PG8_SA(b, h) (((b) * 2 + (h)) * HTB)
#define PG8_SB(b, h) ((4 + (b) * 2 + (h)) * HTB)
#define PG8_STAGE(bufoff, gbase, voff) do { _Pragma("unroll") for (int _i = 0; _i < 2; ++_i) \
        __builtin_amdgcn_global_load_lds((const unsigned*)((const char*)(gbase) + (voff)[_i]), (PG8_LAS unsigned*)(lds + (bufoff) + ldsw + _i * 8192), 16, 0, 0); } while (0)
#define PG8_LDA(dst, b, h) do { _Pragma("unroll") for (int m = 0; m < 4; ++m) _Pragma("unroll") for (int k = 0; k < 2; ++k) dst[m][k] = *(const PG8_LAS bf16x8*)(lds + PG8_SA(b, h) + aoff + m * 2048 + k * 1024); } while (0)
#define PG8_LDB(dst, b, h) do { _Pragma("unroll") for (int n = 0; n < 2; ++n) _Pragma("unroll") for (int k = 0; k < 2; ++k) dst[n][k] = *(const PG8_LAS bf16x8*)(lds + PG8_SB(b, h) + boff + n * 2048 + k * 1024); } while (0)
#define PG8_MMA(ai, bj, At, Bt) do { __builtin_amdgcn_s_setprio(1); _Pragma("unroll") for (int m = 0; m < 4; ++m) _Pragma("unroll") for (int n = 0; n < 2; ++n) _Pragma("unroll") for (int k = 0; k < 2; ++k) \
        acc[ai][bj][m][n] = __builtin_amdgcn_mfma_f32_16x16x32_bf16(Bt[n][k], At[m][k], acc[ai][bj][m][n], 0, 0, 0); __builtin_amdgcn_s_setprio(0); } while (0)
#define PG8_WAIT_V(n) asm volatile("s_waitcnt vmcnt(" #n ")" ::: "memory")
#define PG8_WAIT_L(n) asm volatile("s_waitcnt lgkmcnt(" #n ")" ::: "memory")
#define PG8_BAR __builtin_amdgcn_s_barrier()
#define PG8_SCHED __builtin_amdgcn_sched_barrier(0)
    Unit cur, nxt; int ui = 0;
    if (!S.next(0, cur)) return;
    f32x4 acc[2][2][4][2];
#pragma unroll
    for (int a = 0; a < 2; ++a)
#pragma unroll
        for (int b = 0; b < 2; ++b)
#pragma unroll
            for (int m = 0; m < 4; ++m)
#pragma unroll
                for (int n = 0; n < 2; ++n) acc[a][b][m][n] = (f32x4){0.f, 0.f, 0.f, 0.f};
    bf16x8 At[4][2], B0[2][2], B1[2][2];
    const char* cA = (const char*)g.A + (size_t)cur.pm * tstep; const char* cB = (const char*)g.Bt + (size_t)cur.pn * tstep;
    S.a_ready(cur);
    if constexpr (SP2) {
        PG8_STAGE(PG8_SB(0, 0), cB, voffB); PG8_STAGE(PG8_SB(0, 1), cB + hstep, voffB); PG8_STAGE(PG8_SA(0, 0), cA, voffA); PG8_STAGE(PG8_SA(0, 1), cA + hstep, voffA);
        if (wr == 1) PG8_BAR;
        PG8_WAIT_V(2); PG8_BAR;
        PG8_STAGE(PG8_SB(1, 0), cB + kstep, voffB); PG8_STAGE(PG8_SA(1, 0), cA + kstep, voffA); PG8_STAGE(PG8_SB(1, 1), cB + hstep + kstep, voffB);
        PG8_WAIT_V(6); PG8_BAR;
    } else {
        PG8_STAGE(PG8_SB(0, 0), cB, voffB); PG8_STAGE(PG8_SA(0, 0), cA, voffA); PG8_STAGE(PG8_SB(0, 1), cB + hstep, voffB); PG8_STAGE(PG8_SA(0, 1), cA + hstep, voffA);
        if (wr == 1) PG8_BAR;
        PG8_WAIT_V(4); PG8_BAR;
        PG8_STAGE(PG8_SB(1, 0), cB + kstep, voffB); PG8_STAGE(PG8_SA(1, 0), cA + kstep, voffA); PG8_STAGE(PG8_SB(1, 1), cB + hstep + kstep, voffB);
        PG8_WAIT_V(6); PG8_BAR;
    }
    for (;;) {
        const bool has_next = S.next(ui + 1, nxt);
        const char* nA = has_next ? (const char*)g.A + (size_t)nxt.pm * tstep : cA; const char* nB = has_next ? (const char*)g.Bt + (size_t)nxt.pn * tstep : cB;
        for (int t = 0; t < nt; t += 2) {
            const bool last = (t == nt - 2);
            const char* a1 = cA + (size_t)(t + 1) * kstep;
            const char* a2 = last ? nA : cA + (size_t)(t + 2) * kstep; const char* b2 = last ? nB : cB + (size_t)(t + 2) * kstep;
            const char* a3 = a2 + kstep; const char* b3 = b2 + kstep;
            if (last && has_next) S.a_ready(nxt);
            if constexpr (SP2) {
            PG8_LDB(B0, 0, 0); PG8_LDB(B1, 0, 1); PG8_SCHED; PG8_LDA(At, 0, 0); PG8_STAGE(PG8_SA(1, 1), a1 + hstep, voffA);
            PG8_WAIT_V(8); PG8_WAIT_L(0); PG8_BAR; PG8_MMA(0, 0, At, B0); PG8_MMA(0, 1, At, B1); PG8_BAR; PG8_SCHED;
            PG8_LDA(At, 0, 1); PG8_STAGE(PG8_SB(0, 0), b2, voffB); PG8_STAGE(PG8_SB(0, 1), b2 + hstep, voffB); PG8_STAGE(PG8_SA(0, 0), a2, voffA);
            PG8_WAIT_V(8); PG8_WAIT_L(0); PG8_BAR; PG8_MMA(1, 0, At, B0); PG8_MMA(1, 1, At, B1); PG8_BAR; PG8_SCHED;
            PG8_LDB(B0, 1, 0); PG8_LDB(B1, 1, 1); PG8_SCHED; PG8_LDA(At, 1, 0); PG8_STAGE(PG8_SA(0, 1), a2 + hstep, voffA);
            PG8_WAIT_V(8); PG8_WAIT_L(0); PG8_BAR; PG8_MMA(0, 0, At, B0); PG8_MMA(0, 1, At, B1); PG8_BAR; PG8_SCHED;
            PG8_LDA(At, 1, 1); PG8_STAGE(PG8_SB(1, 0), b3, voffB); PG8_STAGE(PG8_SB(1, 1), b3 + hstep, voffB); PG8_STAGE(PG8_SA(1, 0), a3, voffA);
            PG8_WAIT_V(8); PG8_WAIT_L(0); PG8_BAR; PG8_MMA(1, 0, At, B0); PG8_MMA(1, 1, At, B1); PG8_BAR; PG8_SCHED;
            } else {
            PG8_LDB(B0, 0, 0); PG8_SCHED; PG8_LDA(At, 0, 0); PG8_STAGE(PG8_SA(1, 1), a1 + hstep, voffA);
            PG8_WAIT_L(8); PG8_BAR; PG8_WAIT_L(0); PG8_MMA(0, 0, At, B0); PG8_BAR; PG8_SCHED;
            PG8_LDB(B1, 0, 1); PG8_STAGE(PG8_SB(0, 0), b2, voffB);
            PG8_BAR; PG8_WAIT_L(0); PG8_MMA(0, 1, At, B1); PG8_BAR;
            PG8_LDA(At, 0, 1); PG8_STAGE(PG8_SA(0, 0), a2, voffA);
            PG8_BAR; PG8_WAIT_L(0); PG8_MMA(1, 0, At, B0); PG8_BAR; PG8_SCHED;
            PG8_STAGE(PG8_SB(0, 1), b2 + hstep, voffB);
            PG8_WAIT_V(6); PG8_BAR; PG8_MMA(1, 1, At, B1); PG8_BAR;
            PG8_LDB(B0, 1, 0); PG8_SCHED; PG8_LDA(At, 1, 0); PG8_STAGE(PG8_SA(0, 1), a2 + hstep, voffA);
            PG8_WAIT_L(8); PG8_BAR; PG8_WAIT_L(0); PG8_MMA(0, 0, At, B0); PG8_BAR; PG8_SCHED;
            PG8_LDB(B1, 1, 1); PG8_STAGE(PG8_SB(1, 0), b3, voffB);
            PG8_BAR; PG8_WAIT_L(0); PG8_MMA(0, 1, At, B1); PG8_BAR;
            PG8_LDA(At, 1, 1); PG8_STAGE(PG8_SA(1, 0), a3, voffA);
            PG8_BAR; PG8_WAIT_L(0); PG8_MMA(1, 0, At, B0); PG8_BAR; PG8_SCHED;
            PG8_STAGE(PG8_SB(1, 1), b3 + hstep, voffB);
            PG8_WAIT_V(6); PG8_BAR; PG8_MMA(1, 1, At, B1); PG8_BAR;
            }
        }
        if constexpr (ALIGN_EPI) { if (wr == 0) PG8_BAR; }
        if constexpr (!Epi::AFTER_DRAIN) { E(acc, cur, wr, wc, fr, fq); S.done(cur); }
        if (!has_next) break;
#pragma unroll
        for (int a = 0; a < 2; ++a)
#pragma unroll
            for (int b = 0; b < 2; ++b)
#pragma unroll
                for (int m = 0; m < 4; ++m)
#pragma unroll
                    for (int n = 0; n < 2; ++n) acc[a][b][m][n] = (f32x4){0.f, 0.f, 0.f, 0.f};
        cur = nxt; cA = nA; cB = nB; ++ui;
        if constexpr (ALIGN_EPI) { if (wr == 1) PG8_BAR; }
    }
    PG8_WAIT_V(0);
    if constexpr (!ALIGN_EPI) { if (wr == 0) PG8_BAR; }
    PG8_BAR;
    if constexpr (Epi::AFTER_DRAIN) { E.fused(acc, cur, wr, wc, fr, fq, lds, wid, lane); S.done(cur); }
#undef PG8_SA
#undef PG8_SB
#undef PG8_STAGE
#undef PG8_LDA
#undef PG8_LDB
#undef PG8_MMA
#undef PG8_WAIT_V
#undef PG8_WAIT_L
#undef PG8_BAR
#undef PG8_SCHED
}
}
#define GAS __attribute__((address_space(1)))
#define LAS __attribute__((address_space(3)))
typedef unsigned short bf16;
typedef unsigned v4u __attribute__((ext_vector_type(4)));
typedef float f32x4 __attribute__((ext_vector_type(4)));
typedef short bf16x8 __attribute__((ext_vector_type(8)));
typedef GAS unsigned gu32;
typedef GAS unsigned long long gu64;
#define RLX_AGENT __ATOMIC_RELAXED, __HIP_MEMORY_SCOPE_AGENT
#define LDS_WAIT() asm volatile("s_waitcnt lgkmcnt(0)" ::: "memory")
#define VM_WAIT() asm volatile("s_waitcnt vmcnt(0)" ::: "memory")
__device__ __forceinline__ unsigned long long rt() { return __builtin_amdgcn_s_memrealtime(); }
__device__ __forceinline__ unsigned f2bf(float f) { unsigned u = __builtin_bit_cast(unsigned, f); return (u + 0x7fffu + ((u >> 16) & 1u)) >> 16; }
__device__ __forceinline__ unsigned pk2(float lo, float hi) { return f2bf(lo) | (f2bf(hi) << 16); }

#define XB_TMO      128
#define XB_XCNT(j)  (256  + 64 * (j))
#define XB_XSUB(j)  (1280 + 64 * (j))
#define XB_XGEN(j)  (2304 + 64 * (j))
#define XB_TOP      3328
#define XB_TOPGEN   3392
#define XCD_BAR_WORDS 3456
#define XB_SPIN_CAP (1u << 18)

__device__ __forceinline__ unsigned xb_ld(unsigned* p)              { return __hip_atomic_load(p, __ATOMIC_RELAXED, __HIP_MEMORY_SCOPE_AGENT); }
__device__ __forceinline__ unsigned xb_add(unsigned* p, unsigned v) { return __hip_atomic_fetch_add(p, v, __ATOMIC_RELAXED, __HIP_MEMORY_SCOPE_AGENT); }
__device__ __forceinline__ unsigned xb_xcc_id() { return (unsigned)__builtin_amdgcn_s_getreg((3 << 11) | 20) & 0xFu; }
#define XB_SPIN(cond, bar) do { unsigned _sp = 0; while (cond) { __builtin_amdgcn_s_sleep(1); \
    if ((++_sp & 255u) == 0u) { if (xb_ld(&(bar)[XB_TMO])) break; if (_sp > XB_SPIN_CAP) { atomicAdd(&(bar)[XB_TMO], 1u); break; } } } } while (0)

struct XcdBarrier {
    unsigned* bar; unsigned x;
    volatile LAS unsigned* st;
};

__device__ __forceinline__ XcdBarrier xcd_barrier_post(unsigned* bar, volatile LAS unsigned* st) {
    XcdBarrier b; b.bar = bar; b.x = xb_xcc_id(); b.st = st;
    if (threadIdx.x == 0) (void)xb_add(&bar[XB_XCNT(b.x)], 1u);
    return b;
}
__device__ __forceinline__ void xcd_barrier_complete(unsigned* bar, unsigned x, unsigned& nloc, unsigned& nx) {
    const unsigned G = gridDim.x * gridDim.y * gridDim.z;
    unsigned sum, cnt, mine, sp = 0u;
    for (;;) {
        sum = 0u; cnt = 0u; mine = 0u;
#pragma unroll
        for (unsigned j = 0; j < 16; ++j) { const unsigned c = xb_ld(&bar[XB_XCNT(j)]); sum += c; cnt += (c > 0u) ? 1u : 0u; mine = (j == x) ? c : mine; }
        if (sum == G) break;
        __builtin_amdgcn_s_sleep(1);
        if ((++sp & 255u) == 0u) { if (xb_ld(&bar[XB_TMO])) break; if (sp > XB_SPIN_CAP) { atomicAdd(&bar[XB_TMO], 1u); break; } }
    }
    nloc = mine > 0u ? mine : 1u; nx = cnt > 0u ? cnt : 1u;
}

__device__ __forceinline__ void xcd_barrier(const XcdBarrier& b) {
    asm volatile("s_waitcnt vmcnt(0)" ::: "memory");
    __syncthreads();
    if (threadIdx.x == 0) {
        unsigned* bar = b.bar;
        __builtin_amdgcn_s_waitcnt(0);
        unsigned nloc = b.st[0], nx = b.st[1];
        if (nloc == 0u) { xcd_barrier_complete(bar, b.x, nloc, nx); b.st[0] = nloc; b.st[1] = nx; }
        const unsigned old = xb_add(&bar[XB_XSUB(b.x)], 1u);
        const unsigned gen = old / nloc;
        if (old + 1u == (gen + 1u) * nloc) {
            __builtin_amdgcn_fence(__ATOMIC_RELEASE, "agent");
            asm volatile("s_waitcnt vmcnt(0)" ::: "memory");
            const unsigned og = xb_add(&bar[XB_TOP], 1u);
            const unsigned tg = og / nx;
            if (og + 1u == (tg + 1u) * nx) xb_add(&bar[XB_TOPGEN], 1u);
            else XB_SPIN(xb_ld(&bar[XB_TOPGEN]) == tg, bar);
            __builtin_amdgcn_fence(__ATOMIC_ACQUIRE, "agent");
            xb_add(&bar[XB_XGEN(b.x)], 1u);
            asm volatile("s_waitcnt vmcnt(0)" ::: "memory");
        } else {
            XB_SPIN(xb_ld(&bar[XB_XGEN(b.x)]) == gen, bar);
            __builtin_amdgcn_fence(__ATOMIC_ACQUIRE, "agent");
            asm volatile("s_waitcnt vmcnt(0)" ::: "memory");
        }
    }
    __syncthreads();
}
__device__ __forceinline__ float bf2f(unsigned short u) { return __builtin_bit_cast(float, (unsigned)u << 16); }
__device__ __forceinline__ float bflo(unsigned u) { return __builtin_bit_cast(float, u << 16); }
__device__ __forceinline__ float bfhi(unsigned u) { return __builtin_bit_cast(float, u & 0xffff0000u); }
__device__ __forceinline__ float wave_sum(float v) {
#pragma unroll
    for (int o = 1; o < 64; o <<= 1) v += __shfl_xor(v, o);
    return v;
}


namespace cs {
typedef short bf16x8 __attribute__((ext_vector_type(8)));
typedef short s16x4 __attribute__((ext_vector_type(4)));
typedef float f32x16 __attribute__((ext_vector_type(16)));
typedef float f32x2 __attribute__((ext_vector_type(2)));
typedef __bf16 bf16x2_t __attribute__((ext_vector_type(2)));
typedef unsigned u32x2 __attribute__((ext_vector_type(2)));
#define CS_MFMA(a, b, c) __builtin_amdgcn_mfma_f32_32x32x16_bf16((a), (b), (c), 0, 0, 0)
__device__ __forceinline__ unsigned pkbf(float lo, float hi) { return __builtin_bit_cast(unsigned, __builtin_convertvector((f32x2){lo, hi}, bf16x2_t)); }
template <int NCH> __device__ __forceinline__ unsigned img_off(unsigned row, unsigned ch) { return (128u * NCH) * (row >> 3) + 512u * (ch >> 2) + 64u * (row & 7) + 16u * ((ch & 3) ^ ((row >> 2) & 3)); }
template <int NCH> __device__ __forceinline__ bf16x8 row_read(LAS unsigned char* img, unsigned rowbase, int s, int r, int h) {
    return *(const LAS bf16x8*)(img + img_off<NCH>(rowbase + r, 2 * s + h));
}
template <int NCH> __device__ __forceinline__ unsigned tr_addr(unsigned lane, unsigned c, unsigned ks, unsigned t) {
    const unsigned h = lane >> 5, blk = (lane >> 4) & 1, q = (lane & 15) >> 2, p = lane & 3;
    return img_off<NCH>(16 * ks + 8 * h + 4 * t + q, 4 * c + 2 * blk + (p >> 1)) + 8 * (p & 1);
}
__device__ __forceinline__ void tr_read_ab(unsigned a0, unsigned a1, unsigned b0, unsigned b1, bf16x8& a, bf16x8& b) {
    s16x4 alo, ahi, blo, bhi;
    asm volatile("ds_read_b64_tr_b16 %0, %4\n\tds_read_b64_tr_b16 %1, %5\n\tds_read_b64_tr_b16 %2, %6\n\tds_read_b64_tr_b16 %3, %7\n\ts_waitcnt lgkmcnt(0)"
                 : "=&v"(alo), "=&v"(ahi), "=&v"(blo), "=&v"(bhi) : "v"(a0), "v"(a1), "v"(b0), "v"(b1) : "memory");
    a = __builtin_shufflevector(alo, ahi, 0, 1, 2, 3, 4, 5, 6, 7); b = __builtin_shufflevector(blo, bhi, 0, 1, 2, 3, 4, 5, 6, 7);
}
__device__ __forceinline__ bf16x8 tr_read_1(unsigned a0, unsigned a1) {
    s16x4 alo, ahi;
    asm volatile("ds_read_b64_tr_b16 %0, %2\n\tds_read_b64_tr_b16 %1, %3\n\ts_waitcnt lgkmcnt(0)" : "=&v"(alo), "=&v"(ahi) : "v"(a0), "v"(a1) : "memory");
    return __builtin_shufflevector(alo, ahi, 0, 1, 2, 3, 4, 5, 6, 7);
}
__device__ __forceinline__ int crow(int reg, int h) { return (reg & 3) + 8 * (reg >> 2) + 4 * h; }

struct ScanIO {
    const bf16* Qd; const bf16* Kd; int qk_ld;
    const bf16* V; int v_ld;
    const float* dec;
    float dec_const;
    bf16* Out; int out_ld;
    const bf16* SG; int sg_ld;
};

struct RR { unsigned e, o; };
template <int NCH> __device__ __forceinline__ RR rr_make(unsigned imgbase, unsigned row, unsigned h) { RR b; b.e = imgbase + img_off<NCH>(row, h); b.o = imgbase + img_off<NCH>(row, 2 + h); return b; }
__device__ __forceinline__ bf16x8 rr_read(LAS unsigned char* lds, const RR b, int s) { return *(const LAS bf16x8*)(lds + ((s & 1) ? b.o : b.e) + 512 * (s >> 1)); }
__device__ __forceinline__ bf16x8 tr8(LAS unsigned char* lds, unsigned a0, unsigned a1) {
    const s16x4 lo = __builtin_amdgcn_ds_read_tr16_b64_v4i16((LAS s16x4*)(lds + a0)), hi = __builtin_amdgcn_ds_read_tr16_b64_v4i16((LAS s16x4*)(lds + a1));
    return __builtin_shufflevector(lo, hi, 0, 1, 2, 3, 4, 5, 6, 7);
}

template <int DK, int DV, bool VECDEC> __device__ __forceinline__ void chunk_scan(LAS unsigned char* lds, const ScanIO io) {
    constexpr int C = 64, NCHUNKS = 2048 / C, KS = DK / 16, NVT = DV / 32, NCHK = DK / 8, NCHV = DV / 8;
    constexpr int QD = 0, KD = C * DK * 2, V0 = 2 * C * DK * 2, VSZ = C * DV * 2, SDT = V0 + 2 * VSZ, PIM = SDT + DV * DK * 2, OB = PIM + C * C * 2, END = OB + C * DV * 4;
    static_assert(END <= 146944, "scan LDS map");
    constexpr int NQ = (C * NCHK) / 512, NV = (C * NCHV) / 512;
    static_assert(NQ * 512 == C * NCHK && NV * 512 == C * NCHV, "staging split");
    static_assert(NCHUNKS % 2 == 0, "the chunk loop is unrolled by two (two prefetch register sets)");
    constexpr int NS = (DK / 32) * NVT / 8;
    static_assert(NVT == 2 || NVT == 4, "DV is 64 or 128"); static_assert(NS == 1 || NS == 2, "one or two state tiles per wave");
    constexpr bool ZALL = (2 * NVT == 8);
    constexpr unsigned KSTEP_K = 2 * 128 * NCHK, KSTEP_V = 2 * 128 * NCHV;
    const int wave0 = __builtin_amdgcn_readfirstlane(threadIdx.x >> 6); const unsigned lane0 = threadIdx.x & 63;
    f32x16 S0, S1, Z;
#pragma unroll
    for (int i = 0; i < 16; ++i) { S0[i] = 0.f; S1[i] = 0.f; Z[i] = 0.f; }
    v4u pqA[NQ], pkA[NQ], pvA[NV], pqB[NQ], pkB[NQ], pvB[NV];
    f32x4 dvA[4], dvB[4];
#define CS_IDS() int wave = wave0; unsigned lane = lane0; asm volatile("" : "+s"(wave)); asm volatile("" : "+v"(lane)); \
        const unsigned r = lane & 31, h = lane >> 5; const int tid = wave * 64 + (int)lane; \
        const bool zw = ZALL ? true : (wave < 2 * NVT); const int z_it = wave / NVT, z_vt = wave % NVT; \
        const int xw0 = ZALL ? 0 : 2 * NVT; const bool xw = (wave >= xw0 && wave < xw0 + 3); const int xt = wave - xw0; const int x_jt = (xt == 2) ? 1 : 0, x_it = (xt == 0) ? 0 : 1; \
        const int s_kt = (NS * wave) / NVT, s_vt0 = (NS * wave) % NVT; (void)r; (void)h; (void)tid; (void)zw; (void)z_it; (void)z_vt; (void)xw; (void)x_jt; (void)x_it; (void)s_kt; (void)s_vt0
#define CS_LOAD_CHUNK(n_, pq, pk, pv, dv) do { const size_t rowb_ = (size_t)(n_) * C; \
        _Pragma("unroll") for (int i_ = 0; i_ < NQ; ++i_) { const int c_ = tid + 512 * i_, row_ = c_ / NCHK, ch_ = c_ % NCHK; \
            pq[i_] = *(const GAS v4u*)(io.Qd + (rowb_ + row_) * io.qk_ld + ch_ * 8); pk[i_] = *(const GAS v4u*)(io.Kd + (rowb_ + row_) * io.qk_ld + ch_ * 8); } \
        _Pragma("unroll") for (int i_ = 0; i_ < NV; ++i_) { const int c_ = tid + 512 * i_, row_ = c_ / NCHV, ch_ = c_ % NCHV; \
            pv[i_] = *(const GAS v4u*)(io.V + (rowb_ + row_) * io.v_ld + ch_ * 8); } \
        if (VECDEC) { _Pragma("unroll") for (int g_ = 0; g_ < 4; ++g_) dv[g_] = *(const GAS f32x4*)(io.dec + (size_t)(n_) * 512 + 32 * s_kt + 8 * g_ + 4 * h); } } while (0)
#define CS_STAGE_CHUNK(vbuf_, pq, pk, pv) do { \
        _Pragma("unroll") for (int i_ = 0; i_ < NQ; ++i_) { const int c_ = tid + 512 * i_, row_ = c_ / NCHK, ch_ = c_ % NCHK; const unsigned o_ = img_off<NCHK>(row_, ch_); \
            *(LAS v4u*)(lds + o_ + QD) = pq[i_]; *(LAS v4u*)(lds + o_ + KD) = pk[i_]; } \
        _Pragma("unroll") for (int i_ = 0; i_ < NV; ++i_) { const int c_ = tid + 512 * i_, row_ = c_ / NCHV, ch_ = c_ % NCHV; \
            *(LAS v4u*)(lds + img_off<NCHV>(row_, ch_) + V0 + (vbuf_) * VSZ) = pv[i_]; } } while (0)
#define CS_WRITE_SDT() do { \
        _Pragma("unroll") for (int g_ = 0; g_ < 4; ++g_) { \
            u32x2 w0_, w1_; w0_.x = pkbf(S0[4 * g_], S0[4 * g_ + 1]); w0_.y = pkbf(S0[4 * g_ + 2], S0[4 * g_ + 3]); w1_.x = pkbf(S1[4 * g_], S1[4 * g_ + 1]); w1_.y = pkbf(S1[4 * g_ + 2], S1[4 * g_ + 3]); \
            *(LAS u32x2*)(lds + SDT + img_off<NCHK>(32 * s_vt0 + r, 4 * s_kt + g_) + 8 * h) = w0_; \
            if (NS == 2) *(LAS u32x2*)(lds + SDT + img_off<NCHK>(32 * (s_vt0 + 1) + r, 4 * s_kt + g_) + 8 * h) = w1_; } } while (0)
#define CS_OUTPUT(n_) do { const size_t rowb_ = (size_t)(n_) * C; const LAS float* ob_ = (const LAS float*)(lds + OB); \
        _Pragma("unroll") for (int i_ = 0; i_ < (C * DV) / (512 * 8); ++i_) { const int e_ = (tid + 512 * i_) * 8, row_ = e_ / DV, c8_ = e_ % DV; \
            const f32x4 a_ = *(const LAS f32x4*)(ob_ + row_ * DV + c8_), b_ = *(const LAS f32x4*)(ob_ + row_ * DV + c8_ + 4); \
            v4u w_; w_.x = pkbf(a_[0], a_[1]); w_.y = pkbf(a_[2], a_[3]); w_.z = pkbf(b_[0], b_[1]); w_.w = pkbf(b_[2], b_[3]); \
            *(GAS v4u*)(io.Out + (rowb_ + row_) * io.out_ld + c8_) = w_; } } while (0)

#define CS_ITER(n, pqX, pkX, pvX, dvX, pqY, pkY, pvY, dvY) do { \
        CS_IDS(); \
        const unsigned vb = V0 + ((n) & 1) * VSZ; \
          \
        if ((n) > 0) CS_OUTPUT((n) - 1); \
        if ((n) + 2 < NCHUNKS) CS_LOAD_CHUNK((n) + 2, pqX, pkX, pvX, dvX); \
        if (xw) {                                                      \
            f32x16 x; \
            _Pragma("unroll") for (int i = 0; i < 16; ++i) x[i] = 0.f; \
            const RR ra = rr_make<NCHK>(KD, 32 * x_jt + r, h), rb = rr_make<NCHK>(QD, 32 * x_it + r, h); \
            _Pragma("unroll") for (int s = 0; s < KS; ++s) { const bf16x8 a = rr_read(lds, ra, s), b = rr_read(lds, rb, s); x = CS_MFMA(a, b, x); } \
            if (x_jt == x_it) { _Pragma("unroll") for (int i = 0; i < 16; ++i) x[i] = ((unsigned)crow(i, h) > r) ? 0.f : x[i]; } \
            _Pragma("unroll") for (int g = 0; g < 4; ++g) { u32x2 w; w.x = pkbf(x[4 * g], x[4 * g + 1]); w.y = pkbf(x[4 * g + 2], x[4 * g + 3]); \
                *(LAS u32x2*)(lds + PIM + img_off<8>(32 * x_it + r, 4 * x_jt + g) + 8 * h) = w; } \
        } \
        if (zw) {                                                      \
            _Pragma("unroll") for (int i = 0; i < 16; ++i) Z[i] = 0.f; \
            const RR ra = rr_make<NCHK>(QD, 32 * z_it + r, h), rb = rr_make<NCHK>(SDT, 32 * z_vt + r, h); \
            _Pragma("unroll") for (int s = 0; s < KS; ++s) { const bf16x8 a = rr_read(lds, ra, s), b = rr_read(lds, rb, s); Z = CS_MFMA(a, b, Z); } \
        } \
        {                                                              \
            const unsigned tk0 = KD + tr_addr<NCHK>(lane, s_kt, 0, 0), tk1 = KD + tr_addr<NCHK>(lane, s_kt, 0, 1); \
            const unsigned t0a = vb + tr_addr<NCHV>(lane, s_vt0, 0, 0), t0b = vb + tr_addr<NCHV>(lane, s_vt0, 0, 1); \
            const unsigned t1a = vb + tr_addr<NCHV>(lane, s_vt0 + (NS - 1), 0, 0), t1b = vb + tr_addr<NCHV>(lane, s_vt0 + (NS - 1), 0, 1); \
            _Pragma("unroll") for (int ks = 0; ks < C / 16; ++ks) { \
                const bf16x8 a = tr8(lds, tk0 + ks * KSTEP_K, tk1 + ks * KSTEP_K), b0 = tr8(lds, t0a + ks * KSTEP_V, t0b + ks * KSTEP_V); \
                S0 = CS_MFMA(a, b0, S0); \
                if (NS == 2) { const bf16x8 b1 = tr8(lds, t1a + ks * KSTEP_V, t1b + ks * KSTEP_V); S1 = CS_MFMA(a, b1, S1); } } \
        } \
        __syncthreads(); \
          \
        if (zw) {                                                      \
            const RR rp = rr_make<8>(PIM, 32 * z_it + r, h); \
            const unsigned tza = vb + tr_addr<NCHV>(lane, z_vt, 0, 0), tzb = vb + tr_addr<NCHV>(lane, z_vt, 0, 1); \
            _Pragma("unroll") for (int s = 0; s < 4; ++s) { if (s < 2 * (z_it + 1)) { const bf16x8 a = rr_read(lds, rp, s); \
                    const bf16x8 b = tr8(lds, tza + s * KSTEP_V, tzb + s * KSTEP_V); Z = CS_MFMA(a, b, Z); } } \
            LAS float* ob = (LAS float*)(lds + OB) + (32 * z_it + 4 * h) * DV + 32 * z_vt + r; \
            _Pragma("unroll") for (int i = 0; i < 16; ++i) ob[((i & 3) + 8 * (i >> 2)) * DV] = Z[i]; \
        } \
        if ((n) + 1 < NCHUNKS) { \
            if (VECDEC) { _Pragma("unroll") for (int i = 0; i < 16; ++i) { const float d = dvY[i >> 2][i & 3]; S0[i] *= d; S1[i] *= d; } } \
            else { _Pragma("unroll") for (int i = 0; i < 16; ++i) { S0[i] *= io.dec_const; S1[i] *= io.dec_const; } } \
            CS_WRITE_SDT(); \
            CS_STAGE_CHUNK(((n) + 1) & 1, pqY, pkY, pvY); \
        } \
        __syncthreads(); \
    } while (0)

    { CS_IDS(); CS_WRITE_SDT(); CS_LOAD_CHUNK(0, pqA, pkA, pvA, dvA); CS_STAGE_CHUNK(0, pqA, pkA, pvA); CS_LOAD_CHUNK(1, pqB, pkB, pvB, dvB); }
    __syncthreads();
    for (int n = 0; n < NCHUNKS; n += 2) {
        CS_ITER(n, pqA, pkA, pvA, dvA, pqB, pkB, pvB, dvB);
        CS_ITER(n + 1, pqB, pkB, pvB, dvB, pqA, pkA, pvA, dvA);
    }
    { CS_IDS(); CS_OUTPUT(NCHUNKS - 1); }
    __syncthreads();
#undef CS_IDS
#undef CS_LOAD_CHUNK
#undef CS_LOAD_SG
#undef CS_STAGE_CHUNK
#undef CS_WRITE_SDT
#undef CS_OUTPUT
#undef CS_ITER
}
}

constexpr int NWAVES = 8;
using pg8::RMS_EPS;
constexpr int BATCH = 8, SEQ = 2048, D = 1024, M = BATCH * SEQ;
constexpr int EVEN_IN = 3584, ODD_IN = 6144, FFH = 2816, FF2 = 5632;
constexpr int N_PHASES = 15;
#ifndef MK_N_LAUNCHES
#define MK_N_LAUNCHES 1
#endif
constexpr int N_LAUNCHES = MK_N_LAUNCHES;
#ifndef PROBE_MASK
#define PROBE_MASK 0
#endif
#ifndef PROBE_REPS
#define PROBE_REPS 1
#endif

constexpr size_t MiB = 1u << 20;
constexpr size_t WS_CTL = 0, CTL_ZERO_BYTES = 64 * 1024;
constexpr size_t WS_PART = 1 * MiB;
constexpr size_t WS_W_ODD_IN = 2 * MiB, WS_W_ODD_OUT = 14 * MiB, WS_W_FFN_IN1 = 18 * MiB, WS_W_FFN_OUT1 = 2 * MiB  ;
constexpr size_t WS_HB = 32 * MiB;
constexpr size_t WS_W_EVEN_IN = 64 * MiB, WS_W_EVEN_OUT = 71 * MiB, WS_W_FFN_IN0 = 73 * MiB, WS_W_FFN_OUT0 = 84 * MiB;
constexpr size_t WS_U = 96 * MiB, WS_BB = 112 * MiB, WS_SQ = 128 * MiB, WS_LOGF = 144 * MiB, WS_IV = 176 * MiB, WS_SG0 = 192 * MiB, WS_MIX0 = 208 * MiB;
constexpr size_t WS_KD = 240 * MiB;
constexpr size_t WS_ORAW = 144 * MiB;
constexpr size_t WS_DEC = 29 * MiB;
constexpr size_t WS_ACT0 = 96 * MiB;
constexpr size_t WS_Q = 64 * MiB, WS_K = 96 * MiB, WS_V = 128 * MiB, WS_G = 192 * MiB;
constexpr size_t WS_ACT1 = 64 * MiB;
constexpr size_t WS_END = 256 * MiB;
constexpr int CW_BAR = 4096;

constexpr int RING_OFF = 0, RING_BYTES = 131072;
constexpr int LDS_BYTES = 147456;
constexpr int LDSCTL_OFF = LDS_BYTES - 512, MISC_OFF = LDSCTL_OFF + 320;

struct Args { const float* in[15]; float* out; unsigned char* ws; int ph_lo, ph_hi, li, pad; };

struct MatDesc { const float* W; int K, N; bf16* WT; const float* scale; int scale_from; int map; };
__device__ __forceinline__ int map_col(int map, int n) {
    if (map == 1) { const int seg = n >> 9, c = n & 511; if (seg == 0) return 256 * (c >> 7) + (c & 127); if (seg == 2) return 256 * (c >> 7) + 128 + (c & 127); if (seg == 1) return 1024 + c; return n; }
    if (map == 2) { if (n < FFH) return 256 * (n >> 7) + (n & 127); const int c = n - FFH; return 256 * (c >> 7) + 128 + (c & 127); }
    return n;
}
__device__ __forceinline__ void transpose_item(const MatDesc& md, LAS float* scr, int item, int lane) {
    const int N = md.N, K = md.K, nblk = N / 32, kb = item / nblk, nb = item % nblk, k0 = 64 * kb, n0 = 32 * nb;
    float wv[32];
#pragma unroll
    for (int i = 0; i < 32; ++i) wv[i] = md.W[(size_t)(k0 + 2 * i + (lane >> 5)) * N + n0 + (lane & 31)];
#pragma unroll
    for (int i = 0; i < 32; ++i) { const int kk = 2 * i + (lane >> 5); const int k = k0 + kk; float w = wv[i];
        if (md.scale && k >= md.scale_from) w *= md.scale[k - md.scale_from];
        scr[kk * 33 + (lane & 31)] = w; }
    LDS_WAIT(); asm volatile("" ::: "memory");
    const int c = lane & 7; const int d0 = map_col(md.map, n0);
#pragma unroll
    for (int j = 0; j < 4; ++j) { const int n = (lane >> 3) + 8 * j; const LAS float* s = scr + (8 * c) * 33 + n;
        v4u o; o.x = pk2(s[0 * 33], s[1 * 33]); o.y = pk2(s[2 * 33], s[3 * 33]); o.z = pk2(s[4 * 33], s[5 * 33]); o.w = pk2(s[6 * 33], s[7 * 33]);
        *(GAS v4u*)(md.WT + (size_t)(d0 + n) * K + k0 + 8 * c) = o; }
    LDS_WAIT(); asm volatile("" ::: "memory");
}
__device__ __forceinline__ MatDesc mat_desc(const Args& a, int mat) {
    unsigned char* ws = a.ws; MatDesc d;
    switch (mat) {
    case 0: d = MatDesc{a.in[5], D, EVEN_IN, (bf16*)(ws + WS_W_EVEN_IN), a.in[2], 0, 1}; break;
    case 1: d = MatDesc{a.in[9], D, D, (bf16*)(ws + WS_W_EVEN_OUT), a.in[8], 512, 0}; break;
    case 2: d = MatDesc{a.in[13], D, FF2, (bf16*)(ws + WS_W_FFN_IN0), a.in[3], 0, 2}; break;
    case 3: d = MatDesc{a.in[14], FFH, D, (bf16*)(ws + WS_W_FFN_OUT0), nullptr, 0, 0}; break;
    case 4: d = MatDesc{a.in[10], D, ODD_IN, (bf16*)(ws + WS_W_ODD_IN), a.in[2] + D, 0, 0}; break;
    case 5: d = MatDesc{a.in[12], 2048, D, (bf16*)(ws + WS_W_ODD_OUT), a.in[11], 0, 0}; break;
    case 6: d = MatDesc{a.in[13] + (size_t)D * FF2, D, FF2, (bf16*)(ws + WS_W_FFN_IN1), a.in[3] + D, 0, 2}; break;
    default: d = MatDesc{a.in[14] + (size_t)FFH * D, FFH, D, (bf16*)(ws + WS_W_FFN_OUT1), nullptr, 0, 0}; break;
    }
    return d;
}
__device__ __forceinline__ void convert_mats(const Args& a, int mat_lo, int mat_hi, LAS float* scr, int gw, int NGW, int lane) {
    for (int mat = mat_lo; mat < mat_hi; ++mat) { const MatDesc md = mat_desc(a, mat); const int nitems = (md.K / 64) * (md.N / 32);
        for (int it = gw; it < nitems; it += NGW) transpose_item(md, scr, it, lane); }
}
template <int NR> __device__ __forceinline__ void x_rows_prep(const float* x, bf16* hb, float* part, int m0, int stride, int lane) {
    f32x4 v[NR][4];
#pragma unroll
    for (int i = 0; i < NR; ++i) { const GAS f32x4* xr = (const GAS f32x4*)(x + (size_t)(m0 + i * stride) * D) + lane;
#pragma unroll
        for (int j = 0; j < 4; ++j) v[i][j] = xr[64 * j]; }
#pragma unroll
    for (int i = 0; i < NR; ++i) { const int m = m0 + i * stride; float s = 0.f;
#pragma unroll
        for (int j = 0; j < 4; ++j) s += (v[i][j].x * v[i][j].x + v[i][j].y * v[i][j].y) + (v[i][j].z * v[i][j].z + v[i][j].w * v[i][j].w);
        s = wave_sum(s);
        GAS unsigned long long* o8 = (GAS unsigned long long*)(hb + (size_t)m * D) + lane;
#pragma unroll
        for (int j = 0; j < 4; ++j) o8[64 * j] = (unsigned long long)pk2(v[i][j].x, v[i][j].y) | ((unsigned long long)pk2(v[i][j].z, v[i][j].w) << 32);
        if (lane < 16) part[(size_t)m * 16 + lane] = (lane == 0) ? s : 0.f; }
}

__device__ __forceinline__ float exp_fast(float x) { return __builtin_amdgcn_exp2f(x * 1.44269504089f); }
__device__ __forceinline__ void hgrn_prep(LAS unsigned char* lds, unsigned char* ws, int unit) {
    const int tid = threadIdx.x, k = tid & 127, tq = tid >> 7; const int b = unit >> 7, h = (unit >> 5) & 3, n = unit & 31;
    LAS float* part = (LAS float*)lds;
    const size_t row0 = (size_t)b * SEQ + n * 64 + 16 * tq; const int col = h * 128 + k;
    const float* LF = (const float*)(ws + WS_LOGF); bf16* SQ = (bf16*)(ws + WS_SQ); bf16* KDG = (bf16*)(ws + WS_KD);
    float l[16], c[16]; float run = 0.f;
#pragma unroll
    for (int j = 0; j < 16; ++j) l[j] = LF[(row0 + j) * 512 + col];
    unsigned short qh[16];
#pragma unroll
    for (int j = 0; j < 16; ++j) qh[j] = SQ[(row0 + j) * 512 + col];
#pragma unroll
    for (int j = 0; j < 16; ++j) { run += l[j]; c[j] = run; }
    part[tq * 128 + k] = run;
    __syncthreads();
    const float p0 = part[k], p1 = part[128 + k], p2 = part[256 + k], p3 = part[384 + k];
    const float bl = (p0 + p1) + (p2 + p3); const float pre = (tq > 0 ? p0 : 0.f) + (tq > 1 ? p1 : 0.f) + (tq > 2 ? p2 : 0.f);
#pragma unroll
    for (int j = 0; j < 16; ++j) { const float bt = pre + c[j]; const float q = bf2f(qh[j]); const float f = exp_fast(l[j]);
        SQ[(row0 + j) * 512 + col] = (bf16)f2bf(q * exp_fast(bt - bl)); KDG[(row0 + j) * 512 + col] = (bf16)f2bf((1.0f - f) * exp_fast(bl - bt)); }
    if (tq == 0) ((float*)(ws + WS_DEC))[(size_t)(b * 32 + n) * 512 + col] = exp_fast(bl);
    __syncthreads();
}

template <int K> __device__ __forceinline__ void run_phase(const Args& args, LAS unsigned char* lds, float* Hout) {
    const int tid = threadIdx.x, lane = tid & 63, wave = __builtin_amdgcn_readfirstlane(tid >> 6);
    const int G = gridDim.x; const int bx = blockIdx.x; const int vcu = (G % 8 == 0) ? (bx % 8) * (G / 8) + bx / 8 : bx;
    unsigned char* ws = args.ws;
    const int gw = vcu * NWAVES + wave, NGW = G * NWAVES;
    float* PART = (float*)(ws + WS_PART);
    bf16* HB = (bf16*)(ws + WS_HB);
    const float* x = args.in[0];
    (void)lane; (void)gw; (void)NGW; (void)PART; (void)HB; (void)x; (void)Hout;
    if constexpr (K == 0) {
        LAS float* scr = (LAS float*)(lds + RING_OFF + wave * 16384);
        convert_mats(args, 0, 1, scr, gw, NGW, lane);
        { int m = gw; for (; m + 3 * NGW < M; m += 4 * NGW) x_rows_prep<4>(x, HB, PART, m, NGW, lane); for (; m < M; m += NGW) x_rows_prep<1>(x, HB, PART, m, NGW, lane); }
    }
    if constexpr (K == 1) {
        pg8::Gemm g{HB, (const bf16*)(ws + WS_W_EVEN_IN), M, EVEN_IN, D}; pg8::StaticOrder S; S.init(M, EVEN_IN, G, bx);
        pg8::EpiL0In E{PART, (bf16*)(ws + WS_U), (bf16*)(ws + WS_BB), (bf16*)(ws + WS_SQ), (bf16*)(ws + WS_IV), (bf16*)(ws + WS_SG0), (float*)(ws + WS_LOGF), args.in[7]};
        pg8::gemm_phase<pg8::EpiL0In, pg8::StaticOrder, true, true>(lds + RING_OFF, g, S, E);
    }
    if constexpr (K == 2) {
        for (int u = bx; u < BATCH * 4 * 32; u += G) hgrn_prep(lds, ws, u);
    }
    if constexpr (K == 3) {
        for (int u = bx; u < 64; u += G) { const int b = u >> 3, h = (u >> 1) & 3, vs = u & 1; const size_t r5 = (size_t)b * SEQ * 512 + h * 128;
            cs::ScanIO io; io.Qd = (const bf16*)(ws + WS_SQ) + r5; io.Kd = (const bf16*)(ws + WS_KD) + r5; io.qk_ld = 512; io.V = (const bf16*)(ws + WS_IV) + r5 + vs * 64; io.v_ld = 512;
            io.dec = (const float*)(ws + WS_DEC) + (size_t)b * 32 * 512 + h * 128; io.dec_const = 0.f;
            io.Out = (bf16*)(ws + WS_ORAW) + r5 + vs * 64; io.out_ld = 512;
            cs::chunk_scan<128, 64, true>(lds, io); }
        { int cb, ncb; if (G > 64) { cb = bx - 64; ncb = G - 64; } else { cb = bx; ncb = G; }
          if (cb >= 0) { const bf16* U = (const bf16*)(ws + WS_U); const bf16* Bb = (const bf16*)(ws + WS_BB); bf16* MIX = (bf16*)(ws + WS_MIX0); const float* cw = args.in[6];
            for (int it = cb * 512 + tid; it < M * 64; it += ncb * 512) { const int row = it >> 6, c0 = (it & 63) * 8, t = row & (SEQ - 1);
                const v4u u0 = *(const GAS v4u*)(U + (size_t)row * 512 + c0); v4u u1 = (v4u){0u, 0u, 0u, 0u}, u2 = u1;
                if (t >= 1) u1 = *(const GAS v4u*)(U + (size_t)(row - 1) * 512 + c0);
                if (t >= 2) u2 = *(const GAS v4u*)(U + (size_t)(row - 2) * 512 + c0);
                const v4u bb = *(const GAS v4u*)(Bb + (size_t)row * 512 + c0);
                float y[8];
#pragma unroll
                for (int p = 0; p < 4; ++p) { const int c = c0 + 2 * p;
                    y[2 * p] = bflo(bb[p]) * (cw[c] * bflo(u2[p]) + cw[512 + c] * bflo(u1[p]) + cw[1024 + c] * bflo(u0[p]));
                    y[2 * p + 1] = bfhi(bb[p]) * (cw[c + 1] * bfhi(u2[p]) + cw[512 + c + 1] * bfhi(u1[p]) + cw[1024 + c + 1] * bfhi(u0[p])); }
                v4u o; o.x = pk2(y[0], y[1]); o.y = pk2(y[2], y[3]); o.z = pk2(y[4], y[5]); o.w = pk2(y[6], y[7]);
                *(GAS v4u*)(MIX + (size_t)row * 1024 + c0) = o; }
            LAS float* scr = (LAS float*)(lds + RING_OFF + wave * 16384);
            convert_mats(args, 1, 7, scr, cb * NWAVES + wave, ncb * NWAVES, lane); } }
    }
    if constexpr (K == 4) {
        const bf16* O = (const bf16*)(ws + WS_ORAW); const bf16* SG = (const bf16*)(ws + WS_SG0); bf16* MIX = (bf16*)(ws + WS_MIX0);
        for (int m0 = gw; m0 < M; m0 += 4 * NGW) { v4u ov[4], gv[4];
#pragma unroll
            for (int i = 0; i < 4; ++i) { const int m = (m0 + i * NGW < M) ? m0 + i * NGW : m0; ov[i] = *(const GAS v4u*)(O + (size_t)m * 512 + lane * 8); gv[i] = *(const GAS v4u*)(SG + (size_t)m * 512 + lane * 8); }
#pragma unroll
            for (int i = 0; i < 4; ++i) { float o[8]; float q = 0.f;
#pragma unroll
                for (int p = 0; p < 4; ++p) { o[2 * p] = bflo(ov[i][p]); o[2 * p + 1] = bfhi(ov[i][p]); q += o[2 * p] * o[2 * p] + o[2 * p + 1] * o[2 * p + 1]; }
                q += __shfl_xor(q, 1); q += __shfl_xor(q, 2); q += __shfl_xor(q, 4); q += __shfl_xor(q, 8);
                const float rstd = 1.0f / sqrtf(q * (1.0f / 128.0f) + RMS_EPS);
                v4u w;
#pragma unroll
                for (int p = 0; p < 4; ++p) w[p] = pk2(o[2 * p] * rstd * bflo(gv[i][p]), o[2 * p + 1] * rstd * bfhi(gv[i][p]));
                if (m0 + i * NGW < M) *(GAS v4u*)(MIX + (size_t)(m0 + i * NGW) * 1024 + 512 + lane * 8) = w; } }
    }
    if constexpr (K == 5) {
        pg8::Gemm g{(const bf16*)(ws + WS_MIX0), (const bf16*)(ws + WS_W_EVEN_OUT), M, D, D}; pg8::StaticOrder S; S.init(M, D, G, bx);
        pg8::EpiResid<true> E{x, HB, PART};
        pg8::gemm_phase<pg8::EpiResid<true>, pg8::StaticOrder, true, true>(lds + RING_OFF, g, S, E);
    }
    if constexpr (K == 6) {
        pg8::Gemm g{HB, (const bf16*)(ws + WS_W_FFN_IN0), M, FF2, D}; pg8::StaticOrder S; S.init(M, FF2, G, bx);
        pg8::EpiSwiGLU E{PART, (bf16*)(ws + WS_ACT0)};
        pg8::gemm_phase<pg8::EpiSwiGLU, pg8::StaticOrder, true, true>(lds + RING_OFF, g, S, E);
    }
    if constexpr (K == 7) {
        pg8::Gemm g{(const bf16*)(ws + WS_ACT0), (const bf16*)(ws + WS_W_FFN_OUT0), M, D, FFH}; pg8::StaticOrder S; S.init(M, D, G, bx);
        pg8::EpiResid<false> E{nullptr, HB, PART};
        pg8::gemm_phase<pg8::EpiResid<false>, pg8::StaticOrder, true, true>(lds + RING_OFF, g, S, E);
    }
    if constexpr (K == 8) {
        pg8::Gemm g{HB, (const bf16*)(ws + WS_W_ODD_IN), M, ODD_IN, D}; pg8::StaticOrder S; S.init(M, ODD_IN, G, bx);
        pg8::EpiL1In E{PART, (const int*)args.in[1], (bf16*)(ws + WS_Q), (bf16*)(ws + WS_K), (bf16*)(ws + WS_V), (bf16*)(ws + WS_G)};
        pg8::gemm_phase<pg8::EpiL1In, pg8::StaticOrder, true, true>(lds + RING_OFF, g, S, E);
    }
    if constexpr (K == 9) {
        for (int u0 = bx; u0 < 256; u0 += G) { const int u = (G == 256) ? (((u0 & 7) * 4 + (u0 >> 6)) * 8 + ((u0 >> 3) & 7)) : u0;
            const int b = u >> 5, h = (u >> 3) & 3, vs = u & 7;
            const float lg = __builtin_amdgcn_logf(1.0f - exp2f(-5.0f - (float)h));
            cs::ScanIO io; io.Qd = (const bf16*)(ws + WS_Q) + (size_t)b * SEQ * 1024 + h * 256; io.Kd = (const bf16*)(ws + WS_K) + (size_t)b * SEQ * 1024 + h * 256; io.qk_ld = 1024;
            io.V = (const bf16*)(ws + WS_V) + (size_t)b * SEQ * 2048 + h * 512 + vs * 64; io.v_ld = 2048; io.dec = nullptr; io.dec_const = __builtin_amdgcn_exp2f(64.0f * lg);
            io.Out = (bf16*)(ws + WS_V) + (size_t)b * SEQ * 2048 + h * 512 + vs * 64; io.out_ld = 2048;
            cs::chunk_scan<256, 64, false>(lds, io); }
    }
    if constexpr (K == 10) {
        LAS float* scr = (LAS float*)(lds + RING_OFF + wave * 16384);
        convert_mats(args, 7, 8, scr, gw, NGW, lane);
        const bf16* O = (const bf16*)(ws + WS_V); bf16* Gp = (bf16*)(ws + WS_G);
        for (int it0 = gw; it0 < M * 4; it0 += 4 * NGW) {
            v4u ov[4], gv[4]; size_t off[4];
#pragma unroll
            for (int i = 0; i < 4; ++i) { int it = it0 + i * NGW; if (it >= M * 4) it = it0; off[i] = (size_t)(it >> 2) * 2048 + (it & 3) * 512 + lane * 8;
                ov[i] = *(const GAS v4u*)(O + off[i]); gv[i] = *(const GAS v4u*)(Gp + off[i]); }
#pragma unroll
            for (int i = 0; i < 4; ++i) { float o[8]; float sm = 0.f;
#pragma unroll
                for (int p = 0; p < 4; ++p) { o[2 * p] = bflo(ov[i][p]); o[2 * p + 1] = bfhi(ov[i][p]); sm += o[2 * p] + o[2 * p + 1]; }
                const float mu = wave_sum(sm) * (1.0f / 512.0f); float q = 0.f;
#pragma unroll
                for (int e = 0; e < 8; ++e) { o[e] -= mu; q += o[e] * o[e]; }
                const float rstd = 1.0f / sqrtf(wave_sum(q) * (1.0f / 512.0f) + RMS_EPS);
                v4u w;
#pragma unroll
                for (int p = 0; p < 4; ++p) w[p] = pk2(o[2 * p] * rstd * bflo(gv[i][p]), o[2 * p + 1] * rstd * bfhi(gv[i][p]));
                if (it0 + i * NGW < M * 4) *(GAS v4u*)(Gp + off[i]) = w; } }
    }
    if constexpr (K == 11) {
        pg8::Gemm g{(const bf16*)(ws + WS_G), (const bf16*)(ws + WS_W_ODD_OUT), M, D, 2048}; pg8::StaticOrder S; S.init(M, D, G, bx);
        pg8::EpiResid<false> E{nullptr, HB, PART};
        pg8::gemm_phase<pg8::EpiResid<false>, pg8::StaticOrder, true, true>(lds + RING_OFF, g, S, E);
    }
    if constexpr (K == 12) {
        pg8::Gemm g{HB, (const bf16*)(ws + WS_W_FFN_IN1), M, FF2, D}; pg8::StaticOrder S; S.init(M, FF2, G, bx);
        pg8::EpiSwiGLU E{PART, (bf16*)(ws + WS_ACT1)};
        pg8::gemm_phase<pg8::EpiSwiGLU, pg8::StaticOrder, true, true>(lds + RING_OFF, g, S, E);
    }
    if constexpr (K == 13) {
        pg8::Gemm g{(const bf16*)(ws + WS_ACT1), (const bf16*)(ws + WS_W_FFN_OUT1), M, D, FFH}; pg8::StaticOrder S; S.init(M, D, G, bx);
        pg8::EpiResid<false> E{nullptr, HB, PART};
        pg8::gemm_phase<pg8::EpiResid<false>, pg8::StaticOrder, true, true>(lds + RING_OFF, g, S, E);
    }
    if constexpr (K == 14) {
        const float* wf = args.in[4];
        f32x4 wv[4];
#pragma unroll
        for (int j = 0; j < 2; ++j) { wv[2 * j] = *((const GAS f32x4*)(wf + 512 * j + 8 * lane)); wv[2 * j + 1] = *((const GAS f32x4*)(wf + 512 * j + 8 * lane + 4)); }
        for (int m0 = gw; m0 < M; m0 += 4 * NGW) { v4u hv[4][2];
#pragma unroll
            for (int i = 0; i < 4; ++i) { const int m = (m0 + i * NGW < M) ? m0 + i * NGW : m0;
#pragma unroll
                for (int j = 0; j < 2; ++j) hv[i][j] = *(const GAS v4u*)(HB + (size_t)m * D + 512 * j + 8 * lane); }
#pragma unroll
            for (int i = 0; i < 4; ++i) { float v[16]; float sq = 0.f;
#pragma unroll
                for (int j = 0; j < 2; ++j)
#pragma unroll
                    for (int p = 0; p < 4; ++p) { v[8 * j + 2 * p] = bflo(hv[i][j][p]); v[8 * j + 2 * p + 1] = bfhi(hv[i][j][p]); sq += v[8 * j + 2 * p] * v[8 * j + 2 * p] + v[8 * j + 2 * p + 1] * v[8 * j + 2 * p + 1]; }
                const float rs = 1.0f / sqrtf(wave_sum(sq) * (1.0f / 1024.0f) + RMS_EPS);
                if (m0 + i * NGW < M) { float* orow = args.out + (size_t)(m0 + i * NGW) * D;
#pragma unroll
                    for (int j = 0; j < 2; ++j) { *(GAS f32x4*)(orow + 512 * j + 8 * lane) = (f32x4){v[8 * j] * rs, v[8 * j + 1] * rs, v[8 * j + 2] * rs, v[8 * j + 3] * rs} * wv[2 * j];
                        *(GAS f32x4*)(orow + 512 * j + 8 * lane + 4) = (f32x4){v[8 * j + 4] * rs, v[8 * j + 5] * rs, v[8 * j + 6] * rs, v[8 * j + 7] * rs} * wv[2 * j + 1]; } } } }
    }
}

__global__ void __launch_bounds__(NWAVES * 64, 2) fwd_kernel(Args args) {
    extern __shared__ __attribute__((aligned(16))) unsigned char lds_raw[];
    LAS unsigned char* lds = (LAS unsigned char*)lds_raw;
    volatile LAS unsigned* MISC = (volatile LAS unsigned*)(lds + MISC_OFF);
    gu32* ctl = (gu32*)(args.ws + WS_CTL);
    for (int u = threadIdx.x; u < (LDS_BYTES - LDSCTL_OFF) / 4; u += NWAVES * 64) ((LAS unsigned*)(lds + LDSCTL_OFF))[u] = 0u;
    __syncthreads();
    XcdBarrier bar; bar.bar = (unsigned*)(ctl + CW_BAR); bar.x = 0; bar.st = nullptr;
    if (N_LAUNCHES == 1) bar = xcd_barrier_post((unsigned*)(ctl + CW_BAR), MISC + 8);
#define GRID_BAR() do { if (N_LAUNCHES == 1) xcd_barrier(bar); } while (0)
    const int lo = args.ph_lo, hi = args.ph_hi;
#define IN(k) (lo <= (k) && (k) < hi)
#define PHASE(k) do { if (IN(k)) { run_phase<k>(args, lds, args.out); if ((k) + 1 < N_PHASES && IN((k) + 1)) GRID_BAR(); } } while (0)
    PHASE(0); PHASE(1); PHASE(2); PHASE(3); PHASE(4); PHASE(5); PHASE(6); PHASE(7); PHASE(8); PHASE(9); PHASE(10); PHASE(11); PHASE(12); PHASE(13); PHASE(14);
#define REPLAY(k) do { if ((PROBE_MASK >> (k)) & 1) { for (int rep_ = 0; rep_ < PROBE_REPS; ++rep_) { GRID_BAR(); run_phase<k>(args, lds, (float*)(args.ws + 192 * MiB)); } } } while (0)
    REPLAY(0); REPLAY(1); REPLAY(2); REPLAY(3); REPLAY(4); REPLAY(5); REPLAY(6); REPLAY(7); REPLAY(8); REPLAY(9); REPLAY(10); REPLAY(11); REPLAY(12); REPLAY(13);
#undef IN
#undef PHASE
#undef REPLAY
#undef GRID_BAR
}

extern "C" void kernel_launch(void* const* d_in, const int* in_sizes, int n_in, void* d_out, int out_size, void* d_ws, size_t ws_size, hipStream_t stream) {
    static int grid = 0;
    if (grid == 0) {
        if (n_in != 15 || in_sizes[0] != M * D || out_size != M * D || ws_size < WS_END) { fprintf(stderr, "kernel_launch: unexpected problem shape (n_in %d, in0 %d, out %d, ws %zu); nothing launched\n", n_in, n_in > 0 ? in_sizes[0] : -1, out_size, ws_size); grid = -1; return; }
        int dev = 0, cus = 0, per_cu = 0;
        if (hipGetDevice(&dev) != hipSuccess || hipDeviceGetAttribute(&cus, hipDeviceAttributeMultiprocessorCount, dev) != hipSuccess) { grid = -1; return; }
        if (hipFuncSetAttribute((const void*)fwd_kernel, hipFuncAttributeMaxDynamicSharedMemorySize, LDS_BYTES) != hipSuccess) { fprintf(stderr, "kernel_launch: hipFuncSetAttribute failed\n"); grid = -1; return; }
        if (hipOccupancyMaxActiveBlocksPerMultiprocessor(&per_cu, (const void*)fwd_kernel, NWAVES * 64, LDS_BYTES) != hipSuccess || per_cu < 1)
            fprintf(stderr, "kernel_launch: note: occupancy query reports %d workgroups per CU\n", per_cu);
        (void)hipGetLastError();
        grid = cus;
    }
    if (grid < 0) return;
    if (hipMemsetAsync((char*)d_ws + WS_CTL, 0, CTL_ZERO_BYTES, stream) != hipSuccess) { fprintf(stderr, "kernel_launch: hipMemsetAsync failed\n"); return; }
    Args a{};
    for (int i = 0; i < 15; ++i) a.in[i] = (const float*)d_in[i];
    a.out = (float*)d_out; a.ws = (unsigned char*)d_ws;
    for (int li = 0; li < N_LAUNCHES; ++li) {
        if (N_LAUNCHES == 1) { a.ph_lo = 0; a.ph_hi = N_PHASES; } else { a.ph_lo = li; a.ph_hi = li + 1; }
        a.li = li;
        hipLaunchKernelGGL(fwd_kernel, dim3(grid), dim3(NWAVES * 64), LDS_BYTES, stream, a);
        const hipError_t le = hipPeekAtLastError();
        if (le != hipSuccess) { fprintf(stderr, "kernel_launch: launch %d failed: %s\n", li, hipGetErrorName(le)); break; }
    }
}
```

```cpp
#include <hip/hip_runtime.h>
#include <cstdio>
#include <cstdint>
namespace pg8 {
#define PG8_LAS __attribute__((address_space(3)))
typedef unsigned short bf16_t;
typedef short bf16x8 __attribute__((ext_vector_type(8)));
typedef float f32x4 __attribute__((ext_vector_type(4)));
typedef unsigned u32x4 __attribute__((ext_vector_type(4)));
constexpr int BM = 256, BK = 64, HALF = 128, HTB = HALF * BK * 2  , STAGE_BYTES = 8 * HTB, NXCD = 8, WGM = 8;

__host__ __device__ __forceinline__ int lds_byte(int r, int c) { const int st = (r >> 4) * 2 + (c >> 5), rr = r & 15, cc = c & 31, ob = rr * 64 + cc * 2; return st * 1024 + (ob ^ (((ob >> 9) & 1) << 5)); }
__host__ __device__ __forceinline__ void stage_rc(int b, int& R, int& C) { const int st = b / 1024, sb = b % 1024, swz = sb ^ (((sb >> 9) & 1) << 5); R = (st >> 1) * 16 + swz / 64; C = (st & 1) * 32 + (swz % 64) / 2; }
__host__ __device__ __forceinline__ int perm32(int rho) { const int n = rho >> 4, i = rho & 15; return 8 * (i >> 2) + 4 * n + (i & 3); }

struct Unit { int pm, pn; };
struct Gemm { const bf16_t* A; const bf16_t* Bt; int M, N, K; };

struct StaticOrder {
    int nM, nN, nwg, G, c;
    __host__ __device__ void init(int M, int N, int G_, int c_) { nM = M / BM; nN = N / BM; nwg = nM * nN; G = G_; c = c_; }
    __host__ __device__ bool next(int i, Unit& u) const {
        const long L = (long)i * G + c; if (L >= nwg) return false;
        int wgid = (int)L; { const int q = nwg / NXCD, r = nwg % NXCD, xcd = wgid % NXCD, off = wgid / NXCD; wgid = (xcd < r ? xcd * (q + 1) : r * (q + 1) + (xcd - r) * q) + off; }
        const int nig = WGM * nN, gid = wgid / nig, fm = gid * WGM, gsz = (nM - fm) < WGM ? (nM - fm) : WGM;
        u.pm = fm + ((wgid % nig) % gsz); u.pn = (wgid % nig) / gsz; return true;
    }
    __device__ __forceinline__ void a_ready(const Unit&) const {}
    __device__ __forceinline__ void done(const Unit&) const {}
};

__device__ __forceinline__ unsigned cvt_pk_bf16(float lo, float hi) { unsigned r; asm volatile("v_cvt_pk_bf16_f32 %0, %1, %2" : "=v"(r) : "v"(lo), "v"(hi)); return r; }
__device__ __forceinline__ float fast_rcp(float x) { return __builtin_amdgcn_rcpf(x); }
__device__ __forceinline__ float fast_exp(float x) { return __builtin_amdgcn_exp2f(x * 1.44269504089f); }
__device__ __forceinline__ float fast_log(float x) { return __builtin_amdgcn_logf(x) * 0.69314718056f; }
__device__ __forceinline__ float silu_f(float x) { return x * fast_rcp(1.0f + fast_exp(-x)); }
__device__ __forceinline__ float sigmoid_f(float x) { return fast_rcp(1.0f + fast_exp(-x)); }
constexpr float RMS_EPS = 1e-6f;
__device__ __forceinline__ void row_rs8(const float* part, int row0, int fq, float (&rs)[8]) {
    f32x4 p[8];
#pragma unroll
    for (int i = 0; i < 8; ++i) p[i] = *(const f32x4*)(part + (size_t)(row0 + (i >> 2) * HALF + (i & 3) * 16) * 16 + 4 * fq);
#pragma unroll
    for (int i = 0; i < 8; ++i) { float s = (p[i][0] + p[i][1]) + (p[i][2] + p[i][3]); s += __shfl_xor(s, 16); s += __shfl_xor(s, 32); rs[i] = 1.0f / sqrtf(s * (1.0f / 1024.0f) + RMS_EPS); }
}
__device__ __forceinline__ void store_bf16x8(bf16_t* p, const f32x4 v0, const f32x4 v1) {
    u32x4 w; w.x = cvt_pk_bf16(v0[0], v0[1]); w.y = cvt_pk_bf16(v0[2], v0[3]); w.z = cvt_pk_bf16(v1[0], v1[1]); w.w = cvt_pk_bf16(v1[2], v1[3]);
    *(u32x4*)p = w;
}

struct EpiL0In {
    static constexpr bool PERM = true, AFTER_DRAIN = false;
    const float* part;
    bf16_t *U, *Bb, *SQ, *IV, *SG; float* LOGF; const float* lbl;
    __device__ __forceinline__ void operator()(const f32x4 (&acc)[2][2][4][2], const Unit& u, int wr, int wc, int fr, int fq) const {
        const int row0 = u.pm * BM + wr * 64 + fr, cw = wc * 32 + 8 * fq, pn = u.pn;
        float rs8[8]; row_rs8(part, row0, fq, rs8);
        if (pn < 4) {
#pragma unroll
            for (int ai = 0; ai < 2; ++ai)
#pragma unroll
                for (int m = 0; m < 4; ++m) { const int row = row0 + ai * HALF + m * 16; const float r = rs8[ai * 4 + m], r2 = r * r;
                    const f32x4 v0 = acc[ai][0][m][0] * acc[ai][1][m][0] * r2, v1 = acc[ai][0][m][1] * acc[ai][1][m][1] * r2;
                    store_bf16x8(U + (size_t)row * 512 + pn * 128 + cw, v0, v1); }
        } else {
            const int seg = (pn - 4) >> 1, cb = ((pn - 4) & 1) * 256;
            float lb[2][8];
            if (seg == 2) {
#pragma unroll
                for (int bj = 0; bj < 2; ++bj)
#pragma unroll
                    for (int e = 0; e < 8; ++e) { const int c = cb + bj * HALF + cw + e; lb[bj][e] = fast_rcp(1.0f + fast_exp(lbl[512 + c] - lbl[c])); }
            }
#pragma unroll
            for (int ai = 0; ai < 2; ++ai)
#pragma unroll
                for (int m = 0; m < 4; ++m) { const int row = row0 + ai * HALF + m * 16; const float r = rs8[ai * 4 + m];
#pragma unroll
                    for (int bj = 0; bj < 2; ++bj) { const int col = cb + bj * HALF + cw; f32x4 v0 = acc[ai][bj][m][0] * r, v1 = acc[ai][bj][m][1] * r; const size_t off = (size_t)row * 512 + col;
                        if (seg == 0) store_bf16x8(Bb + off, v0, v1);
                        else if (seg == 1) { _Pragma("unroll") for (int e = 0; e < 4; ++e) { v0[e] = silu_f(v0[e]); v1[e] = silu_f(v1[e]); } store_bf16x8(SQ + off, v0, v1); }
                        else if (seg == 2) { _Pragma("unroll") for (int e = 0; e < 4; ++e) { const float l0 = lb[bj][e], l1 = lb[bj][4 + e];
                                v0[e] = fast_log(l0 + (1.0f - l0) * sigmoid_f(v0[e])); v1[e] = fast_log(l1 + (1.0f - l1) * sigmoid_f(v1[e])); }
                            *(f32x4*)(LOGF + off) = v0; *(f32x4*)(LOGF + off + 4) = v1; }
                        else if (seg == 3) store_bf16x8(IV + off, v0, v1);
                        else { _Pragma("unroll") for (int e = 0; e < 4; ++e) { v0[e] = silu_f(v0[e]); v1[e] = silu_f(v1[e]); } store_bf16x8(SG + off, v0, v1); }
                    } }
        }
    }
};

struct EpiSwiGLU {
    static constexpr bool PERM = true, AFTER_DRAIN = false;
    const float* part; bf16_t* ACT;
    __device__ __forceinline__ void operator()(const f32x4 (&acc)[2][2][4][2], const Unit& u, int wr, int wc, int fr, int fq) const {
        const int row0 = u.pm * BM + wr * 64 + fr, cw = wc * 32 + 8 * fq;
        float rs8[8]; row_rs8(part, row0, fq, rs8);
#pragma unroll
        for (int ai = 0; ai < 2; ++ai)
#pragma unroll
            for (int m = 0; m < 4; ++m) { const int row = row0 + ai * HALF + m * 16; const float r = rs8[ai * 4 + m];
                f32x4 g0 = acc[ai][0][m][0] * r, g1 = acc[ai][0][m][1] * r; const f32x4 u0 = acc[ai][1][m][0] * r, u1 = acc[ai][1][m][1] * r;
#pragma unroll
                for (int e = 0; e < 4; ++e) { g0[e] = silu_f(g0[e]) * u0[e]; g1[e] = silu_f(g1[e]) * u1[e]; }
                store_bf16x8(ACT + (size_t)row * 2816 + u.pn * 128 + cw, g0, g1); }
    }
};

template <bool BASE_F32> struct EpiResid {
    static constexpr bool PERM = true, AFTER_DRAIN = false;
    const float* X; bf16_t* HB; float* PART;
    __device__ __forceinline__ void operator()(const f32x4 (&acc)[2][2][4][2], const Unit& u, int wr, int wc, int fr, int fq) const {
        const int row0 = u.pm * BM + wr * 64 + fr, col0 = u.pn * BM + wc * 32 + 8 * fq;
#pragma unroll
        for (int ai = 0; ai < 2; ++ai) {
            f32x4 b0[4][2], b1[4][2]; u32x4 bb[4][2];
#pragma unroll
            for (int m = 0; m < 4; ++m)
#pragma unroll
                for (int bj = 0; bj < 2; ++bj) { const size_t o = (size_t)(row0 + ai * HALF + m * 16) * 1024 + col0 + bj * HALF;
                    if (BASE_F32) { b0[m][bj] = *(const f32x4*)(X + o); b1[m][bj] = *(const f32x4*)(X + o + 4); } else bb[m][bj] = *(const u32x4*)(HB + o); }
#pragma unroll
            for (int m = 0; m < 4; ++m) { const int row = row0 + ai * HALF + m * 16; float s = 0.f;
#pragma unroll
                for (int bj = 0; bj < 2; ++bj) { const size_t o = (size_t)row * 1024 + col0 + bj * HALF; f32x4 h0, h1;
                    if (BASE_F32) { h0 = b0[m][bj] + acc[ai][bj][m][0]; h1 = b1[m][bj] + acc[ai][bj][m][1]; }
                    else { const u32x4 bv = bb[m][bj];
                        h0 = (f32x4){__builtin_bit_cast(float, bv.x << 16), __builtin_bit_cast(float, bv.x & 0xffff0000u), __builtin_bit_cast(float, bv.y << 16), __builtin_bit_cast(float, bv.y & 0xffff0000u)} + acc[ai][bj][m][0];
                        h1 = (f32x4){__builtin_bit_cast(float, bv.z << 16), __builtin_bit_cast(float, bv.z & 0xffff0000u), __builtin_bit_cast(float, bv.w << 16), __builtin_bit_cast(float, bv.w & 0xffff0000u)} + acc[ai][bj][m][1]; }
                    store_bf16x8(HB + o, h0, h1);
                    s += ((h0[0] * h0[0] + h0[1] * h0[1]) + (h0[2] * h0[2] + h0[3] * h0[3])) + ((h1[0] * h1[0] + h1[1] * h1[1]) + (h1[2] * h1[2] + h1[3] * h1[3])); }
                s += __shfl_xor(s, 16); s += __shfl_xor(s, 32);
                if (fq == 0) PART[(size_t)row * 16 + u.pn * 4 + wc] = s; }
        }
    }
};

struct EpiL1In {
    static constexpr bool PERM = true, AFTER_DRAIN = false;
    const float* part; const int* pos; bf16_t *Q, *Kk, *V, *G;
    __device__ __forceinline__ void operator()(const f32x4 (&acc)[2][2][4][2], const Unit& u, int wr, int wc, int fr, int fq) const {
        const int row0 = u.pm * BM + wr * 64 + fr, cw = wc * 32 + 8 * fq, pn = u.pn;
        float rs8[8]; row_rs8(part, row0, fq, rs8);
        if (pn < 8) {
            const int head = pn & 3; bf16_t* O = (pn < 4) ? Q : Kk; const float sc = (pn < 4) ? 1.0f : 0.0625f;
            const float lgam = __builtin_amdgcn_logf(1.0f - __builtin_amdgcn_exp2f(-5.0f - (float)head)) * ((pn < 4) ? 1.0f : -1.0f);
            float fr_rev[8];
#pragma unroll
            for (int e = 0; e < 8; ++e) fr_rev[e] = __builtin_amdgcn_exp2f((float)(cw + e) * (-13.287712379549449f / 128.0f)) * 0.15915494309189535f;
#pragma unroll
            for (int ai = 0; ai < 2; ++ai)
#pragma unroll
                for (int m = 0; m < 4; ++m) { const int row = row0 + ai * HALF + m * 16; const float r = rs8[ai * 4 + m] * sc * __builtin_amdgcn_exp2f((float)((row & 63) - 63) * lgam); const float p = (float)pos[row];
                    f32x4 o1[2], o2[2];
#pragma unroll
                    for (int n = 0; n < 2; ++n)
#pragma unroll
                        for (int e = 0; e < 4; ++e) { const float rev = p * fr_rev[4 * n + e]; const float fr_ = rev - floorf(rev);
                            const float sn = __builtin_amdgcn_sinf(fr_), cs = __builtin_amdgcn_cosf(fr_);
                            const float x1 = acc[ai][0][m][n][e] * r, x2 = acc[ai][1][m][n][e] * r;
                            o1[n][e] = x1 * cs - x2 * sn; o2[n][e] = x1 * sn + x2 * cs; }
                    bf16_t* rp = O + (size_t)row * 1024 + head * 256 + cw;
                    store_bf16x8(rp, o1[0], o1[1]); store_bf16x8(rp + 128, o2[0], o2[1]); }
        } else {
            const bool isg = pn >= 16; bf16_t* O = isg ? G : V; const int cb = ((pn - 8) & 7) * 256;
#pragma unroll
            for (int ai = 0; ai < 2; ++ai)
#pragma unroll
                for (int m = 0; m < 4; ++m) { const int row = row0 + ai * HALF + m * 16; const float r = rs8[ai * 4 + m];
#pragma unroll
                    for (int bj = 0; bj < 2; ++bj) { f32x4 v0 = acc[ai][bj][m][0] * r, v1 = acc[ai][bj][m][1] * r;
                        if (isg) { _Pragma("unroll") for (int e = 0; e < 4; ++e) { v0[e] = silu_f(v0[e]); v1[e] = silu_f(v1[e]); } }
                        store_bf16x8(O + (size_t)row * 2048 + cb + bj * HALF + cw, v0, v1); } }
        }
    }
};


struct EpiNull {
    static constexpr bool PERM = true, AFTER_DRAIN = false;
    __device__ __forceinline__ void operator()(const f32x4 (&acc)[2][2][4][2], const Unit& u, int wr, int wc, int fr, int fq) const {
#pragma unroll
        for (int ai = 0; ai < 2; ++ai)
#pragma unroll
            for (int bj = 0; bj < 2; ++bj)
#pragma unroll
                for (int m = 0; m < 4; ++m)
#pragma unroll
                    for (int n = 0; n < 2; ++n) asm volatile("" :: "v"(acc[ai][bj][m][n]));
    }
};

template <class Epi, class Sched, bool ALIGN_EPI = false, bool SP2 = false>
__device__ __forceinline__ void gemm_phase(PG8_LAS unsigned char* lds, const Gemm g, const Sched& S, const Epi& E) {
    const int tid = threadIdx.x, wid = __builtin_amdgcn_readfirstlane(tid >> 6), lane = tid & 63, wr = wid >> 2, wc = wid & 3, fr = lane & 15, fq = lane >> 4;
    const int K = g.K, nt = K / BK;
    unsigned voffA[2], voffB[2];
#pragma unroll
    for (int i = 0; i < 2; ++i) { int R, C; stage_rc(tid * 16 + i * 8192, R, C); const int Rb = Epi::PERM ? ((R & ~31) + perm32(R & 31)) : R;
        voffA[i] = (unsigned)(R * K + C) * 2u; voffB[i] = (unsigned)(Rb * K + C) * 2u; }
    const size_t kstep = (size_t)(BK * 2);
    const size_t hstep = (size_t)HALF * K * 2;
    const size_t tstep = 2 * hstep;
    const unsigned ldsw = (unsigned)wid * 1024u;
    const int aoff = lds_byte(wr * 64 + fr, fq * 8), boff = lds_byte(wc * 32 + fr, fq * 8);
#define PG8_SA(b, h) (((b) * 2 + (h)) * HTB)
#define PG8_SB(b, h) ((4 + (b) * 2 + (h)) * HTB)
#define PG8_STAGE(bufoff, gbase, voff) do { _Pragma("unroll") for (int _i = 0; _i < 2; ++_i) \
        __builtin_amdgcn_global_load_lds((const unsigned*)((const char*)(gbase) + (voff)[_i]), (PG8_LAS unsigned*)(lds + (bufoff) + ldsw + _i * 8192), 16, 0, 0); } while (0)
#define PG8_LDA(dst, b, h) do { _Pragma("unroll") for (int m = 0; m < 4; ++m) _Pragma("unroll") for (int k = 0; k < 2; ++k) dst[m][k] = *(const PG8_LAS bf16x8*)(lds + PG8_SA(b, h) + aoff + m * 2048 + k * 1024); } while (0)
#define PG8_LDB(dst, b, h) do { _Pragma("unroll") for (int n = 0; n < 2; ++n) _Pragma("unroll") for (int k = 0; k < 2; ++k) dst[n][k] = *(const PG8_LAS bf16x8*)(lds + PG8_SB(b, h) + boff + n * 2048 + k * 1024); } while (0)
#define PG8_MMA(ai, bj, At, Bt) do { __builtin_amdgcn_s_setprio(1); _Pragma("unroll") for (int m = 0; m < 4; ++m) _Pragma("unroll") for (int n = 0; n < 2; ++n) _Pragma("unroll") for (int k = 0; k < 2; ++k) \
        acc[ai][bj][m][n] = __builtin_amdgcn_mfma_f32_16x16x32_bf16(Bt[n][k], At[m][k], acc[ai][bj][m][n], 0, 0, 0); __builtin_amdgcn_s_setprio(0); } while (0)
#define PG8_WAIT_V(n) asm volatile("s_waitcnt vmcnt(" #n ")" ::: "memory")
#define PG8_WAIT_L(n) asm volatile("s_waitcnt lgkmcnt(" #n ")" ::: "memory")
#define PG8_BAR __builtin_amdgcn_s_barrier()
#define PG8_SCHED __builtin_amdgcn_sched_barrier(0)
    Unit cur, nxt; int ui = 0;
    if (!S.next(0, cur)) return;
    f32x4 acc[2][2][4][2];
#pragma unroll
    for (int a = 0; a < 2; ++a)
#pragma unroll
        for (int b = 0; b < 2; ++b)
#pragma unroll
            for (int m = 0; m < 4; ++m)
#pragma unroll
                for (int n = 0; n < 2; ++n) acc[a][b][m][n] = (f32x4){0.f, 0.f, 0.f, 0.f};
    bf16x8 At[4][2], B0[2][2], B1[2][2];
    const char* cA = (const char*)g.A + (size_t)cur.pm * tstep; const char* cB = (const char*)g.Bt + (size_t)cur.pn * tstep;
    S.a_ready(cur);
    if constexpr (SP2) {
        PG8_STAGE(PG8_SB(0, 0), cB, voffB); PG8_STAGE(PG8_SB(0, 1), cB + hstep, voffB); PG8_STAGE(PG8_SA(0, 0), cA, voffA); PG8_STAGE(PG8_SA(0, 1), cA + hstep, voffA);
        if (wr == 1) PG8_BAR;
        PG8_WAIT_V(2); PG8_BAR;
        PG8_STAGE(PG8_SB(1, 0), cB + kstep, voffB); PG8_STAGE(PG8_SA(1, 0), cA + kstep, voffA); PG8_STAGE(PG8_SB(1, 1), cB + hstep + kstep, voffB);
        PG8_WAIT_V(6); PG8_BAR;
    } else {
        PG8_STAGE(PG8_SB(0, 0), cB, voffB); PG8_STAGE(PG8_SA(0, 0), cA, voffA); PG8_STAGE(PG8_SB(0, 1), cB + hstep, voffB); PG8_STAGE(PG8_SA(0, 1), cA + hstep, voffA);
        if (wr == 1) PG8_BAR;
        PG8_WAIT_V(4); PG8_BAR;
        PG8_STAGE(PG8_SB(1, 0), cB + kstep, voffB); PG8_STAGE(PG8_SA(1, 0), cA + kstep, voffA); PG8_STAGE(PG8_SB(1, 1), cB + hstep + kstep, voffB);
        PG8_WAIT_V(6); PG8_BAR;
    }
    for (;;) {
        const bool has_next = S.next(ui + 1, nxt);
        const char* nA = has_next ? (const char*)g.A + (size_t)nxt.pm * tstep : cA; const char* nB = has_next ? (const char*)g.Bt + (size_t)nxt.pn * tstep : cB;
        for (int t = 0; t < nt; t += 2) {
            const bool last = (t == nt - 2);
            const char* a1 = cA + (size_t)(t + 1) * kstep;
            const char* a2 = last ? nA : cA + (size_t)(t + 2) * kstep; const char* b2 = last ? nB : cB + (size_t)(t + 2) * kstep;
            const char* a3 = a2 + kstep; const char* b3 = b2 + kstep;
            if (last && has_next) S.a_ready(nxt);
            if constexpr (SP2) {
            PG8_LDB(B0, 0, 0); PG8_LDB(B1, 0, 1); PG8_SCHED; PG8_LDA(At, 0, 0); PG8_STAGE(PG8_SA(1, 1), a1 + hstep, voffA);
            PG8_WAIT_V(8); PG8_WAIT_L(0); PG8_BAR; PG8_MMA(0, 0, At, B0); PG8_MMA(0, 1, At, B1); PG8_BAR; PG8_SCHED;
            PG8_LDA(At, 0, 1); PG8_STAGE(PG8_SB(0, 0), b2, voffB); PG8_STAGE(PG8_SB(0, 1), b2 + hstep, voffB); PG8_STAGE(PG8_SA(0, 0), a2, voffA);
            PG8_WAIT_V(8); PG8_WAIT_L(0); PG8_BAR; PG8_MMA(1, 0, At, B0); PG8_MMA(1, 1, At, B1); PG8_BAR; PG8_SCHED;
            PG8_LDB(B0, 1, 0); PG8_LDB(B1, 1, 1); PG8_SCHED; PG8_LDA(At, 1, 0); PG8_STAGE(PG8_SA(0, 1), a2 + hstep, voffA);
            PG8_WAIT_V(8); PG8_WAIT_L(0); PG8_BAR; PG8_MMA(0, 0, At, B0); PG8_MMA(0, 1, At, B1); PG8_BAR; PG8_SCHED;
            PG8_LDA(At, 1, 1); PG8_STAGE(PG8_SB(1, 0), b3, voffB); PG8_STAGE(PG8_SB(1, 1), b3 + hstep, voffB); PG8_STAGE(PG8_SA(1, 0), a3, voffA);
            PG8_WAIT_V(8); PG8_WAIT_L(0); PG8_BAR; PG8_MMA(1, 0, At, B0); PG8_MMA(1, 1, At, B1); PG8_BAR; PG8_SCHED;
            } else {
            PG8_LDB(B0, 0, 0); PG8_SCHED; PG8_LDA(At, 0, 0); PG8_STAGE(PG8_SA(1, 1), a1 + hstep, voffA);
            PG8_WAIT_L(8); PG8_BAR; PG8_WAIT_L(0); PG8_MMA(0, 0, At, B0); PG8_BAR; PG8_SCHED;
            PG8_LDB(B1, 0, 1); PG8_STAGE(PG8_SB(0, 0), b2, voffB);
            PG8_BAR; PG8_WAIT_L(0); PG8_MMA(0, 1, At, B1); PG8_BAR;
            PG8_LDA(At, 0, 1); PG8_STAGE(PG8_SA(0, 0), a2, voffA);
            PG8_BAR; PG8_WAIT_L(0); PG8_MMA(1, 0, At, B0); PG8_BAR; PG8_SCHED;
            PG8_STAGE(PG8_SB(0, 1), b2 + hstep, voffB);
            PG8_WAIT_V(6); PG8_BAR; PG8_MMA(1, 1, At, B1); PG8_BAR;
            PG8_LDB(B0, 1, 0); PG8_SCHED; PG8_LDA(At, 1, 0); PG8_STAGE(PG8_SA(0, 1), a2 + hstep, voffA);
            PG8_WAIT_L(8); PG8_BAR; PG8_WAIT_L(0); PG8_MMA(0, 0, At, B0); PG8_BAR; PG8_SCHED;
            PG8_LDB(B1, 1, 1); PG8_STAGE(PG8_SB(1, 0), b3, voffB);
            PG8_BAR; PG8_WAIT_L(0); PG8_MMA(0, 1, At, B1); PG8_BAR;
            PG8_LDA(At, 1, 1); PG8_STAGE(PG8_SA(1, 0), a3, voffA);
            PG8_BAR; PG8_WAIT_L(0); PG8_MMA(1, 0, At, B0); PG8_BAR; PG8_SCHED;
            PG8_STAGE(PG8_SB(1, 1), b3 + hstep, voffB);
            PG8_WAIT_V(6); PG8_BAR; PG8_MMA(1, 1, At, B1); PG8_BAR;
            }
        }
        if constexpr (ALIGN_EPI) { if (wr == 0) PG8_BAR; }
        if constexpr (!Epi::AFTER_DRAIN) { E(acc, cur, wr, wc, fr, fq); S.done(cur); }
        if (!has_next) break;
#pragma unroll
        for (int a = 0; a < 2; ++a)
#pragma unroll
            for (int b = 0; b < 2; ++b)
#pragma unroll
                for (int m = 0; m < 4; ++m)
#pragma unroll
                    for (int n = 0; n < 2; ++n) acc[a][b][m][n] = (f32x4){0.f, 0.f, 0.f, 0.f};
        cur = nxt; cA = nA; cB = nB; ++ui;
        if constexpr (ALIGN_EPI) { if (wr == 1) PG8_BAR; }
    }
    PG8_WAIT_V(0);
    if constexpr (!ALIGN_EPI) { if (wr == 0) PG8_BAR; }
    PG8_BAR;
    if constexpr (Epi::AFTER_DRAIN) { E.fused(acc, cur, wr, wc, fr, fq, lds, wid, lane); S.done(cur); }
#undef PG8_SA
#undef PG8_SB
#undef PG8_STAGE
#undef PG8_LDA
#undef PG8_LDB
#undef PG8_MMA
#undef PG8_WAIT_V
#undef PG8_WAIT_L
#undef PG8_BAR
#undef PG8_SCHED
}
}
#define GAS __attribute__((address_space(1)))
#define LAS __attribute__((address_space(3)))
typedef unsigned short bf16;
typedef unsigned v4u __attribute__((ext_vector_type(4)));
typedef float f32x4 __attribute__((ext_vector_type(4)));
typedef short bf16x8 __attribute__((ext_vector_type(8)));
typedef GAS unsigned gu32;
typedef GAS unsigned long long gu64;
#define RLX_AGENT __ATOMIC_RELAXED, __HIP_MEMORY_SCOPE_AGENT
#define LDS_WAIT() asm volatile("s_waitcnt lgkmcnt(0)" ::: "memory")
#define VM_WAIT() asm volatile("s_waitcnt vmcnt(0)" ::: "memory")
__device__ __forceinline__ unsigned long long rt() { return __builtin_amdgcn_s_memrealtime(); }
__device__ __forceinline__ unsigned f2bf(float f) { unsigned u = __builtin_bit_cast(unsigned, f); return (u + 0x7fffu + ((u >> 16) & 1u)) >> 16; }
__device__ __forceinline__ unsigned pk2(float lo, float hi) { return f2bf(lo) | (f2bf(hi) << 16); }

#define XB_TMO      128
#define XB_XCNT(j)  (256  + 64 * (j))
#define XB_XSUB(j)  (1280 + 64 * (j))
#define XB_XGEN(j)  (2304 + 64 * (j))
#define XB_TOP      3328
#define XB_TOPGEN   3392
#define XCD_BAR_WORDS 3456
#define XB_SPIN_CAP (1u << 18)

__device__ __forceinline__ unsigned xb_ld(unsigned* p)              { return __hip_atomic_load(p, __ATOMIC_RELAXED, __HIP_MEMORY_SCOPE_AGENT); }
__device__ __forceinline__ unsigned xb_add(unsigned* p, unsigned v) { return __hip_atomic_fetch_add(p, v, __ATOMIC_RELAXED, __HIP_MEMORY_SCOPE_AGENT); }
__device__ __forceinline__ unsigned xb_xcc_id() { return (unsigned)__builtin_amdgcn_s_getreg((3 << 11) | 20) & 0xFu; }
#define XB_SPIN(cond, bar) do { unsigned _sp = 0; while (cond) { __builtin_amdgcn_s_sleep(1); \
    if ((++_sp & 255u) == 0u) { if (xb_ld(&(bar)[XB_TMO])) break; if (_sp > XB_SPIN_CAP) { atomicAdd(&(bar)[XB_TMO], 1u); break; } } } } while (0)

struct XcdBarrier {
    unsigned* bar; unsigned x;
    volatile LAS unsigned* st;
};

__device__ __forceinline__ XcdBarrier xcd_barrier_post(unsigned* bar, volatile LAS unsigned* st) {
    XcdBarrier b; b.bar = bar; b.x = xb_xcc_id(); b.st = st;
    if (threadIdx.x == 0) (void)xb_add(&bar[XB_XCNT(b.x)], 1u);
    return b;
}
__device__ __forceinline__ void xcd_barrier_complete(unsigned* bar, unsigned x, unsigned& nloc, unsigned& nx) {
    const unsigned G = gridDim.x * gridDim.y * gridDim.z;
    unsigned sum, cnt, mine, sp = 0u;
    for (;;) {
        sum = 0u; cnt = 0u; mine = 0u;
#pragma unroll
        for (unsigned j = 0; j < 16; ++j) { const unsigned c = xb_ld(&bar[XB_XCNT(j)]); sum += c; cnt += (c > 0u) ? 1u : 0u; mine = (j == x) ? c : mine; }
        if (sum == G) break;
        __builtin_amdgcn_s_sleep(1);
        if ((++sp & 255u) == 0u) { if (xb_ld(&bar[XB_TMO])) break; if (sp > XB_SPIN_CAP) { atomicAdd(&bar[XB_TMO], 1u); break; } }
    }
    nloc = mine > 0u ? mine : 1u; nx = cnt > 0u ? cnt : 1u;
}

__device__ __forceinline__ void xcd_barrier(const XcdBarrier& b) {
    asm volatile("s_waitcnt vmcnt(0)" ::: "memory");
    __syncthreads();
    if (threadIdx.x == 0) {
        unsigned* bar = b.bar;
        __builtin_amdgcn_s_waitcnt(0);
        unsigned nloc = b.st[0], nx = b.st[1];
        if (nloc == 0u) { xcd_barrier_complete(bar, b.x, nloc, nx); b.st[0] = nloc; b.st[1] = nx; }
        const unsigned old = xb_add(&bar[XB_XSUB(b.x)], 1u);
        const unsigned gen = old / nloc;
        if (old + 1u == (gen + 1u) * nloc) {
            __builtin_amdgcn_fence(__ATOMIC_RELEASE, "agent");
            asm volatile("s_waitcnt vmcnt(0)" ::: "memory");
            const unsigned og = xb_add(&bar[XB_TOP], 1u);
            const unsigned tg = og / nx;
            if (og + 1u == (tg + 1u) * nx) xb_add(&bar[XB_TOPGEN], 1u);
            else XB_SPIN(xb_ld(&bar[XB_TOPGEN]) == tg, bar);
            __builtin_amdgcn_fence(__ATOMIC_ACQUIRE, "agent");
            xb_add(&bar[XB_XGEN(b.x)], 1u);
            asm volatile("s_waitcnt vmcnt(0)" ::: "memory");
        } else {
            XB_SPIN(xb_ld(&bar[XB_XGEN(b.x)]) == gen, bar);
            __builtin_amdgcn_fence(__ATOMIC_ACQUIRE, "agent");
            asm volatile("s_waitcnt vmcnt(0)" ::: "memory");
        }
    }
    __syncthreads();
}
__device__ __forceinline__ float bf2f(unsigned short u) { return __builtin_bit_cast(float, (unsigned)u << 16); }
__device__ __forceinline__ float bflo(unsigned u) { return __builtin_bit_cast(float, u << 16); }
__device__ __forceinline__ float bfhi(unsigned u) { return __builtin_bit_cast(float, u & 0xffff0000u); }
__device__ __forceinline__ float wave_sum(float v) {
#pragma unroll
    for (int o = 1; o < 64; o <<= 1) v += __shfl_xor(v, o);
    return v;
}


namespace cs {
typedef short bf16x8 __attribute__((ext_vector_type(8)));
typedef short s16x4 __attribute__((ext_vector_type(4)));
typedef float f32x16 __attribute__((ext_vector_type(16)));
typedef float f32x2 __attribute__((ext_vector_type(2)));
typedef __bf16 bf16x2_t __attribute__((ext_vector_type(2)));
typedef unsigned u32x2 __attribute__((ext_vector_type(2)));
#define CS_MFMA(a, b, c) __builtin_amdgcn_mfma_f32_32x32x16_bf16((a), (b), (c), 0, 0, 0)
__device__ __forceinline__ unsigned pkbf(float lo, float hi) { return __builtin_bit_cast(unsigned, __builtin_convertvector((f32x2){lo, hi}, bf16x2_t)); }
template <int NCH> __device__ __forceinline__ unsigned img_off(unsigned row, unsigned ch) { return (128u * NCH) * (row >> 3) + 512u * (ch >> 2) + 64u * (row & 7) + 16u * ((ch & 3) ^ ((row >> 2) & 3)); }
template <int NCH> __device__ __forceinline__ bf16x8 row_read(LAS unsigned char* img, unsigned rowbase, int s, int r, int h) {
    return *(const LAS bf16x8*)(img + img_off<NCH>(rowbase + r, 2 * s + h));
}
template <int NCH> __device__ __forceinline__ unsigned tr_addr(unsigned lane, unsigned c, unsigned ks, unsigned t) {
    const unsigned h = lane >> 5, blk = (lane >> 4) & 1, q = (lane & 15) >> 2, p = lane & 3;
    return img_off<NCH>(16 * ks + 8 * h + 4 * t + q, 4 * c + 2 * blk + (p >> 1)) + 8 * (p & 1);
}
__device__ __forceinline__ void tr_read_ab(unsigned a0, unsigned a1, unsigned b0, unsigned b1, bf16x8& a, bf16x8& b) {
    s16x4 alo, ahi, blo, bhi;
    asm volatile("ds_read_b64_tr_b16 %0, %4\n\tds_read_b64_tr_b16 %1, %5\n\tds_read_b64_tr_b16 %2, %6\n\tds_read_b64_tr_b16 %3, %7\n\ts_waitcnt lgkmcnt(0)"
                 : "=&v"(alo), "=&v"(ahi), "=&v"(blo), "=&v"(bhi) : "v"(a0), "v"(a1), "v"(b0), "v"(b1) : "memory");
    a = __builtin_shufflevector(alo, ahi, 0, 1, 2, 3, 4, 5, 6, 7); b = __builtin_shufflevector(blo, bhi, 0, 1, 2, 3, 4, 5, 6, 7);
}
__device__ __forceinline__ bf16x8 tr_read_1(unsigned a0, unsigned a1) {
    s16x4 alo, ahi;
    asm volatile("ds_read_b64_tr_b16 %0, %2\n\tds_read_b64_tr_b16 %1, %3\n\ts_waitcnt lgkmcnt(0)" : "=&v"(alo), "=&v"(ahi) : "v"(a0), "v"(a1) : "memory");
    return __builtin_shufflevector(alo, ahi, 0, 1, 2, 3, 4, 5, 6, 7);
}
__device__ __forceinline__ int crow(int reg, int h) { return (reg & 3) + 8 * (reg >> 2) + 4 * h; }

struct ScanIO {
    const bf16* Qd; const bf16* Kd; int qk_ld;
    const bf16* V; int v_ld;
    const float* dec;
    float dec_const;
    bf16* Out; int out_ld;
    const bf16* SG; int sg_ld;
};

struct RR { unsigned e, o; };
template <int NCH> __device__ __forceinline__ RR rr_make(unsigned imgbase, unsigned row, unsigned h) { RR b; b.e = imgbase + img_off<NCH>(row, h); b.o = imgbase + img_off<NCH>(row, 2 + h); return b; }
__device__ __forceinline__ bf16x8 rr_read(LAS unsigned char* lds, const RR b, int s) { return *(const LAS bf16x8*)(lds + ((s & 1) ? b.o : b.e) + 512 * (s >> 1)); }
__device__ __forceinline__ bf16x8 tr8(LAS unsigned char* lds, unsigned a0, unsigned a1) {
    const s16x4 lo = __builtin_amdgcn_ds_read_tr16_b64_v4i16((LAS s16x4*)(lds + a0)), hi = __builtin_amdgcn_ds_read_tr16_b64_v4i16((LAS s16x4*)(lds + a1));
    return __builtin_shufflevector(lo, hi, 0, 1, 2, 3, 4, 5, 6, 7);
}

template <int DK, int DV, bool VECDEC> __device__ __forceinline__ void chunk_scan(LAS unsigned char* lds, const ScanIO io) {
    constexpr int C = 64, NCHUNKS = 2048 / C, KS = DK / 16, NVT = DV / 32, NCHK = DK / 8, NCHV = DV / 8;
    constexpr int QD = 0, KD = C * DK * 2, V0 = 2 * C * DK * 2, VSZ = C * DV * 2, SDT = V0 + 2 * VSZ, PIM = SDT + DV * DK * 2, OB = PIM + C * C * 2, END = OB + C * DV * 4;
    static_assert(END <= 146944, "scan LDS map");
    constexpr int NQ = (C * NCHK) / 512, NV = (C * NCHV) / 512;
    static_assert(NQ * 512 == C * NCHK && NV * 512 == C * NCHV, "staging split");
    static_assert(NCHUNKS % 2 == 0, "the chunk loop is unrolled by two (two prefetch register sets)");
    constexpr int NS = (DK / 32) * NVT / 8;
    static_assert(NVT == 2 || NVT == 4, "DV is 64 or 128"); static_assert(NS == 1 || NS == 2, "one or two state tiles per wave");
    constexpr bool ZALL = (2 * NVT == 8);
    constexpr unsigned KSTEP_K = 2 * 128 * NCHK, KSTEP_V = 2 * 128 * NCHV;
    const int wave0 = __builtin_amdgcn_readfirstlane(threadIdx.x >> 6); const unsigned lane0 = threadIdx.x & 63;
    f32x16 S0, S1, Z;
#pragma unroll
    for (int i = 0; i < 16; ++i) { S0[i] = 0.f; S1[i] = 0.f; Z[i] = 0.f; }
    v4u pqA[NQ], pkA[NQ], pvA[NV], pqB[NQ], pkB[NQ], pvB[NV];
    f32x4 dvA[4], dvB[4];
#define CS_IDS() int wave = wave0; unsigned lane = lane0; asm volatile("" : "+s"(wave)); asm volatile("" : "+v"(lane)); \
        const unsigned r = lane & 31, h = lane >> 5; const int tid = wave * 64 + (int)lane; \
        const bool zw = ZALL ? true : (wave < 2 * NVT); const int z_it = wave / NVT, z_vt = wave % NVT; \
        const int xw0 = ZALL ? 0 : 2 * NVT; const bool xw = (wave >= xw0 && wave < xw0 + 3); const int xt = wave - xw0; const int x_jt = (xt == 2) ? 1 : 0, x_it = (xt == 0) ? 0 : 1; \
        const int s_kt = (NS * wave) / NVT, s_vt0 = (NS * wave) % NVT; (void)r; (void)h; (void)tid; (void)zw; (void)z_it; (void)z_vt; (void)xw; (void)x_jt; (void)x_it; (void)s_kt; (void)s_vt0
#define CS_LOAD_CHUNK(n_, pq, pk, pv, dv) do { const size_t rowb_ = (size_t)(n_) * C; \
        _Pragma("unroll") for (int i_ = 0; i_ < NQ; ++i_) { const int c_ = tid + 512 * i_, row_ = c_ / NCHK, ch_ = c_ % NCHK; \
            pq[i_] = *(const GAS v4u*)(io.Qd + (rowb_ + row_) * io.qk_ld + ch_ * 8); pk[i_] = *(const GAS v4u*)(io.Kd + (rowb_ + row_) * io.qk_ld + ch_ * 8); } \
        _Pragma("unroll") for (int i_ = 0; i_ < NV; ++i_) { const int c_ = tid + 512 * i_, row_ = c_ / NCHV, ch_ = c_ % NCHV; \
            pv[i_] = *(const GAS v4u*)(io.V + (rowb_ + row_) * io.v_ld + ch_ * 8); } \
        if (VECDEC) { _Pragma("unroll") for (int g_ = 0; g_ < 4; ++g_) dv[g_] = *(const GAS f32x4*)(io.dec + (size_t)(n_) * 512 + 32 * s_kt + 8 * g_ + 4 * h); } } while (0)
#define CS_STAGE_CHUNK(vbuf_, pq, pk, pv) do { \
        _Pragma("unroll") for (int i_ = 0; i_ < NQ; ++i_) { const int c_ = tid + 512 * i_, row_ = c_ / NCHK, ch_ = c_ % NCHK; const unsigned o_ = img_off<NCHK>(row_, ch_); \
            *(LAS v4u*)(lds + o_ + QD) = pq[i_]; *(LAS v4u*)(lds + o_ + KD) = pk[i_]; } \
        _Pragma("unroll") for (int i_ = 0; i_ < NV; ++i_) { const int c_ = tid + 512 * i_, row_ = c_ / NCHV, ch_ = c_ % NCHV; \
            *(LAS v4u*)(lds + img_off<NCHV>(row_, ch_) + V0 + (vbuf_) * VSZ) = pv[i_]; } } while (0)
#define CS_WRITE_SDT() do { \
        _Pragma("unroll") for (int g_ = 0; g_ < 4; ++g_) { \
            u32x2 w0_, w1_; w0_.x = pkbf(S0[4 * g_], S0[4 * g_ + 1]); w0_.y = pkbf(S0[4 * g_ + 2], S0[4 * g_ + 3]); w1_.x = pkbf(S1[4 * g_], S1[4 * g_ + 1]); w1_.y = pkbf(S1[4 * g_ + 2], S1[4 * g_ + 3]); \
            *(LAS u32x2*)(lds + SDT + img_off<NCHK>(32 * s_vt0 + r, 4 * s_kt + g_) + 8 * h) = w0_; \
            if (NS == 2) *(LAS u32x2*)(lds + SDT + img_off<NCHK>(32 * (s_vt0 + 1) + r, 4 * s_kt + g_) + 8 * h) = w1_; } } while (0)
#define CS_OUTPUT(n_) do { const size_t rowb_ = (size_t)(n_) * C; const LAS float* ob_ = (const LAS float*)(lds + OB); \
        _Pragma("unroll") for (int i_ = 0; i_ < (C * DV) / (512 * 8); ++i_) { const int e_ = (tid + 512 * i_) * 8, row_ = e_ / DV, c8_ = e_ % DV; \
            const f32x4 a_ = *(const LAS f32x4*)(ob_ + row_ * DV + c8_), b_ = *(const LAS f32x4*)(ob_ + row_ * DV + c8_ + 4); \
            v4u w_; w_.x = pkbf(a_[0], a_[1]); w_.y = pkbf(a_[2], a_[3]); w_.z = pkbf(b_[0], b_[1]); w_.w = pkbf(b_[2], b_[3]); \
            *(GAS v4u*)(io.Out + (rowb_ + row_) * io.out_ld + c8_) = w_; } } while (0)

#define CS_ITER(n, pqX, pkX, pvX, dvX, pqY, pkY, pvY, dvY) do { \
        CS_IDS(); \
        const unsigned vb = V0 + ((n) & 1) * VSZ; \
          \
        if ((n) > 0) CS_OUTPUT((n) - 1); \
        if ((n) + 2 < NCHUNKS) CS_LOAD_CHUNK((n) + 2, pqX, pkX, pvX, dvX); \
        if (xw) {                                                      \
            f32x16 x; \
            _Pragma("unroll") for (int i = 0; i < 16; ++i) x[i] = 0.f; \
            const RR ra = rr_make<NCHK>(KD, 32 * x_jt + r, h), rb = rr_make<NCHK>(QD, 32 * x_it + r, h); \
            _Pragma("unroll") for (int s = 0; s < KS; ++s) { const bf16x8 a = rr_read(lds, ra, s), b = rr_read(lds, rb, s); x = CS_MFMA(a, b, x); } \
            if (x_jt == x_it) { _Pragma("unroll") for (int i = 0; i < 16; ++i) x[i] = ((unsigned)crow(i, h) > r) ? 0.f : x[i]; } \
            _Pragma("unroll") for (int g = 0; g < 4; ++g) { u32x2 w; w.x = pkbf(x[4 * g], x[4 * g + 1]); w.y = pkbf(x[4 * g + 2], x[4 * g + 3]); \
                *(LAS u32x2*)(lds + PIM + img_off<8>(32 * x_it + r, 4 * x_jt + g) + 8 * h) = w; } \
        } \
        if (zw) {                                                      \
            _Pragma("unroll") for (int i = 0; i < 16; ++i) Z[i] = 0.f; \
            const RR ra = rr_make<NCHK>(QD, 32 * z_it + r, h), rb = rr_make<NCHK>(SDT, 32 * z_vt + r, h); \
            _Pragma("unroll") for (int s = 0; s < KS; ++s) { const bf16x8 a = rr_read(lds, ra, s), b = rr_read(lds, rb, s); Z = CS_MFMA(a, b, Z); } \
        } \
        {                                                              \
            const unsigned tk0 = KD + tr_addr<NCHK>(lane, s_kt, 0, 0), tk1 = KD + tr_addr<NCHK>(lane, s_kt, 0, 1); \
            const unsigned t0a = vb + tr_addr<NCHV>(lane, s_vt0, 0, 0), t0b = vb + tr_addr<NCHV>(lane, s_vt0, 0, 1); \
            const unsigned t1a = vb + tr_addr<NCHV>(lane, s_vt0 + (NS - 1), 0, 0), t1b = vb + tr_addr<NCHV>(lane, s_vt0 + (NS - 1), 0, 1); \
            _Pragma("unroll") for (int ks = 0; ks < C / 16; ++ks) { \
                const bf16x8 a = tr8(lds, tk0 + ks * KSTEP_K, tk1 + ks * KSTEP_K), b0 = tr8(lds, t0a + ks * KSTEP_V, t0b + ks * KSTEP_V); \
                S0 = CS_MFMA(a, b0, S0); \
                if (NS == 2) { const bf16x8 b1 = tr8(lds, t1a + ks * KSTEP_V, t1b + ks * KSTEP_V); S1 = CS_MFMA(a, b1, S1); } } \
        } \
        __syncthreads(); \
          \
        if (zw) {                                                      \
            const RR rp = rr_make<8>(PIM, 32 * z_it + r, h); \
            const unsigned tza = vb + tr_addr<NCHV>(lane, z_vt, 0, 0), tzb = vb + tr_addr<NCHV>(lane, z_vt, 0, 1); \
            _Pragma("unroll") for (int s = 0; s < 4; ++s) { if (s < 2 * (z_it + 1)) { const bf16x8 a = rr_read(lds, rp, s); \
                    const bf16x8 b = tr8(lds, tza + s * KSTEP_V, tzb + s * KSTEP_V); Z = CS_MFMA(a, b, Z); } } \
            LAS float* ob = (LAS float*)(lds + OB) + (32 * z_it + 4 * h) * DV + 32 * z_vt + r; \
            _Pragma("unroll") for (int i = 0; i < 16; ++i) ob[((i & 3) + 8 * (i >> 2)) * DV] = Z[i]; \
        } \
        if ((n) + 1 < NCHUNKS) { \
            if (VECDEC) { _Pragma("unroll") for (int i = 0; i < 16; ++i) { const float d = dvY[i >> 2][i & 3]; S0[i] *= d; S1[i] *= d; } } \
            else { _Pragma("unroll") for (int i = 0; i < 16; ++i) { S0[i] *= io.dec_const; S1[i] *= io.dec_const; } } \
            CS_WRITE_SDT(); \
            CS_STAGE_CHUNK(((n) + 1) & 1, pqY, pkY, pvY); \
        } \
        __syncthreads(); \
    } while (0)

    { CS_IDS(); CS_WRITE_SDT(); CS_LOAD_CHUNK(0, pqA, pkA, pvA, dvA); CS_STAGE_CHUNK(0, pqA, pkA, pvA); CS_LOAD_CHUNK(1, pqB, pkB, pvB, dvB); }
    __syncthreads();
    for (int n = 0; n < NCHUNKS; n += 2) {
        CS_ITER(n, pqA, pkA, pvA, dvA, pqB, pkB, pvB, dvB);
        CS_ITER(n + 1, pqB, pkB, pvB, dvB, pqA, pkA, pvA, dvA);
    }
    { CS_IDS(); CS_OUTPUT(NCHUNKS - 1); }
    __syncthreads();
#undef CS_IDS
#undef CS_LOAD_CHUNK
#undef CS_LOAD_SG
#undef CS_STAGE_CHUNK
#undef CS_WRITE_SDT
#undef CS_OUTPUT
#undef CS_ITER
}
}

constexpr int NWAVES = 8;
using pg8::RMS_EPS;
constexpr int BATCH = 8, SEQ = 2048, D = 1024, M = BATCH * SEQ;
constexpr int EVEN_IN = 3584, ODD_IN = 6144, FFH = 2816, FF2 = 5632;
constexpr int N_PHASES = 15;
#ifndef MK_N_LAUNCHES
#define MK_N_LAUNCHES 1
#endif
constexpr int N_LAUNCHES = MK_N_LAUNCHES;
#ifndef PROBE_MASK
#define PROBE_MASK 0
#endif
#ifndef PROBE_REPS
#define PROBE_REPS 1
#endif

constexpr size_t MiB = 1u << 20;
constexpr size_t WS_CTL = 0, CTL_ZERO_BYTES = 64 * 1024;
constexpr size_t WS_PART = 1 * MiB;
constexpr size_t WS_W_ODD_IN = 2 * MiB, WS_W_ODD_OUT = 14 * MiB, WS_W_FFN_IN1 = 18 * MiB, WS_W_FFN_OUT1 = 2 * MiB  ;
constexpr size_t WS_HB = 32 * MiB;
constexpr size_t WS_W_EVEN_IN = 64 * MiB, WS_W_EVEN_OUT = 71 * MiB, WS_W_FFN_IN0 = 73 * MiB, WS_W_FFN_OUT0 = 84 * MiB;
constexpr size_t WS_U = 96 * MiB, WS_BB = 112 * MiB, WS_SQ = 128 * MiB, WS_LOGF = 144 * MiB, WS_IV = 176 * MiB, WS_SG0 = 192 * MiB, WS_MIX0 = 208 * MiB;
constexpr size_t WS_KD = 240 * MiB;
constexpr size_t WS_ORAW = 144 * MiB;
constexpr size_t WS_DEC = 29 * MiB;
constexpr size_t WS_ACT0 = 96 * MiB;
constexpr size_t WS_Q = 64 * MiB, WS_K = 96 * MiB, WS_V = 128 * MiB, WS_G = 192 * MiB;
constexpr size_t WS_ACT1 = 64 * MiB;
constexpr size_t WS_END = 256 * MiB;
constexpr int CW_BAR = 4096;

constexpr int RING_OFF = 0, RING_BYTES = 131072;
constexpr int LDS_BYTES = 147456;
constexpr int LDSCTL_OFF = LDS_BYTES - 512, MISC_OFF = LDSCTL_OFF + 320;

struct Args { const float* in[15]; float* out; unsigned char* ws; int ph_lo, ph_hi, li, pad; };

struct MatDesc { const float* W; int K, N; bf16* WT; const float* scale; int scale_from; int map; };
__device__ __forceinline__ int map_col(int map, int n) {
    if (map == 1) { const int seg = n >> 9, c = n & 511; if (seg == 0) return 256 * (c >> 7) + (c & 127); if (seg == 2) return 256 * (c >> 7) + 128 + (c & 127); if (seg == 1) return 1024 + c; return n; }
    if (map == 2) { if (n < FFH) return 256 * (n >> 7) + (n & 127); const int c = n - FFH; return 256 * (c >> 7) + 128 + (c & 127); }
    return n;
}
__device__ __forceinline__ void transpose_item(const MatDesc& md, LAS float* scr, int item, int lane) {
    const int N = md.N, K = md.K, nblk = N / 32, kb = item / nblk, nb = item % nblk, k0 = 64 * kb, n0 = 32 * nb;
    float wv[32];
#pragma unroll
    for (int i = 0; i < 32; ++i) wv[i] = md.W[(size_t)(k0 + 2 * i + (lane >> 5)) * N + n0 + (lane & 31)];
#pragma unroll
    for (int i = 0; i < 32; ++i) { const int kk = 2 * i + (lane >> 5); const int k = k0 + kk; float w = wv[i];
        if (md.scale && k >= md.scale_from) w *= md.scale[k - md.scale_from];
        scr[kk * 33 + (lane & 31)] = w; }
    LDS_WAIT(); asm volatile("" ::: "memory");
    const int c = lane & 7; const int d0 = map_col(md.map, n0);
#pragma unroll
    for (int j = 0; j < 4; ++j) { const int n = (lane >> 3) + 8 * j; const LAS float* s = scr + (8 * c) * 33 + n;
        v4u o; o.x = pk2(s[0 * 33], s[1 * 33]); o.y = pk2(s[2 * 33], s[3 * 33]); o.z = pk2(s[4 * 33], s[5 * 33]); o.w = pk2(s[6 * 33], s[7 * 33]);
        *(GAS v4u*)(md.WT + (size_t)(d0 + n) * K + k0 + 8 * c) = o; }
    LDS_WAIT(); asm volatile("" ::: "memory");
}
__device__ __forceinline__ MatDesc mat_desc(const Args& a, int mat) {
    unsigned char* ws = a.ws; MatDesc d;
    switch (mat) {
    case 0: d = MatDesc{a.in[5], D, EVEN_IN, (bf16*)(ws + WS_W_EVEN_IN), a.in[2], 0, 1}; break;
    case 1: d = MatDesc{a.in[9], D, D, (bf16*)(ws + WS_W_EVEN_OUT), a.in[8], 512, 0}; break;
    case 2: d = MatDesc{a.in[13], D, FF2, (bf16*)(ws + WS_W_FFN_IN0), a.in[3], 0, 2}; break;
    case 3: d = MatDesc{a.in[14], FFH, D, (bf16*)(ws + WS_W_FFN_OUT0), nullptr, 0, 0}; break;
    case 4: d = MatDesc{a.in[10], D, ODD_IN, (bf16*)(ws + WS_W_ODD_IN), a.in[2] + D, 0, 0}; break;
    case 5: d = MatDesc{a.in[12], 2048, D, (bf16*)(ws + WS_W_ODD_OUT), a.in[11], 0, 0}; break;
    case 6: d = MatDesc{a.in[13] + (size_t)D * FF2, D, FF2, (bf16*)(ws + WS_W_FFN_IN1), a.in[3] + D, 0, 2}; break;
    default: d = MatDesc{a.in[14] + (size_t)FFH * D, FFH, D, (bf16*)(ws + WS_W_FFN_OUT1), nullptr, 0, 0}; break;
    }
    return d;
}
__device__ __forceinline__ void convert_mats(const Args& a, int mat_lo, int mat_hi, LAS float* scr, int gw, int NGW, int lane) {
    for (int mat = mat_lo; mat < mat_hi; ++mat) { const MatDesc md = mat_desc(a, mat); const int nitems = (md.K / 64) * (md.N / 32);
        for (int it = gw; it < nitems; it += NGW) transpose_item(md, scr, it, lane); }
}
template <int NR> __device__ __forceinline__ void x_rows_prep(const float* x, bf16* hb, float* part, int m0, int stride, int lane) {
    f32x4 v[NR][4];
#pragma unroll
    for (int i = 0; i < NR; ++i) { const GAS f32x4* xr = (const GAS f32x4*)(x + (size_t)(m0 + i * stride) * D) + lane;
#pragma unroll
        for (int j = 0; j < 4; ++j) v[i][j] = xr[64 * j]; }
#pragma unroll
    for (int i = 0; i < NR; ++i) { const int m = m0 + i * stride; float s = 0.f;
#pragma unroll
        for (int j = 0; j < 4; ++j) s += (v[i][j].x * v[i][j].x + v[i][j].y * v[i][j].y) + (v[i][j].z * v[i][j].z + v[i][j].w * v[i][j].w);
        s = wave_sum(s);
        GAS unsigned long long* o8 = (GAS unsigned long long*)(hb + (size_t)m * D) + lane;
#pragma unroll
        for (int j = 0; j < 4; ++j) o8[64 * j] = (unsigned long long)pk2(v[i][j].x, v[i][j].y) | ((unsigned long long)pk2(v[i][j].z, v[i][j].w) << 32);
        if (lane < 16) part[(size_t)m * 16 + lane] = (lane == 0) ? s : 0.f; }
}

__device__ __forceinline__ float exp_fast(float x) { return __builtin_amdgcn_exp2f(x * 1.44269504089f); }
__device__ __forceinline__ void hgrn_prep(LAS unsigned char* lds, unsigned char* ws, int unit) {
    const int tid = threadIdx.x, k = tid & 127, tq = tid >> 7; const int b = unit >> 7, h = (unit >> 5) & 3, n = unit & 31;
    LAS float* part = (LAS float*)lds;
    const size_t row0 = (size_t)b * SEQ + n * 64 + 16 * tq; const int col = h * 128 + k;
    const float* LF = (const float*)(ws + WS_LOGF); bf16* SQ = (bf16*)(ws + WS_SQ); bf16* KDG = (bf16*)(ws + WS_KD);
    float l[16], c[16]; float run = 0.f;
#pragma unroll
    for (int j = 0; j < 16; ++j) l[j] = LF[(row0 + j) * 512 + col];
    unsigned short qh[16];
#pragma unroll
    for (int j = 0; j < 16; ++j) qh[j] = SQ[(row0 + j) * 512 + col];
#pragma unroll
    for (int j = 0; j < 16; ++j) { run += l[j]; c[j] = run; }
    part[tq * 128 + k] = run;
    __syncthreads();
    const float p0 = part[k], p1 = part[128 + k], p2 = part[256 + k], p3 = part[384 + k];
    const float bl = (p0 + p1) + (p2 + p3); const float pre = (tq > 0 ? p0 : 0.f) + (tq > 1 ? p1 : 0.f) + (tq > 2 ? p2 : 0.f);
#pragma unroll
    for (int j = 0; j < 16; ++j) { const float bt = pre + c[j]; const float q = bf2f(qh[j]); const float f = exp_fast(l[j]);
        SQ[(row0 + j) * 512 + col] = (bf16)f2bf(q * exp_fast(bt - bl)); KDG[(row0 + j) * 512 + col] = (bf16)f2bf((1.0f - f) * exp_fast(bl - bt)); }
    if (tq == 0) ((float*)(ws + WS_DEC))[(size_t)(b * 32 + n) * 512 + col] = exp_fast(bl);
    __syncthreads();
}

template <int K> __device__ __forceinline__ void run_phase(const Args& args, LAS unsigned char* lds, float* Hout) {
    const int tid = threadIdx.x, lane = tid & 63, wave = __builtin_amdgcn_readfirstlane(tid >> 6);
    const int G = gridDim.x; const int bx = blockIdx.x; const int vcu = (G % 8 == 0) ? (bx % 8) * (G / 8) + bx / 8 : bx;
    unsigned char* ws = args.ws;
    const int gw = vcu * NWAVES + wave, NGW = G * NWAVES;
    float* PART = (float*)(ws + WS_PART);
    bf16* HB = (bf16*)(ws + WS_HB);
    const float* x = args.in[0];
    (void)lane; (void)gw; (void)NGW; (void)PART; (void)HB; (void)x; (void)Hout;
    if constexpr (K == 0) {
        LAS float* scr = (LAS float*)(lds + RING_OFF + wave * 16384);
        convert_mats(args, 0, 1, scr, gw, NGW, lane);
        { int m = gw; for (; m + 3 * NGW < M; m += 4 * NGW) x_rows_prep<4>(x, HB, PART, m, NGW, lane); for (; m < M; m += NGW) x_rows_prep<1>(x, HB, PART, m, NGW, lane); }
    }
    if constexpr (K == 1) {
        pg8::Gemm g{HB, (const bf16*)(ws + WS_W_EVEN_IN), M, EVEN_IN, D}; pg8::StaticOrder S; S.init(M, EVEN_IN, G, bx);
        pg8::EpiL0In E{PART, (bf16*)(ws + WS_U), (bf16*)(ws + WS_BB), (bf16*)(ws + WS_SQ), (bf16*)(ws + WS_IV), (bf16*)(ws + WS_SG0), (float*)(ws + WS_LOGF), args.in[7]};
        pg8::gemm_phase<pg8::EpiL0In, pg8::StaticOrder, true, true>(lds + RING_OFF, g, S, E);
    }
    if constexpr (K == 2) {
        for (int u = bx; u < BATCH * 4 * 32; u += G) hgrn_prep(lds, ws, u);
    }
    if constexpr (K == 3) {
        for (int u = bx; u < 64; u += G) { const int b = u >> 3, h = (u >> 1) & 3, vs = u & 1; const size_t r5 = (size_t)b * SEQ * 512 + h * 128;
            cs::ScanIO io; io.Qd = (const bf16*)(ws + WS_SQ) + r5; io.Kd = (const bf16*)(ws + WS_KD) + r5; io.qk_ld = 512; io.V = (const bf16*)(ws + WS_IV) + r5 + vs * 64; io.v_ld = 512;
            io.dec = (const float*)(ws + WS_DEC) + (size_t)b * 32 * 512 + h * 128; io.dec_const = 0.f;
            io.Out = (bf16*)(ws + WS_ORAW) + r5 + vs * 64; io.out_ld = 512;
            cs::chunk_scan<128, 64, true>(lds, io); }
        { int cb, ncb; if (G > 64) { cb = bx - 64; ncb = G - 64; } else { cb = bx; ncb = G; }
          if (cb >= 0) { const bf16* U = (const bf16*)(ws + WS_U); const bf16* Bb = (const bf16*)(ws + WS_BB); bf16* MIX = (bf16*)(ws + WS_MIX0); const float* cw = args.in[6];
            for (int it = cb * 512 + tid; it < M * 64; it += ncb * 512) { const int row = it >> 6, c0 = (it & 63) * 8, t = row & (SEQ - 1);
                const v4u u0 = *(const GAS v4u*)(U + (size_t)row * 512 + c0); v4u u1 = (v4u){0u, 0u, 0u, 0u}, u2 = u1;
                if (t >= 1) u1 = *(const GAS v4u*)(U + (size_t)(row - 1) * 512 + c0);
                if (t >= 2) u2 = *(const GAS v4u*)(U + (size_t)(row - 2) * 512 + c0);
                const v4u bb = *(const GAS v4u*)(Bb + (size_t)row * 512 + c0);
                float y[8];
#pragma unroll
                for (int p = 0; p < 4; ++p) { const int c = c0 + 2 * p;
                    y[2 * p] = bflo(bb[p]) * (cw[c] * bflo(u2[p]) + cw[512 + c] * bflo(u1[p]) + cw[1024 + c] * bflo(u0[p]));
                    y[2 * p + 1] = bfhi(bb[p]) * (cw[c + 1] * bfhi(u2[p]) + cw[512 + c + 1] * bfhi(u1[p]) + cw[1024 + c + 1] * bfhi(u0[p])); }
                v4u o; o.x = pk2(y[0], y[1]); o.y = pk2(y[2], y[3]); o.z = pk2(y[4], y[5]); o.w = pk2(y[6], y[7]);
                *(GAS v4u*)(MIX + (size_t)row * 1024 + c0) = o; }
            LAS float* scr = (LAS float*)(lds + RING_OFF + wave * 16384);
            convert_mats(args, 1, 7, scr, cb * NWAVES + wave, ncb * NWAVES, lane); } }
    }
    if constexpr (K == 4) {
        const bf16* O = (const bf16*)(ws + WS_ORAW); const bf16* SG = (const bf16*)(ws + WS_SG0); bf16* MIX = (bf16*)(ws + WS_MIX0);
        for (int m0 = gw; m0 < M; m0 += 4 * NGW) { v4u ov[4], gv[4];
#pragma unroll
            for (int i = 0; i < 4; ++i) { const int m = (m0 + i * NGW < M) ? m0 + i * NGW : m0; ov[i] = *(const GAS v4u*)(O + (size_t)m * 512 + lane * 8); gv[i] = *(const GAS v4u*)(SG + (size_t)m * 512 + lane * 8); }
#pragma unroll
            for (int i = 0; i < 4; ++i) { float o[8]; float q = 0.f;
#pragma unroll
                for (int p = 0; p < 4; ++p) { o[2 * p] = bflo(ov[i][p]); o[2 * p + 1] = bfhi(ov[i][p]); q += o[2 * p] * o[2 * p] + o[2 * p + 1] * o[2 * p + 1]; }
                q += __shfl_xor(q, 1); q += __shfl_xor(q, 2); q += __shfl_xor(q, 4); q += __shfl_xor(q, 8);
                const float rstd = 1.0f / sqrtf(q * (1.0f / 128.0f) + RMS_EPS);
                v4u w;
#pragma unroll
                for (int p = 0; p < 4; ++p) w[p] = pk2(o[2 * p] * rstd * bflo(gv[i][p]), o[2 * p + 1] * rstd * bfhi(gv[i][p]));
                if (m0 + i * NGW < M) *(GAS v4u*)(MIX + (size_t)(m0 + i * NGW) * 1024 + 512 + lane * 8) = w; } }
    }
    if constexpr (K == 5) {
        pg8::Gemm g{(const bf16*)(ws + WS_MIX0), (const bf16*)(ws + WS_W_EVEN_OUT), M, D, D}; pg8::StaticOrder S; S.init(M, D, G, bx);
        pg8::EpiResid<true> E{x, HB, PART};
        pg8::gemm_phase<pg8::EpiResid<true>, pg8::StaticOrder, true, true>(lds + RING_OFF, g, S, E);
    }
    if constexpr (K == 6) {
        pg8::Gemm g{HB, (const bf16*)(ws + WS_W_FFN_IN0), M, FF2, D}; pg8::StaticOrder S; S.init(M, FF2, G, bx);
        pg8::EpiSwiGLU E{PART, (bf16*)(ws + WS_ACT0)};
        pg8::gemm_phase<pg8::EpiSwiGLU, pg8::StaticOrder, true, true>(lds + RING_OFF, g, S, E);
    }
    if constexpr (K == 7) {
        pg8::Gemm g{(const bf16*)(ws + WS_ACT0), (const bf16*)(ws + WS_W_FFN_OUT0), M, D, FFH}; pg8::StaticOrder S; S.init(M, D, G, bx);
        pg8::EpiResid<false> E{nullptr, HB, PART};
        pg8::gemm_phase<pg8::EpiResid<false>, pg8::StaticOrder, true, true>(lds + RING_OFF, g, S, E);
    }
    if constexpr (K == 8) {
        pg8::Gemm g{HB, (const bf16*)(ws + WS_W_ODD_IN), M, ODD_IN, D}; pg8::StaticOrder S; S.init(M, ODD_IN, G, bx);
        pg8::EpiL1In E{PART, (const int*)args.in[1], (bf16*)(ws + WS_Q), (bf16*)(ws + WS_K), (bf16*)(ws + WS_V), (bf16*)(ws + WS_G)};
        pg8::gemm_phase<pg8::EpiL1In, pg8::StaticOrder, true, true>(lds + RING_OFF, g, S, E);
    }
    if constexpr (K == 9) {
        for (int u0 = bx; u0 < 256; u0 += G) { const int u = (G == 256) ? (((u0 & 7) * 4 + (u0 >> 6)) * 8 + ((u0 >> 3) & 7)) : u0;
            const int b = u >> 5, h = (u >> 3) & 3, vs = u & 7;
            const float lg = __builtin_amdgcn_logf(1.0f - exp2f(-5.0f - (float)h));
            cs::ScanIO io; io.Qd = (const bf16*)(ws + WS_Q) + (size_t)b * SEQ * 1024 + h * 256; io.Kd = (const bf16*)(ws + WS_K) + (size_t)b * SEQ * 1024 + h * 256; io.qk_ld = 1024;
            io.V = (const bf16*)(ws + WS_V) + (size_t)b * SEQ * 2048 + h * 512 + vs * 64; io.v_ld = 2048; io.dec = nullptr; io.dec_const = __builtin_amdgcn_exp2f(64.0f * lg);
            io.Out = (bf16*)(ws + WS_V) + (size_t)b * SEQ * 2048 + h * 512 + vs * 64; io.out_ld = 2048;
            cs::chunk_scan<256, 64, false>(lds, io); }
    }
    if constexpr (K == 10) {
        LAS float* scr = (LAS float*)(lds + RING_OFF + wave * 16384);
        convert_mats(args, 7, 8, scr, gw, NGW, lane);
        const bf16* O = (const bf16*)(ws + WS_V); bf16* Gp = (bf16*)(ws + WS_G);
        for (int it0 = gw; it0 < M * 4; it0 += 4 * NGW) {
            v4u ov[4], gv[4]; size_t off[4];
#pragma unroll
            for (int i = 0; i < 4; ++i) { int it = it0 + i * NGW; if (it >= M * 4) it = it0; off[i] = (size_t)(it >> 2) * 2048 + (it & 3) * 512 + lane * 8;
                ov[i] = *(const GAS v4u*)(O + off[i]); gv[i] = *(const GAS v4u*)(Gp + off[i]); }
#pragma unroll
            for (int i = 0; i < 4; ++i) { float o[8]; float sm = 0.f;
#pragma unroll
                for (int p = 0; p < 4; ++p) { o[2 * p] = bflo(ov[i][p]); o[2 * p + 1] = bfhi(ov[i][p]); sm += o[2 * p] + o[2 * p + 1]; }
                const float mu = wave_sum(sm) * (1.0f / 512.0f); float q = 0.f;
#pragma unroll
                for (int e = 0; e < 8; ++e) { o[e] -= mu; q += o[e] * o[e]; }
                const float rstd = 1.0f / sqrtf(wave_sum(q) * (1.0f / 512.0f) + RMS_EPS);
                v4u w;
#pragma unroll
                for (int p = 0; p < 4; ++p) w[p] = pk2(o[2 * p] * rstd * bflo(gv[i][p]), o[2 * p + 1] * rstd * bfhi(gv[i][p]));
                if (it0 + i * NGW < M * 4) *(GAS v4u*)(Gp + off[i]) = w; } }
    }
    if constexpr (K == 11) {
        pg8::Gemm g{(const bf16*)(ws + WS_G), (const bf16*)(ws + WS_W_ODD_OUT), M, D, 2048}; pg8::StaticOrder S; S.init(M, D, G, bx);
        pg8::EpiResid<false> E{nullptr, HB, PART};
        pg8::gemm_phase<pg8::EpiResid<false>, pg8::StaticOrder, true, true>(lds + RING_OFF, g, S, E);
    }
    if constexpr (K == 12) {
        pg8::Gemm g{HB, (const bf16*)(ws + WS_W_FFN_IN1), M, FF2, D}; pg8::StaticOrder S; S.init(M, FF2, G, bx);
        pg8::EpiSwiGLU E{PART, (bf16*)(ws + WS_ACT1)};
        pg8::gemm_phase<pg8::EpiSwiGLU, pg8::StaticOrder, true, true>(lds + RING_OFF, g, S, E);
    }
    if constexpr (K == 13) {
        pg8::Gemm g{(const bf16*)(ws + WS_ACT1), (const bf16*)(ws + WS_W_FFN_OUT1), M, D, FFH}; pg8::StaticOrder S; S.init(M, D, G, bx);
        pg8::EpiResid<false> E{nullptr, HB, PART};
        pg8::gemm_phase<pg8::EpiResid<false>, pg8::StaticOrder, true, true>(lds + RING_OFF, g, S, E);
    }
    if constexpr (K == 15) {
        pg8::Gemm g{HB, (const bf16*)(ws + WS_W_ODD_IN), M, ODD_IN, D}; pg8::StaticOrder S; S.init(M, ODD_IN, G, bx);
        pg8::EpiNull E{};
        pg8::gemm_phase<pg8::EpiNull, pg8::StaticOrder, true, true>(lds + RING_OFF, g, S, E);
    }
    if constexpr (K == 14) {
        const float* wf = args.in[4];
        f32x4 wv[4];
#pragma unroll
        for (int j = 0; j < 2; ++j) { wv[2 * j] = *((const GAS f32x4*)(wf + 512 * j + 8 * lane)); wv[2 * j + 1] = *((const GAS f32x4*)(wf + 512 * j + 8 * lane + 4)); }
        for (int m0 = gw; m0 < M; m0 += 4 * NGW) { v4u hv[4][2];
#pragma unroll
            for (int i = 0; i < 4; ++i) { const int m = (m0 + i * NGW < M) ? m0 + i * NGW : m0;
#pragma unroll
                for (int j = 0; j < 2; ++j) hv[i][j] = *(const GAS v4u*)(HB + (size_t)m * D + 512 * j + 8 * lane); }
#pragma unroll
            for (int i = 0; i < 4; ++i) { float v[16]; float sq = 0.f;
#pragma unroll
                for (int j = 0; j < 2; ++j)
#pragma unroll
                    for (int p = 0; p < 4; ++p) { v[8 * j + 2 * p] = bflo(hv[i][j][p]); v[8 * j + 2 * p + 1] = bfhi(hv[i][j][p]); sq += v[8 * j + 2 * p] * v[8 * j + 2 * p] + v[8 * j + 2 * p + 1] * v[8 * j + 2 * p + 1]; }
                const float rs = 1.0f / sqrtf(wave_sum(sq) * (1.0f / 1024.0f) + RMS_EPS);
                if (m0 + i * NGW < M) { float* orow = args.out + (size_t)(m0 + i * NGW) * D;
#pragma unroll
                    for (int j = 0; j < 2; ++j) { *(GAS f32x4*)(orow + 512 * j + 8 * lane) = (f32x4){v[8 * j] * rs, v[8 * j + 1] * rs, v[8 * j + 2] * rs, v[8 * j + 3] * rs} * wv[2 * j];
                        *(GAS f32x4*)(orow + 512 * j + 8 * lane + 4) = (f32x4){v[8 * j + 4] * rs, v[8 * j + 5] * rs, v[8 * j + 6] * rs, v[8 * j + 7] * rs} * wv[2 * j + 1]; } } } }
    }
}

__global__ void __launch_bounds__(NWAVES * 64, 2) fwd_kernel(Args args) {
    extern __shared__ __attribute__((aligned(16))) unsigned char lds_raw[];
    LAS unsigned char* lds = (LAS unsigned char*)lds_raw;
    volatile LAS unsigned* MISC = (volatile LAS unsigned*)(lds + MISC_OFF);
    gu32* ctl = (gu32*)(args.ws + WS_CTL);
    for (int u = threadIdx.x; u < (LDS_BYTES - LDSCTL_OFF) / 4; u += NWAVES * 64) ((LAS unsigned*)(lds + LDSCTL_OFF))[u] = 0u;
    __syncthreads();
    XcdBarrier bar; bar.bar = (unsigned*)(ctl + CW_BAR); bar.x = 0; bar.st = nullptr;
    if (N_LAUNCHES == 1) bar = xcd_barrier_post((unsigned*)(ctl + CW_BAR), MISC + 8);
#define GRID_BAR() do { if (N_LAUNCHES == 1) xcd_barrier(bar); } while (0)
    const int lo = args.ph_lo, hi = args.ph_hi;
#define IN(k) (lo <= (k) && (k) < hi)
#define PHASE(k) do { if (IN(k)) { run_phase<k>(args, lds, args.out); if ((k) + 1 < N_PHASES && IN((k) + 1)) GRID_BAR(); } } while (0)
    PHASE(0); PHASE(1); PHASE(2); PHASE(3); PHASE(4); PHASE(5); PHASE(6); PHASE(7); PHASE(8); PHASE(9); PHASE(10); PHASE(11); PHASE(12); PHASE(13); PHASE(14);
#define REPLAY(k) do { if ((PROBE_MASK >> (k)) & 1) { for (int rep_ = 0; rep_ < PROBE_REPS; ++rep_) { GRID_BAR(); run_phase<k>(args, lds, (float*)(args.ws + 192 * MiB)); } } } while (0)
    REPLAY(0); REPLAY(1); REPLAY(2); REPLAY(3); REPLAY(4); REPLAY(5); REPLAY(6); REPLAY(7); REPLAY(8); REPLAY(9); REPLAY(10); REPLAY(11); REPLAY(12); REPLAY(13); REPLAY(15);
#undef IN
#undef PHASE
#undef REPLAY
#undef GRID_BAR
}

extern "C" void kernel_launch(void* const* d_in, const int* in_sizes, int n_in, void* d_out, int out_size, void* d_ws, size_t ws_size, hipStream_t stream) {
    static int grid = 0;
    if (grid == 0) {
        if (n_in != 15 || in_sizes[0] != M * D || out_size != M * D || ws_size < WS_END) { fprintf(stderr, "kernel_launch: unexpected problem shape (n_in %d, in0 %d, out %d, ws %zu); nothing launched\n", n_in, n_in > 0 ? in_sizes[0] : -1, out_size, ws_size); grid = -1; return; }
        int dev = 0, cus = 0, per_cu = 0;
        if (hipGetDevice(&dev) != hipSuccess || hipDeviceGetAttribute(&cus, hipDeviceAttributeMultiprocessorCount, dev) != hipSuccess) { grid = -1; return; }
        if (hipFuncSetAttribute((const void*)fwd_kernel, hipFuncAttributeMaxDynamicSharedMemorySize, LDS_BYTES) != hipSuccess) { fprintf(stderr, "kernel_launch: hipFuncSetAttribute failed\n"); grid = -1; return; }
        if (hipOccupancyMaxActiveBlocksPerMultiprocessor(&per_cu, (const void*)fwd_kernel, NWAVES * 64, LDS_BYTES) != hipSuccess || per_cu < 1)
            fprintf(stderr, "kernel_launch: note: occupancy query reports %d workgroups per CU\n", per_cu);
        (void)hipGetLastError();
        grid = cus;
    }
    if (grid < 0) return;
    if (hipMemsetAsync((char*)d_ws + WS_CTL, 0, CTL_ZERO_BYTES, stream) != hipSuccess) { fprintf(stderr, "kernel_launch: hipMemsetAsync failed\n"); return; }
    Args a{};
    for (int i = 0; i < 15; ++i) a.in[i] = (const float*)d_in[i];
    a.out = (float*)d_out; a.ws = (unsigned char*)d_ws;
    for (int li = 0; li < N_LAUNCHES; ++li) {
        if (N_LAUNCHES == 1) { a.ph_lo = 0; a.ph_hi = N_PHASES; } else { a.ph_lo = li; a.ph_hi = li + 1; }
        a.li = li;
        hipLaunchKernelGGL(fwd_kernel, dim3(grid), dim3(NWAVES * 64), LDS_BYTES, stream, a);
        const hipError_t le = hipPeekAtLastError();
        if (le != hipSuccess) { fprintf(stderr, "kernel_launch: launch %d failed: %s\n", li, hipGetErrorName(le)); break; }
    }
}
```
